# Optimizing an MI355X kernel written in HIP

```python
import math
import jax, jax.numpy as jnp
from jax import lax
import numpy as np

D_MODEL = 1024
BATCH = 16
SEQ = 4096
DEPTH = 2

CHUNK = 64
HEAD_DIM = 64
N_HEADS = D_MODEL // HEAD_DIM
N_SB_HEADS = N_HEADS // 2
N_RET_HEADS = N_HEADS - N_SB_HEADS
D_SB = N_SB_HEADS * HEAD_DIM
D_RET = N_RET_HEADS * HEAD_DIM
D_IN_EVEN = 3 * D_SB + 4 * D_RET
SB_BLOCK = 128
N_C_HEADS = N_HEADS
LEFT_CHUNKS = 8
BAND = (LEFT_CHUNKS + 1) * CHUNK
MAX_REL = 4 * CHUNK
D_FF_DENSE = 256 * (-(-(8 * D_MODEL // 3) // 256))
D_FF_EXPERT = 7 * D_MODEL // 2
N_EXPERTS = 8
TOP_K = 2
ROPE_BASE = 10000.0
LN_EPS = 1e-5
N_EVEN = (DEPTH + 1) // 2
N_ODD = DEPTH // 2
DEEPNORM_ALPHA = (2 * DEPTH) ** 0.25
DEEPNORM_BETA = (8 * DEPTH) ** -0.25

kernel_name = "hybrid_stickbreak_retention_chunkattn_moe"


def layer_norm(x, g, b):
    xf = x.astype(jnp.float32)
    mu = jnp.mean(xf, axis=-1, keepdims=True)
    var = jnp.mean(jnp.square(xf - mu), axis=-1, keepdims=True)
    return ((xf - mu) * lax.rsqrt(var + LN_EPS) * g + b).astype(x.dtype)


def rotary(x, pos):
    half = HEAD_DIM // 2
    inv_freq = ROPE_BASE ** (-jnp.arange(half, dtype=jnp.float32) / half)
    ang = pos.astype(jnp.float32)[:, None] * inv_freq[None, :]
    cos = jnp.cos(ang)[None, :, None, :]
    sin = jnp.sin(ang)[None, :, None, :]
    x1, x2 = x[..., :half], x[..., half:]
    return jnp.concatenate([x1 * cos - x2 * sin, x1 * sin + x2 * cos], axis=-1)


def stick_breaking(q, k, v):
    S = q.shape[2]
    scale = HEAD_DIM ** -0.5
    outs = []
    for blk in range(S // SB_BLOCK):
        t0 = blk * SB_BLOCK
        t1 = t0 + SB_BLOCK
        z = jnp.einsum('bhqd,bhkd->bhqk', q[:, :, t0:t1], k[:, :, :t1]) * scale
        valid = jnp.arange(t1)[None, :] < (t0 + jnp.arange(SB_BLOCK))[:, None]
        log_1m = jnp.where(valid, jax.nn.log_sigmoid(-z), 0.0)
        suffix = lax.cumsum(log_1m, axis=3, reverse=True) - log_1m
        w = jnp.where(valid, jnp.exp(jax.nn.log_sigmoid(z) + suffix), 0.0)
        outs.append(jnp.einsum('bhqk,bhkd->bhqd', w, v[:, :, :t1]))
    return jnp.concatenate(outs, axis=2)


def retention(q, k, v):
    B, S, H, d = q.shape
    n_chunks = S // CHUNK
    gamma = 1.0 - 2.0 ** (-5.0 - jnp.arange(H, dtype=jnp.float32))
    log_g = jnp.log(gamma)
    i = jnp.arange(CHUNK, dtype=jnp.float32)
    diff = i[:, None] - i[None, :]
    decay_in = jnp.where(diff >= 0, jnp.exp(log_g[:, None, None] * jnp.maximum(diff, 0.0)), 0.0)
    decay_q = jnp.exp(log_g[:, None] * (i + 1.0))[..., None]
    decay_k = jnp.exp(log_g[:, None] * (CHUNK - 1.0 - i))[..., None]
    decay_c = jnp.exp(log_g * CHUNK)[:, None, None]

    def to_chunks(t):
        return t.reshape(B, n_chunks, CHUNK, H, d).transpose(1, 0, 3, 2, 4)

    def step(state, inp):
        qc, kc, vc = inp
        inner = jnp.einsum('bhid,bhjd->bhij', qc, kc) * decay_in
        out = (jnp.einsum('bhij,bhjd->bhid', inner, vc)
               + jnp.einsum('bhid,bhde->bhie', qc, state) * decay_q)
        state = state * decay_c + jnp.einsum('bhjd,bhje->bhde', kc * decay_k, vc)
        return state, out

    state0 = jnp.zeros((B, H, d, d), jnp.float32)
    _, o = lax.scan(step, state0, (to_chunks(q), to_chunks(k), to_chunks(v)))
    return o.transpose(1, 0, 3, 2, 4).reshape(B, S, H, d)


def chunk_attention(q, k, v, bias_table):
    B, S, H, d = q.shape
    n_chunks = S // CHUNK
    pad = LEFT_CHUNKS * CHUNK
    scale = HEAD_DIM ** -0.5
    k_pad = jnp.pad(k, ((0, 0), (pad, 0), (0, 0), (0, 0)))
    v_pad = jnp.pad(v, ((0, 0), (pad, 0), (0, 0), (0, 0)))
    rel = jnp.arange(CHUNK)[:, None] + pad - jnp.arange(BAND)[None, :]
    rel_idx = jnp.clip(rel, -MAX_REL, MAX_REL) + MAX_REL
    bias = bias_table[:, rel_idx].astype(jnp.float32)

    def one_chunk(c):
        start = c * CHUNK
        q_c = lax.dynamic_slice_in_dim(q, start, CHUNK, axis=1)
        k_b = lax.dynamic_slice_in_dim(k_pad, start, BAND, axis=1)
        v_b = lax.dynamic_slice_in_dim(v_pad, start, BAND, axis=1)
        s = jnp.einsum('bqhd,bkhd->bhqk', q_c, k_b).astype(jnp.float32) * scale + bias
        key_pos = start - pad + jnp.arange(BAND)
        s = jnp.where((key_pos >= 0)[None, None, None, :], s, -jnp.inf)
        p = jax.nn.softmax(s, axis=-1)
        return jnp.einsum('bhqk,bkhd->bqhd', p.astype(v.dtype), v_b)

    o = lax.map(one_chunk, jnp.arange(n_chunks))
    return o.transpose(1, 0, 2, 3, 4).reshape(B, S, H * d)


def even_mixer(x, w_in, ret_gn_g, w_out):
    B, S, _ = x.shape
    h = x @ w_in
    splits = [D_SB, 2 * D_SB, 3 * D_SB, 3 * D_SB + D_RET, 3 * D_SB + 2 * D_RET, 3 * D_SB + 3 * D_RET]
    q_sb, k_sb, v_sb, q_r, k_r, v_r, g_r = jnp.split(h, splits, axis=-1)

    def sb_heads(t):
        return t.reshape(B, S, N_SB_HEADS, HEAD_DIM).transpose(0, 2, 1, 3).astype(jnp.float32)

    o_sb = stick_breaking(sb_heads(q_sb), sb_heads(k_sb), sb_heads(v_sb))
    o_sb = o_sb.transpose(0, 2, 1, 3).reshape(B, S, D_SB)

    def ret_heads(t):
        return t.reshape(B, S, N_RET_HEADS, HEAD_DIM).astype(jnp.float32)

    pos = jnp.arange(S)
    qr = rotary(ret_heads(q_r), pos) * HEAD_DIM ** -0.5
    kr = rotary(ret_heads(k_r), pos)
    o_r = retention(qr, kr, ret_heads(v_r))
    mu = jnp.mean(o_r, axis=-1, keepdims=True)
    var = jnp.mean(jnp.square(o_r - mu), axis=-1, keepdims=True)
    o_r = ((o_r - mu) * lax.rsqrt(var + LN_EPS)).reshape(B, S, D_RET) * ret_gn_g
    o_r = jax.nn.silu(g_r.astype(jnp.float32)) * o_r

    o = jnp.concatenate([o_sb, o_r], axis=-1).astype(x.dtype)
    return o @ w_out


def odd_mixer(x, w_qkv, rel_bias, w_out):
    B, S, _ = x.shape
    q, k, v = jnp.split(x @ w_qkv, 3, axis=-1)
    shp = (B, S, N_C_HEADS, HEAD_DIM)
    o = chunk_attention(q.reshape(shp), k.reshape(shp), v.reshape(shp), rel_bias)
    return o.astype(x.dtype) @ w_out


def swiglu(x, w_gate, w_up, w_down):
    return (jax.nn.silu(x @ w_gate) * (x @ w_up)) @ w_down


def moe_swiglu(x, w_router, b_router, w_gate, w_up, w_down):
    B, S, D = x.shape
    xt = x.reshape(B * S, D)
    logits = xt.astype(jnp.float32) @ w_router.astype(jnp.float32) + b_router.astype(jnp.float32)
    top_val, top_idx = lax.top_k(logits, TOP_K)
    gates = jax.nn.softmax(top_val, axis=-1)
    combine = jnp.sum(jax.nn.one_hot(top_idx, N_EXPERTS, dtype=jnp.float32) * gates[..., None], axis=1)
    y = jnp.zeros((B * S, D), jnp.float32)
    for e in range(N_EXPERTS):
        h = jax.nn.silu(xt @ w_gate[e]) * (xt @ w_up[e])
        y = y + combine[:, e:e + 1] * (h @ w_down[e]).astype(jnp.float32)
    return y.astype(x.dtype).reshape(B, S, D)


def setup_inputs(seed: int = 0) -> dict:
    key = jax.random.key(seed)
    ks = jax.random.split(key, 24)

    def nrm(k, shape, scale):
        return jax.random.normal(k, shape, jnp.float32) * scale

    d = D_MODEL
    beta = DEEPNORM_BETA
    return {
        'x': nrm(ks[0], (BATCH, SEQ, d), 1.0),
        'even_ln1_g': 1.0 + nrm(ks[1], (N_EVEN, d), 0.02),
        'even_ln1_b': nrm(ks[2], (N_EVEN, d), 0.02),
        'even_w_in': nrm(ks[3], (N_EVEN, d, D_IN_EVEN), d ** -0.5),
        'even_ret_gn_g': 1.0 + nrm(ks[4], (N_EVEN, D_RET), 0.02),
        'even_w_out': nrm(ks[5], (N_EVEN, d, d), d ** -0.5 * beta),
        'even_ln2_g': 1.0 + nrm(ks[6], (N_EVEN, d), 0.02),
        'even_ln2_b': nrm(ks[7], (N_EVEN, d), 0.02),
        'even_w_gate': nrm(ks[8], (N_EVEN, d, D_FF_DENSE), d ** -0.5),
        'even_w_up': nrm(ks[9], (N_EVEN, d, D_FF_DENSE), d ** -0.5),
        'even_w_down': nrm(ks[10], (N_EVEN, D_FF_DENSE, d), D_FF_DENSE ** -0.5 * beta),
        'odd_ln1_g': 1.0 + nrm(ks[11], (N_ODD, d), 0.02),
        'odd_ln1_b': nrm(ks[12], (N_ODD, d), 0.02),
        'odd_w_qkv': nrm(ks[13], (N_ODD, d, 3 * d), d ** -0.5),
        'odd_rel_bias': nrm(ks[14], (N_ODD, N_C_HEADS, 2 * MAX_REL + 1), 0.5),
        'odd_w_out': nrm(ks[15], (N_ODD, d, d), d ** -0.5 * beta),
        'odd_ln2_g': 1.0 + nrm(ks[16], (N_ODD, d), 0.02),
        'odd_ln2_b': nrm(ks[17], (N_ODD, d), 0.02),
        'odd_w_router': nrm(ks[18], (N_ODD, d, N_EXPERTS), d ** -0.5),
        'odd_b_router': nrm(ks[19], (N_ODD, N_EXPERTS), 0.01),
        'odd_w_gate': nrm(ks[20], (N_ODD, N_EXPERTS, d, D_FF_EXPERT), d ** -0.5),
        'odd_w_up': nrm(ks[21], (N_ODD, N_EXPERTS, d, D_FF_EXPERT), d ** -0.5),
        'odd_w_down': nrm(ks[22], (N_ODD, N_EXPERTS, D_FF_EXPERT, d), D_FF_EXPERT ** -0.5 * beta),
    }


def reference(x, even_ln1_g, even_ln1_b, even_w_in, even_ret_gn_g, even_w_out,
              even_ln2_g, even_ln2_b, even_w_gate, even_w_up, even_w_down,
              odd_ln1_g, odd_ln1_b, odd_w_qkv, odd_rel_bias, odd_w_out,
              odd_ln2_g, odd_ln2_b, odd_w_router, odd_b_router,
              odd_w_gate, odd_w_up, odd_w_down):
    alpha = DEEPNORM_ALPHA
    for layer in range(DEPTH):
        i = layer // 2
        if layer % 2 == 0:
            mix = even_mixer(x, even_w_in[i], even_ret_gn_g[i], even_w_out[i])
            x = layer_norm(alpha * x + mix, even_ln1_g[i], even_ln1_b[i])
            ffn = swiglu(x, even_w_gate[i], even_w_up[i], even_w_down[i])
            x = layer_norm(alpha * x + ffn, even_ln2_g[i], even_ln2_b[i])
        else:
            mix = odd_mixer(x, odd_w_qkv[i], odd_rel_bias[i], odd_w_out[i])
            x = layer_norm(alpha * x + mix, odd_ln1_g[i], odd_ln1_b[i])
            ffn = moe_swiglu(x, odd_w_router[i], odd_b_router[i],
                             odd_w_gate[i], odd_w_up[i], odd_w_down[i])
            x = layer_norm(alpha * x + ffn, odd_ln2_g[i], odd_ln2_b[i])
    return x
```

```cpp
#include <hip/hip_runtime.h>
#include <cstdio>
#include <cstdint>
namespace pg8 {
#define PG8_LAS __attribute__((address_space(3)))
typedef unsigned short bf16_t;
typedef short bf16x8 __attribute__((ext_vector_type(8)));
typedef float f32x4 __attribute__((ext_vector_type(4)));
typedef unsigned u32x4 __attribute__((ext_vector_type(4)));
constexpr int BM = 256, BK = 64, HALF = 128, HTB = HALF * BK * 2  , STAGE_BYTES = 8 * HTB, NXCD = 8, WGM = 8;

__host__ __device__ __forceinline__ int lds_byte(int r, int c) { const int st = (r >> 4) * 2 + (c >> 5), rr = r & 15, cc = c & 31, ob = rr * 64 + cc * 2; return st * 1024 + (ob ^ (((ob >> 9) & 1) << 5)); }
__host__ __device__ __forceinline__ void stage_rc(int b, int& R, int& C) { const int st = b / 1024, sb = b % 1024, swz = sb ^ (((sb >> 9) & 1) << 5); R = (st >> 1) * 16 + swz / 64; C = (st & 1) * 32 + (swz % 64) / 2; }
__host__ __device__ __forceinline__ int perm32(int rho) { const int n = rho >> 4, i = rho & 15; return 8 * (i >> 2) + 4 * n + (i & 3); }

struct Unit { int pm, pn; };
struct Gemm { const bf16_t* A; const bf16_t* Bt; int M, N, K; };

struct StaticOrder {
    int nM, nN, nwg, G, c;
    __host__ __device__ void init(int M, int N, int G_, int c_) { nM = M / BM; nN = N / BM; nwg = nM * nN; G = G_; c = c_; }
    __host__ __device__ bool next(int i, Unit& u) const {
        const long L = (long)i * G + c; if (L >= nwg) return false;
        int wgid = (int)L; { const int q = nwg / NXCD, r = nwg % NXCD, xcd = wgid % NXCD, off = wgid / NXCD; wgid = (xcd < r ? xcd * (q + 1) : r * (q + 1) + (xcd - r) * q) + off; }
        const int nig = WGM * nN, gid = wgid / nig, fm = gid * WGM, gsz = (nM - fm) < WGM ? (nM - fm) : WGM;
        u.pm = fm + ((wgid % nig) % gsz); u.pn = (wgid % nig) / gsz; return true;
    }
    __device__ __forceinline__ void a_ready(const Unit&) const {}
    __device__ __forceinline__ void done(const Unit&) const {}
};
__device__ __forceinline__ unsigned cvt_pk_bf16(float lo, float hi) { unsigned r; asm volatile("v_cvt_pk_bf16_f32 %0, %1, %2" : "=v"(r) : "v"(lo), "v"(hi)); return r; }
typedef float f32x2 __attribute__((ext_vector_type(2)));
__device__ __forceinline__ float silu_mul(float g, float u) { const float e = __builtin_amdgcn_exp2f(g * -1.44269504089f); return g * u * __builtin_amdgcn_rcpf(1.0f + e); }
struct EpiPlain {
    static constexpr bool PERM = true, AFTER_DRAIN = false;
    bf16_t* O; int ldc; int pn_mod; int pm_sub;
    __device__ __forceinline__ void operator()(const f32x4 (&acc)[2][2][4][2], const Unit& u, int wr, int wc, int fr, int fq) const {
        const int pn = pn_mod ? (u.pn % pn_mod) : u.pn;
        const int row0 = (u.pm - pm_sub) * BM + wr * 64 + fr, col0 = pn * BM + wc * 32 + 8 * fq;
#pragma unroll
        for (int ai = 0; ai < 2; ++ai)
#pragma unroll
            for (int m = 0; m < 4; ++m) { bf16_t* rowp = O + (size_t)(row0 + ai * HALF + m * 16) * ldc + col0;
#pragma unroll
                for (int bj = 0; bj < 2; ++bj) { const f32x4 v0 = acc[ai][bj][m][0], v1 = acc[ai][bj][m][1];
                    u32x4 w; w.x = cvt_pk_bf16(v0[0], v0[1]); w.y = cvt_pk_bf16(v0[2], v0[3]); w.z = cvt_pk_bf16(v1[0], v1[1]); w.w = cvt_pk_bf16(v1[2], v1[3]);
                    *(u32x4*)(rowp + bj * HALF) = w; } }
    }
};
struct EpiSwiGLU {
    static constexpr bool PERM = true, AFTER_DRAIN = false;
    bf16_t* O; int ldc; int pn_mod; int pm_sub;
    __device__ __forceinline__ void operator()(const f32x4 (&acc)[2][2][4][2], const Unit& u, int wr, int wc, int fr, int fq) const {
        const int pn = pn_mod ? (u.pn % pn_mod) : u.pn;
        const int row0 = (u.pm - pm_sub) * BM + wr * 64 + fr, col0 = pn * HALF + wc * 32 + 8 * fq;
#pragma unroll
        for (int ai = 0; ai < 2; ++ai)
#pragma unroll
            for (int m = 0; m < 4; ++m) { bf16_t* rowp = O + (size_t)(row0 + ai * HALF + m * 16) * ldc + col0;
                const f32x4 g0 = acc[ai][0][m][0], g1 = acc[ai][0][m][1], u0 = acc[ai][1][m][0], u1 = acc[ai][1][m][1];
                u32x4 w; w.x = cvt_pk_bf16(silu_mul(g0[0], u0[0]), silu_mul(g0[1], u0[1])); w.y = cvt_pk_bf16(silu_mul(g0[2], u0[2]), silu_mul(g0[3], u0[3]));
                w.z = cvt_pk_bf16(silu_mul(g1[0], u1[0]), silu_mul(g1[1], u1[1])); w.w = cvt_pk_bf16(silu_mul(g1[2], u1[2]), silu_mul(g1[3], u1[3]));
                *(u32x4*)rowp = w; }
    }
};
template <class Epi, class Sched, bool ALIGN_EPI = false, bool SP2 = false>
__device__ __forceinline__ void gemm_phase(PG8_LAS unsigned char* lds, const Gemm g, const Sched& S, const Epi& E) {
    const int tid = threadIdx.x, wid = __builtin_amdgcn_readfirstlane(tid >> 6), lane = tid & 63, wr = wid >> 2, wc = wid & 3, fr = lane & 15, fq = lane >> 4;
    const int K = g.K, nt = K / BK;
    unsigned voffA[2], voffB[2];
#pragma unroll
    for (int i = 0; i < 2; ++i) { int R, C; stage_rc(tid * 16 + i * 8192, R, C); const int Rb = Epi::PERM ? ((R & ~31) + perm32(R & 31)) : R;
        voffA[i] = (unsigned)(R * K + C) * 2u; voffB[i] = (unsigned)(Rb * K + C) * 2u; }
    const size_t kstep = (size_t)(BK * 2);
    const size_t hstep = (size_t)HALF * K * 2;
    const size_t tstep = 2 * hstep;
    const unsigned ldsw = (unsigned)wid * 1024u;
    const int aoff = lds_byte(wr * 64 + fr, fq * 8), boff = lds_byte(wc * 32 + fr, fq * 8);
#define PG8_SA(b, h) (((b) * 2 + (h)) * HTB)
#define PG8_SB(b, h) ((4 + (b) * 2 + (h)) * HTB)
#define PG8_STAGE(bufoff, gbase, voff) do { _Pragma("unroll") for (int _i = 0; _i < 2; ++_i) \
        __builtin_amdgcn_global_load_lds((const unsigned*)((const char*)(gbase) + (voff)[_i]), (PG8_LAS unsigned*)(lds + (bufoff) + ldsw + _i * 8192), 16, 0, 0); } while (0)
#define PG8_LDA(dst, b, h) do { _Pragma("unroll") for (int m = 0; m < 4; ++m) _Pragma("unroll") for (int k = 0; k < 2; ++k) dst[m][k] = *(const PG8_LAS bf16x8*)(lds + PG8_SA(b, h) + aoff + m * 2048 + k * 1024); } while (0)
#define PG8_LDB(dst, b, h) do { _Pragma("unroll") for (int n = 0; n < 2; ++n) _Pragma("unroll") for (int k = 0; k < 2; ++k) dst[n][k] = *(const PG8_LAS bf16x8*)(lds + PG8_SB(b, h) + boff + n * 2048 + k * 1024); } while (0)
#define PG8_MMA(ai, bj, At, Bt) do { __builtin_amdgcn_s_setprio(1); _Pragma("unroll") for (int m = 0; m < 4; ++m) _Pragma("unroll") for (int n = 0; n < 2; ++n) _Pragma("unroll") for (int k = 0; k < 2; ++k) \
        acc[ai][bj][m][n] = __builtin_amdgcn_mfma_f32_16x16x32_bf16(Bt[n][k], At[m][k], acc[ai][bj][m][n], 0, 0, 0); __builtin_amdgcn_s_setprio(0); } while (0)
#define PG8_WAIT_V(n) asm volatile("s_waitcnt vmcnt(" #n ")" ::: "memory")
#define PG8_WAIT_L(n) asm volatile("s_waitcnt lgkmcnt(" #n ")" ::: "memory")
#define PG8_BAR __builtin_amdgcn_s_barrier()
#define PG8_SCHED __builtin_amdgcn_sched_barrier(0)
    Unit cur, nxt; int ui = 0;
    if (!S.next(0, cur)) return;
    f32x4 acc[2][2][4][2];
#pragma unroll
    for (int a = 0; a < 2; ++a)
#pragma unroll
        for (int b = 0; b < 2; ++b)
#pragma unroll
            for (int m = 0; m < 4; ++m)
#pragma unroll
                for (int n = 0; n < 2; ++n) acc[a][b][m][n] = (f32x4){0.f, 0.f, 0.f, 0.f};
    bf16x8 At[4][2], B0[2][2], B1[2][2];
    const char* cA = (const char*)g.A + (size_t)cur.pm * tstep; const char* cB = (const char*)g.Bt + (size_t)cur.pn * tstep;
    S.a_ready(cur);
    if constexpr (SP2) {
        PG8_STAGE(PG8_SB(0, 0), cB, voffB); PG8_STAGE(PG8_SB(0, 1), cB + hstep, voffB); PG8_STAGE(PG8_SA(0, 0), cA, voffA); PG8_STAGE(PG8_SA(0, 1), cA + hstep, voffA);
        if (wr == 1) PG8_BAR;
        PG8_WAIT_V(2); PG8_BAR;
        PG8_STAGE(PG8_SB(1, 0), cB + kstep, voffB); PG8_STAGE(PG8_SA(1, 0), cA + kstep, voffA); PG8_STAGE(PG8_SB(1, 1), cB + hstep + kstep, voffB);
        PG8_WAIT_V(6); PG8_BAR;
    } else {
        PG8_STAGE(PG8_SB(0, 0), cB, voffB); PG8_STAGE(PG8_SA(0, 0), cA, voffA); PG8_STAGE(PG8_SB(0, 1), cB + hstep, voffB); PG8_STAGE(PG8_SA(0, 1), cA + hstep, voffA);
        if (wr == 1) PG8_BAR;
        PG8_WAIT_V(4); PG8_BAR;
        PG8_STAGE(PG8_SB(1, 0), cB + kstep, voffB); PG8_STAGE(PG8_SA(1, 0), cA + kstep, voffA); PG8_STAGE(PG8_SB(1, 1), cB + hstep + kstep, voffB);
        PG8_WAIT_V(6); PG8_BAR;
    }
    for (;;) {
        const bool has_next = S.next(ui + 1, nxt);
        const char* nA = has_next ? (const char*)g.A + (size_t)nxt.pm * tstep : cA; const char* nB = has_next ? (const char*)g.Bt + (size_t)nxt.pn * tstep : cB;
        for (int t = 0; t < nt; t += 2) {
            const bool last = (t == nt - 2);
            const char* a1 = cA + (size_t)(t + 1) * kstep;
            const char* a2 = last ? nA : cA + (size_t)(t + 2) * kstep; const char* b2 = last ? nB : cB + (size_t)(t + 2) * kstep;
            const char* a3 = a2 + kstep; const char* b3 = b2 + kstep;
            if (last && has_next) S.a_ready(nxt);
            if constexpr (SP2) {
            PG8_LDB(B0, 0, 0); PG8_LDB(B1, 0, 1); PG8_SCHED; PG8_LDA(At, 0, 0); PG8_STAGE(PG8_SA(1, 1), a1 + hstep, voffA);
            PG8_WAIT_V(8); PG8_WAIT_L(0); PG8_BAR; PG8_MMA(0, 0, At, B0); PG8_MMA(0, 1, At, B1); PG8_BAR; PG8_SCHED;
            PG8_LDA(At, 0, 1); PG8_STAGE(PG8_SB(0, 0), b2, voffB); PG8_STAGE(PG8_SB(0, 1), b2 + hstep, voffB); PG8_STAGE(PG8_SA(0, 0), a2, voffA);
            PG8_WAIT_V(8); PG8_WAIT_L(0); PG8_BAR; PG8_MMA(1, 0, At, B0); PG8_MMA(1, 1, At, B1); PG8_BAR; PG8_SCHED;
            PG8_LDB(B0, 1, 0); PG8_LDB(B1, 1, 1); PG8_SCHED; PG8_LDA(At, 1, 0); PG8_STAGE(PG8_SA(0, 1), a2 + hstep, voffA);
            PG8_WAIT_V(8); PG8_WAIT_L(0); PG8_BAR; PG8_MMA(0, 0, At, B0); PG8_MMA(0, 1, At, B1); PG8_BAR; PG8_SCHED;
            PG8_LDA(At, 1, 1); PG8_STAGE(PG8_SB(1, 0), b3, voffB); PG8_STAGE(PG8_SB(1, 1), b3 + hstep, voffB); PG8_STAGE(PG8_SA(1, 0), a3, voffA);
            PG8_WAIT_V(8); PG8_WAIT_L(0); PG8_BAR; PG8_MMA(1, 0, At, B0); PG8_MMA(1, 1, At, B1); PG8_BAR; PG8_SCHED;
            } else {
            PG8_LDB(B0, 0, 0); PG8_SCHED; PG8_LDA(At, 0, 0); PG8_STAGE(PG8_SA(1, 1), a1 + hstep, voffA);
            PG8_WAIT_L(8); PG8_BAR; PG8_WAIT_L(0); PG8_MMA(0, 0, At, B0); PG8_BAR; PG8_SCHED;
            PG8_LDB(B1, 0, 1); PG8_STAGE(PG8_SB(0, 0), b2, voffB);
            PG8_BAR; PG8_WAIT_L(0); PG8_MMA(0, 1, At, B1); PG8_BAR;
            PG8_LDA(At, 0, 1); PG8_STAGE(PG8_SA(0, 0), a2, voffA);
            PG8_BAR; PG8_WAIT_L(0); PG8_MMA(1, 0, At, B0); PG8_BAR; PG8_SCHED;
            PG8_STAGE(PG8_SB(0, 1), b2 + hstep, voffB);
            PG8_WAIT_V(6); PG8_BAR; PG8_MMA(1, 1, At, B1); PG8_BAR;
            PG8_LDB(B0, 1, 0); PG8_SCHED; PG8_LDA(At, 1, 0); PG8_STAGE(PG8_SA(0, 1), a2 + hstep, voffA);
            PG8_WAIT_L(8); PG8_BAR; PG8_WAIT_L(0); PG8_MMA(0, 0, At, B0); PG8_BAR; PG8_SCHED;
            PG8_LDB(B1, 1, 1); PG8_STAGE(PG8_SB(1, 0), b3, voffB);
            PG8_BAR; PG8_WAIT_L(0); PG8_MMA(0, 1, At, B1); PG8_BAR;
            PG8_LDA(At, 1, 1); PG8_STAGE(PG8_SA(1, 0), a3, voffA);
            PG8_BAR; PG8_WAIT_L(0); PG8_MMA(1, 0, At, B0); PG8_BAR; PG8_SCHED;
            PG8_STAGE(PG8_SB(1, 1), b3 + hstep, voffB);
            PG8_WAIT_V(6); PG8_BAR; PG8_MMA(1, 1, At, B1); PG8_BAR;
            }
        }
        if constexpr (ALIGN_EPI) { if (wr == 0) PG8_BAR; }
        if constexpr (!Epi::AFTER_DRAIN) { E(acc, cur, wr, wc, fr, fq); S.done(cur); }
        if (!has_next) break;
#pragma unroll
        for (int a = 0; a < 2; ++a)
#pragma unroll
            for (int b = 0; b < 2; ++b)
#pragma unroll
                for (int m = 0; m < 4; ++m)
#pragma unroll
                    for (int n = 0; n < 2; ++n) acc[a][b][m][n] = (f32x4){0.f, 0.f, 0.f, 0.f};
        cur = nxt; cA = nA; cB = nB; ++ui;
        if constexpr (ALIGN_EPI) { if (wr == 1) PG8_BAR; }
    }
    PG8_WAIT_V(0);
    if constexpr (!ALIGN_EPI) { if (wr == 0) PG8_BAR; }
    PG8_BAR;
    if constexpr (Epi::AFTER_DRAIN) { E.fused(acc, cur, wr, wc, fr, fq, lds, wid, lane); S.done(cur); }
#undef PG8_SA
#undef PG8_SB
#undef PG8_STAGE
#undef PG8_LDA
#undef PG8_LDB
#undef PG8_MMA
#undef PG8_WAIT_V
#undef PG8_WAIT_L
#undef PG8_BAR
#undef PG8_SCHED
}
}
#define GAS __attribute__((address_space(1)))
#define LAS __attribute__((address_space(3)))
typedef unsigned short bf16;
typedef unsigned v4u __attribute__((ext_vector_type(4)));
typedef float f32x4 __attribute__((ext_vector_type(4)));
typedef short bf16x8 __attribute__((ext_vector_type(8)));
typedef GAS unsigned gu32;
typedef GAS unsigned long long gu64;
#define RLX_AGENT __ATOMIC_RELAXED, __HIP_MEMORY_SCOPE_AGENT
#define LDS_WAIT() asm volatile("s_waitcnt lgkmcnt(0)" ::: "memory")
#define VM_WAIT() asm volatile("s_waitcnt vmcnt(0)" ::: "memory")
__device__ __forceinline__ unsigned long long rt() { return __builtin_amdgcn_s_memrealtime(); }
__device__ __forceinline__ unsigned f2bf(float f) { unsigned u = __builtin_bit_cast(unsigned, f); return (u + 0x7fffu + ((u >> 16) & 1u)) >> 16; }
__device__ __forceinline__ unsigned pk2(float lo, float hi) { return f2bf(lo) | (f2bf(hi) << 16); }

#define XB_TMO      128
#define XB_XCNT(j)  (256  + 64 * (j))
#define XB_XSUB(j)  (1280 + 64 * (j))
#define XB_XGEN(j)  (2304 + 64 * (j))
#define XB_TOP      3328
#define XB_TOPGEN   3392
#define XCD_BAR_WORDS 3456
#define XB_SPIN_CAP (1u << 18)

__device__ __forceinline__ unsigned xb_ld(unsigned* p)              { return __hip_atomic_load(p, __ATOMIC_RELAXED, __HIP_MEMORY_SCOPE_AGENT); }
__device__ __forceinline__ unsigned xb_add(unsigned* p, unsigned v) { return __hip_atomic_fetch_add(p, v, __ATOMIC_RELAXED, __HIP_MEMORY_SCOPE_AGENT); }
__device__ __forceinline__ unsigned xb_xcc_id() { return (unsigned)__builtin_amdgcn_s_getreg((3 << 11) | 20) & 0xFu; }
#define XB_SPIN(cond, bar) do { unsigned _sp = 0; while (cond) { __builtin_amdgcn_s_sleep(1); \
    if ((++_sp & 255u) == 0u) { if (xb_ld(&(bar)[XB_TMO])) break; if (_sp > XB_SPIN_CAP) { atomicAdd(&(bar)[XB_TMO], 1u); break; } } } } while (0)

struct XcdBarrier {
    unsigned* bar; unsigned x;
    volatile LAS unsigned* st;
};

__device__ __forceinline__ XcdBarrier xcd_barrier_post(unsigned* bar, volatile LAS unsigned* st) {
    XcdBarrier b; b.bar = bar; b.x = xb_xcc_id(); b.st = st;
    if (threadIdx.x == 0) (void)xb_add(&bar[XB_XCNT(b.x)], 1u);
    return b;
}
__device__ __forceinline__ void xcd_barrier_complete(unsigned* bar, unsigned x, unsigned& nloc, unsigned& nx) {
    const unsigned G = gridDim.x * gridDim.y * gridDim.z;
    unsigned sum, cnt, mine, sp = 0u;
    for (;;) {
        sum = 0u; cnt = 0u; mine = 0u;
#pragma unroll
        for (unsigned j = 0; j < 16; ++j) { const unsigned c = xb_ld(&bar[XB_XCNT(j)]); sum += c; cnt += (c > 0u) ? 1u : 0u; mine = (j == x) ? c : mine; }
        if (sum == G) break;
        __builtin_amdgcn_s_sleep(1);
        if ((++sp & 255u) == 0u) { if (xb_ld(&bar[XB_TMO])) break; if (sp > XB_SPIN_CAP) { atomicAdd(&bar[XB_TMO], 1u); break; } }
    }
    nloc = mine > 0u ? mine : 1u; nx = cnt > 0u ? cnt : 1u;
}

__device__ __forceinline__ void xcd_barrier(const XcdBarrier& b) {
    asm volatile("s_waitcnt vmcnt(0)" ::: "memory");
    __syncthreads();
    if (threadIdx.x == 0) {
        unsigned* bar = b.bar;
        __builtin_amdgcn_s_waitcnt(0);
        unsigned nloc = b.st[0], nx = b.st[1];
        if (nloc == 0u) { xcd_barrier_complete(bar, b.x, nloc, nx); b.st[0] = nloc; b.st[1] = nx; }
        const unsigned old = xb_add(&bar[XB_XSUB(b.x)], 1u);
        const unsigned gen = old / nloc;
        if (old + 1u == (gen + 1u) * nloc) {
            __builtin_amdgcn_fence(__ATOMIC_RELEASE, "agent");
            asm volatile("s_waitcnt vmcnt(0)" ::: "memory");
            const unsigned og = xb_add(&bar[XB_TOP], 1u);
            const unsigned tg = og / nx;
            if (og + 1u == (tg + 1u) * nx) xb_add(&bar[XB_TOPGEN], 1u);
            else XB_SPIN(xb_ld(&bar[XB_TOPGEN]) == tg, bar);
            __builtin_amdgcn_fence(__ATOMIC_ACQUIRE, "agent");
            xb_add(&bar[XB_XGEN(b.x)], 1u);
            asm volatile("s_waitcnt vmcnt(0)" ::: "memory");
        } else {
            XB_SPIN(xb_ld(&bar[XB_XGEN(b.x)]) == gen, bar);
            __builtin_amdgcn_fence(__ATOMIC_ACQUIRE, "agent");
            asm volatile("s_waitcnt vmcnt(0)" ::: "memory");
        }
    }
    __syncthreads();
}

constexpr int NWAVES = 8;
constexpr int BATCH = 16, SEQ = 4096, DM = 1024, MTOK = BATCH * SEQ;
constexpr int D_IN = 3584, FF0 = 2816, FF1 = 3584, NEXP = 8, NQKV = 3072;
constexpr int OFF_QSB = 0, OFF_KSB = 512, OFF_VSB = 1024, OFF_QR = 1536, OFF_KR = 2048, OFF_VR = 2560, OFF_GR = 3072;
constexpr float LN_EPS = 1e-5f, ALPHA = 1.41421356237309515f;
constexpr float LOG2E = 1.44269504088896341f, LN2 = 0.69314718055994531f;
constexpr int MOE_MAXTILES = 520, MOE_SLICE = 128, MOE_ROWS = MOE_MAXTILES * 256;

constexpr size_t MiB = 1u << 20;
constexpr size_t WS_CTL = 0, CTL_ZERO_BYTES = 1 * MiB;
constexpr size_t WS_TOKE = 1 * MiB;
constexpr size_t WS_TOKG = WS_TOKE + (size_t)MTOK * 4;
constexpr size_t WS_TOKS = WS_TOKG + (size_t)MTOK * 8;
constexpr size_t WS_PERM = WS_TOKS + (size_t)MTOK * 8;
constexpr size_t WS_WCNT = WS_PERM + (size_t)MOE_ROWS * 4;
constexpr size_t WS_TILE = WS_WCNT + 4096 * 8 * 4;
static_assert(WS_TILE + 4096 <= 4 * MiB, "misc map");
constexpr size_t WS_ROPE = 4 * MiB;
constexpr size_t WS_WIN = 5 * MiB, WS_WO0 = 12 * MiB, WS_WGU0 = 14 * MiB, WS_WDN0 = 25 * MiB, WS_WQKV = 31 * MiB, WS_WO1 = 37 * MiB, WS_WGU1 = 39 * MiB, WS_WDN1 = 151 * MiB;
constexpr size_t WS_XB = 208 * MiB;
constexpr size_t WS_O = 336 * MiB;
constexpr size_t WS_BIG = 464 * MiB;
constexpr size_t WS_H = WS_BIG, WS_HID0 = WS_BIG, WS_QKV = WS_BIG, WS_AMOE = WS_BIG;
constexpr size_t WS_MIX = WS_BIG + 352 * MiB;
constexpr size_t WS_HSL = WS_BIG + 260 * MiB;
constexpr size_t WS_END = 948 * MiB;
static_assert(WS_WDN1 + (size_t)NEXP * DM * FF1 * 2 <= WS_XB && WS_HSL + (size_t)MOE_SLICE * 256 * FF1 * 2 <= WS_END && WS_MIX + (size_t)MTOK * DM * 2 <= WS_END, "ws map");
static_assert((size_t)MOE_ROWS * DM * 2 <= 260 * MiB && (size_t)MTOK * FF0 * 2 <= 352 * MiB, "ws map 2");
constexpr int CW_BAR = 4096;
constexpr int CW_NTILES = 16384;

constexpr int RING_BYTES = 131072, LDSCTL_OFF = RING_BYTES, MISC_OFF = LDSCTL_OFF + 320, LDS_BYTES = 147456;
constexpr int TP = 144;

typedef short s16x4 __attribute__((ext_vector_type(4)));
typedef float f32x16 __attribute__((ext_vector_type(16)));
typedef unsigned u32x2 __attribute__((ext_vector_type(2)));
typedef float f32x2 __attribute__((ext_vector_type(2)));
typedef __bf16 bf16x2_t __attribute__((ext_vector_type(2)));
typedef int i32x2 __attribute__((ext_vector_type(2)));
typedef int i32x4 __attribute__((ext_vector_type(4)));

__device__ __forceinline__ unsigned cvtpk(float lo, float hi) { f32x2 v = {lo, hi}; bf16x2_t b = __builtin_convertvector(v, bf16x2_t); return __builtin_bit_cast(unsigned, b); }
__device__ __forceinline__ float bflo(unsigned w) { return __uint_as_float(w << 16); }
__device__ __forceinline__ float bfhi(unsigned w) { return __uint_as_float(w & 0xffff0000u); }
__device__ __forceinline__ float bfel(const v4u& a, int e) { const unsigned w = a[e >> 1]; return (e & 1) ? bfhi(w) : bflo(w); }
__device__ __forceinline__ int crow(int r, int hi) { return (r & 3) + 8 * (r >> 2) + 4 * hi; }
__device__ __forceinline__ float ex2(float x) { return __builtin_amdgcn_exp2f(x); }
__device__ __forceinline__ float lg2(float x) { return __builtin_amdgcn_logf(x); }
__device__ __forceinline__ f32x16 mfma32(bf16x8 x, bf16x8 y, f32x16 c) { return __builtin_amdgcn_mfma_f32_32x32x16_bf16(x, y, c, 0, 0, 0); }
__device__ __forceinline__ float wave_sum(float v) {
#pragma unroll
    for (int o = 1; o < 64; o <<= 1) v += __shfl_xor(v, o);
    return v;
}
typedef short v4i16_t __attribute__((ext_vector_type(4)));
__device__ __forceinline__ s16x4 trrd(const LAS unsigned char* p) { return __builtin_bit_cast(s16x4, __builtin_amdgcn_ds_read_tr16_b64_v4i16((LAS v4i16_t*)p)); }
__device__ __forceinline__ bf16x8 row_frag(const LAS unsigned char* tile, int r32, int hi, int dk) { return *(const LAS bf16x8*)(tile + r32 * TP + (16 * dk + 8 * hi) * 2); }
__device__ __forceinline__ bf16x8 tr_frag(const LAS unsigned char* tile, int rowA, int rowB, int cb, int lane) {
    const int q = (lane & 15) >> 2, p = lane & 3, blk = (lane >> 4) & 1;
    const int co = cb * 64 + blk * 32 + p * 8;
    const s16x4 lo = trrd(tile + (rowA + q) * TP + co), hi4 = trrd(tile + (rowB + q) * TP + co);
    return (bf16x8){lo[0], lo[1], lo[2], lo[3], hi4[0], hi4[1], hi4[2], hi4[3]};
}
__device__ __forceinline__ void load_tile32(const bf16* g, size_t ldg, LAS unsigned char* tile, int lane) {
#pragma unroll
    for (int i = 0; i < 4; ++i) { const int id = i * 64 + lane, row = id >> 3, ch = id & 7;
        const v4u v = *(const GAS v4u*)(g + (size_t)row * ldg + ch * 8); *(LAS v4u*)(tile + row * TP + ch * 16) = v; }
}
template <bool DECAY>
__device__ __forceinline__ void load_tile32_rot(const bf16* g, size_t ldg, const float* rope, int pos0, int j0, float l2g, LAS unsigned char* tile, int lane) {
#pragma unroll
    for (int i = 0; i < 2; ++i) { const int id = i * 64 + lane, row = id >> 2, ch = id & 3;
        const v4u a = *(const GAS v4u*)(g + (size_t)row * ldg + ch * 8), bq = *(const GAS v4u*)(g + (size_t)row * ldg + 32 + ch * 8);
        const float* rp = rope + (size_t)(pos0 + row) * 64 + ch * 8;
        const f32x4 c0 = *(const GAS f32x4*)rp, c1 = *(const GAS f32x4*)(rp + 4), s0 = *(const GAS f32x4*)(rp + 32), s1 = *(const GAS f32x4*)(rp + 36);
        const float sc = DECAY ? ex2((float)(63 - (j0 + row)) * l2g) : 1.0f;
        float o1[8], o2[8];
#pragma unroll
        for (int e = 0; e < 8; ++e) { const float x1 = bfel(a, e), x2 = bfel(bq, e), c = e < 4 ? c0[e & 3] : c1[e & 3], s = e < 4 ? s0[e & 3] : s1[e & 3];
            o1[e] = (x1 * c - x2 * s) * sc; o2[e] = (x1 * s + x2 * c) * sc; }
        v4u w1, w2;
#pragma unroll
        for (int e = 0; e < 4; ++e) { w1[e] = cvtpk(o1[2 * e], o1[2 * e + 1]); w2[e] = cvtpk(o2[2 * e], o2[2 * e + 1]); }
        *(LAS v4u*)(tile + row * TP + ch * 16) = w1; *(LAS v4u*)(tile + row * TP + 64 + ch * 16) = w2; }
}
__device__ __forceinline__ bf16x8 pack8(const float* w) { v4u t; t.x = cvtpk(w[0], w[1]); t.y = cvtpk(w[2], w[3]); t.z = cvtpk(w[4], w[5]); t.w = cvtpk(w[6], w[7]); return __builtin_bit_cast(bf16x8, t); }

struct Ctx { LAS unsigned char* lds; int tid, lane, wave, vcu, G, gw, NGW; };

__device__ __forceinline__ void p0_transpose_item(const float* W, int K, int N, bf16* WT, int rs128, int radd, LAS float* scr, int item, int lane) {
    const int nblk = N / 32, kb = item / nblk, nb = item % nblk, k0 = 64 * kb, n0 = 32 * nb;
    const int drow0 = (n0 >> 7) * rs128 + (n0 & 127) + radd;
#pragma unroll 8
    for (int i = 0; i < 32; ++i) { const int kk = 2 * i + (lane >> 5); scr[kk * 33 + (lane & 31)] = W[(size_t)(k0 + kk) * N + n0 + (lane & 31)]; }
    LDS_WAIT(); asm volatile("" ::: "memory");
    const int c = lane & 7;
#pragma unroll
    for (int j = 0; j < 4; ++j) { const int n = (lane >> 3) + 8 * j; const LAS float* s = scr + (8 * c) * 33 + n;
        v4u o; o.x = cvtpk(s[0 * 33], s[1 * 33]); o.y = cvtpk(s[2 * 33], s[3 * 33]); o.z = cvtpk(s[4 * 33], s[5 * 33]); o.w = cvtpk(s[6 * 33], s[7 * 33]);
        *(GAS v4u*)(WT + (size_t)(drow0 + n) * K + k0 + 8 * c) = o; }
    LDS_WAIT(); asm volatile("" ::: "memory");
}
__device__ __forceinline__ void p0_prologue(const Ctx& C, const float* const* in, unsigned char* ws) {
    LAS float* scr = (LAS float*)(C.lds + C.wave * 16384);
    constexpr int I_WIN = 16 * (D_IN / 32), I_WO = 16 * 32, I_G0 = 16 * (FF0 / 32), I_D0 = (FF0 / 64) * 32, I_QKV = 16 * (NQKV / 32), I_ME = 16 * (FF1 / 32), I_MD = (FF1 / 64) * 32;
    static_assert(I_ME == 1792 && I_MD == 1792, "moe items");
    constexpr int NITEMS = I_WIN + I_WO + 2 * I_G0 + I_D0 + I_QKV + I_WO + NEXP * (2 * I_ME + I_MD);
    for (int it = C.gw; it < NITEMS; it += C.NGW) {
        int r = it;
        if (r < I_WIN) { p0_transpose_item(in[3], DM, D_IN, (bf16*)(ws + WS_WIN), 128, 0, scr, r, C.lane); continue; } r -= I_WIN;
        if (r < I_WO) { p0_transpose_item(in[5], DM, DM, (bf16*)(ws + WS_WO0), 128, 0, scr, r, C.lane); continue; } r -= I_WO;
        if (r < I_G0) { p0_transpose_item(in[8], DM, FF0, (bf16*)(ws + WS_WGU0), 256, 0, scr, r, C.lane); continue; } r -= I_G0;
        if (r < I_G0) { p0_transpose_item(in[9], DM, FF0, (bf16*)(ws + WS_WGU0), 256, 128, scr, r, C.lane); continue; } r -= I_G0;
        if (r < I_D0) { p0_transpose_item(in[10], FF0, DM, (bf16*)(ws + WS_WDN0), 128, 0, scr, r, C.lane); continue; } r -= I_D0;
        if (r < I_QKV) { p0_transpose_item(in[13], DM, NQKV, (bf16*)(ws + WS_WQKV), 128, 0, scr, r, C.lane); continue; } r -= I_QKV;
        if (r < I_WO) { p0_transpose_item(in[15], DM, DM, (bf16*)(ws + WS_WO1), 128, 0, scr, r, C.lane); continue; } r -= I_WO;
        if (r < NEXP * I_ME) { const int e = r / I_ME; p0_transpose_item(in[20] + (size_t)e * DM * FF1, DM, FF1, (bf16*)(ws + WS_WGU1) + (size_t)e * 2 * FF1 * DM, 256, 0, scr, r % I_ME, C.lane); continue; } r -= NEXP * I_ME;
        if (r < NEXP * I_ME) { const int e = r / I_ME; p0_transpose_item(in[21] + (size_t)e * DM * FF1, DM, FF1, (bf16*)(ws + WS_WGU1) + (size_t)e * 2 * FF1 * DM, 256, 128, scr, r % I_ME, C.lane); continue; } r -= NEXP * I_ME;
        { const int e = r / I_MD; p0_transpose_item(in[22] + (size_t)e * FF1 * DM, FF1, DM, (bf16*)(ws + WS_WDN1) + (size_t)e * DM * FF1, 128, 0, scr, r % I_MD, C.lane); }
    }
    { const float* x = in[0]; bf16* xb = (bf16*)(ws + WS_XB); const size_t n8 = (size_t)MTOK * DM / 8;
      for (size_t i = (size_t)C.gw * 64 + C.lane; i < n8; i += (size_t)C.NGW * 64) {
          const f32x4 a = *(const GAS f32x4*)(x + 8 * i), b = *(const GAS f32x4*)(x + 8 * i + 4);
          v4u o; o.x = cvtpk(a[0], a[1]); o.y = cvtpk(a[2], a[3]); o.z = cvtpk(b[0], b[1]); o.w = cvtpk(b[2], b[3]); *(GAS v4u*)(xb + 8 * i) = o; } }
    { float* rope = (float*)(ws + WS_ROPE);
      for (int idx = C.gw * 64 + C.lane; idx < SEQ * 32; idx += C.NGW * 64) { const int pos = idx >> 5, i = idx & 31;
          double f = 1.0; for (int k = 0; k < i; ++k) f *= 0.74989420933245582;
          const float invf = (float)f, ang = (float)pos * invf;
          double rev = (double)ang * 0.15915494309189535; rev -= __builtin_rint(rev);
          rope[pos * 64 + i] = __builtin_amdgcn_cosf((float)rev); rope[pos * 64 + 32 + i] = __builtin_amdgcn_sinf((float)rev); } }
}

template <int MODE>
__device__ __forceinline__ void ln_phase(const Ctx& C, const float* xprev, const bf16* fsrc, const float* gam, const float* bet, float* xout, bf16* xb,
                                         const float* w_router, const float* b_router, unsigned char* ws) {
    const int lane = C.lane;
    LAS float* wrT = (LAS float*)C.lds;
    if (MODE == 1) {
        for (int idx = C.tid; idx < DM * NEXP; idx += NWAVES * 64) { const int d = idx >> 3, e = idx & 7; wrT[e * DM + d] = w_router[idx]; }
        int* perm = (int*)(ws + WS_PERM);
        for (int idx = C.gw * 64 + lane; idx < MOE_ROWS; idx += C.NGW * 64) perm[idx] = -1;
        __syncthreads();
    }
    f32x4 gv[4], bv[4];
#pragma unroll
    for (int j = 0; j < 4; ++j) { gv[j] = ((const GAS f32x4*)gam)[lane + 64 * j]; bv[j] = ((const GAS f32x4*)bet)[lane + 64 * j]; }
    int cnt0 = 0, cnt1 = 0, cnt2 = 0, cnt3 = 0, cnt4 = 0, cnt5 = 0, cnt6 = 0, cnt7 = 0;
    for (int row = C.gw; row < MTOK; row += C.NGW) {
        const GAS f32x4* xr = (const GAS f32x4*)(xprev + (size_t)row * DM) + lane;
        f32x4 v[4];
        if (MODE == 2) {
            const i32x2 sl = *(const GAS i32x2*)(ws + WS_TOKS + (size_t)row * 8); const f32x2 gt = *(const GAS f32x2*)(ws + WS_TOKG + (size_t)row * 8);
            const GAS u32x2* y1 = (const GAS u32x2*)(fsrc + (size_t)sl.x * DM) + lane; const GAS u32x2* y2 = (const GAS u32x2*)(fsrc + (size_t)sl.y * DM) + lane;
#pragma unroll
            for (int j = 0; j < 4; ++j) { const u32x2 a = y1[64 * j], b = y2[64 * j]; const f32x4 xv = xr[64 * j];
                v[j][0] = xv[0] * ALPHA + (gt.x * bflo(a.x) + gt.y * bflo(b.x)); v[j][1] = xv[1] * ALPHA + (gt.x * bfhi(a.x) + gt.y * bfhi(b.x));
                v[j][2] = xv[2] * ALPHA + (gt.x * bflo(a.y) + gt.y * bflo(b.y)); v[j][3] = xv[3] * ALPHA + (gt.x * bfhi(a.y) + gt.y * bfhi(b.y)); }
        } else {
            const GAS u32x2* mr = (const GAS u32x2*)(fsrc + (size_t)row * DM) + lane;
#pragma unroll
            for (int j = 0; j < 4; ++j) { const u32x2 a = mr[64 * j]; const f32x4 xv = xr[64 * j];
                v[j][0] = xv[0] * ALPHA + bflo(a.x); v[j][1] = xv[1] * ALPHA + bfhi(a.x); v[j][2] = xv[2] * ALPHA + bflo(a.y); v[j][3] = xv[3] * ALPHA + bfhi(a.y); }
        }
        float s = 0.f;
#pragma unroll
        for (int j = 0; j < 4; ++j) s += (v[j][0] + v[j][1]) + (v[j][2] + v[j][3]);
        const float mean = wave_sum(s) * (1.0f / DM); float s2 = 0.f;
#pragma unroll
        for (int j = 0; j < 4; ++j) { v[j] = v[j] - mean; s2 += (v[j][0] * v[j][0] + v[j][1] * v[j][1]) + (v[j][2] * v[j][2] + v[j][3] * v[j][3]); }
        const float rstd = 1.0f / sqrtf(wave_sum(s2) * (1.0f / DM) + LN_EPS);
        GAS f32x4* xo = (GAS f32x4*)(xout + (size_t)row * DM) + lane;
#pragma unroll
        for (int j = 0; j < 4; ++j) { v[j] = v[j] * rstd * gv[j] + bv[j]; xo[64 * j] = v[j]; }
        if (MODE != 2) { GAS u32x2* bo = (GAS u32x2*)(xb + (size_t)row * DM) + lane;
#pragma unroll
            for (int j = 0; j < 4; ++j) { u32x2 w; w.x = cvtpk(v[j][0], v[j][1]); w.y = cvtpk(v[j][2], v[j][3]); bo[64 * j] = w; } }
        if (MODE == 1) {
            float lg[8];
#pragma unroll
            for (int e = 0; e < 8; ++e) { float a = 0.f;
#pragma unroll
                for (int j = 0; j < 4; ++j) { const f32x4 w = *(const LAS f32x4*)(wrT + e * DM + 4 * lane + 256 * j); a += (v[j][0] * w[0] + v[j][1] * w[1]) + (v[j][2] * w[2] + v[j][3] * w[3]); }
                lg[e] = wave_sum(a) + b_router[e]; }
            int e1 = 0; float v1 = lg[0];
#pragma unroll
            for (int e = 1; e < 8; ++e) if (lg[e] > v1) { v1 = lg[e]; e1 = e; }
            int e2 = -1; float v2 = -3.0e38f;
#pragma unroll
            for (int e = 0; e < 8; ++e) if (e != e1 && lg[e] > v2) { v2 = lg[e]; e2 = e; }
            const float g1 = 1.0f / (1.0f + __expf(v2 - v1)), g2 = 1.0f - g1;
            if (lane == 0) { *(GAS int*)(ws + WS_TOKE + (size_t)row * 4) = e1 | (e2 << 8); *(GAS f32x2*)(ws + WS_TOKG + (size_t)row * 8) = (f32x2){g1, g2}; }
            cnt0 += (e1 == 0) + (e2 == 0); cnt1 += (e1 == 1) + (e2 == 1); cnt2 += (e1 == 2) + (e2 == 2); cnt3 += (e1 == 3) + (e2 == 3);
            cnt4 += (e1 == 4) + (e2 == 4); cnt5 += (e1 == 5) + (e2 == 5); cnt6 += (e1 == 6) + (e2 == 6); cnt7 += (e1 == 7) + (e2 == 7);
        }
    }
    if (MODE == 1) {
        int myc = cnt0; myc = lane == 1 ? cnt1 : myc; myc = lane == 2 ? cnt2 : myc; myc = lane == 3 ? cnt3 : myc; myc = lane == 4 ? cnt4 : myc; myc = lane == 5 ? cnt5 : myc; myc = lane == 6 ? cnt6 : myc; myc = lane == 7 ? cnt7 : myc;
        if (lane < 8) *(GAS int*)(ws + WS_WCNT + ((size_t)C.gw * 8 + lane) * 4) = myc;
    }
}

__device__ __forceinline__ void moe_assign(const Ctx& C, unsigned char* ws, gu32* ctl) {
    const int lane = C.lane;
    const GAS int* wcnt = (const GAS int*)(ws + WS_WCNT);
    int tot[8], pre[8];
#pragma unroll
    for (int e = 0; e < 8; ++e) { tot[e] = 0; pre[e] = 0; }
    for (int w = lane; w < C.NGW; w += 64) { const i32x4 a = *(const GAS i32x4*)(wcnt + w * 8), b = *(const GAS i32x4*)(wcnt + w * 8 + 4); const bool lo = w < C.gw;
        tot[0] += a.x; tot[1] += a.y; tot[2] += a.z; tot[3] += a.w; tot[4] += b.x; tot[5] += b.y; tot[6] += b.z; tot[7] += b.w;
        if (lo) { pre[0] += a.x; pre[1] += a.y; pre[2] += a.z; pre[3] += a.w; pre[4] += b.x; pre[5] += b.y; pre[6] += b.z; pre[7] += b.w; } }
    int off[9]; off[0] = 0;
#pragma unroll
    for (int e = 0; e < 8; ++e) {
#pragma unroll
        for (int o = 1; o < 64; o <<= 1) { tot[e] += __shfl_xor(tot[e], o); pre[e] += __shfl_xor(pre[e], o); }
        off[e + 1] = off[e] + ((tot[e] + 255) & ~255); }
    const GAS int* toke = (const GAS int*)(ws + WS_TOKE); GAS int* perm = (GAS int*)(ws + WS_PERM);
    int base[8];
#pragma unroll
    for (int e = 0; e < 8; ++e) base[e] = off[e] + pre[e];
    for (int i0 = 0; C.gw + i0 * C.NGW < MTOK; i0 += 64) {
        const int row = C.gw + (i0 + lane) * C.NGW; const bool live = row < MTOK;
        const int ee = live ? toke[row] : 0xffff; const int e1 = ee & 0xff, e2 = (ee >> 8) & 0xff;
        int s1 = 0, s2 = 0; const unsigned long long lower = (1ull << lane) - 1ull;
#pragma unroll
        for (int e = 0; e < 8; ++e) { const unsigned long long m1 = __ballot(live && e1 == e), m2 = __ballot(live && e2 == e);
            const int rank = __popcll(m1 & lower) + __popcll(m2 & lower);
            if (e1 == e) s1 = base[e] + rank; if (e2 == e) s2 = base[e] + rank;
            base[e] += __popcll(m1) + __popcll(m2); }
        if (live) { perm[s1] = row; perm[s2] = row; *(GAS i32x2*)(ws + WS_TOKS + (size_t)row * 8) = (i32x2){s1, s2}; }
    }
    if (C.gw == 0) {
        const int ntile = off[8] >> 8;
        for (int t = lane; t < 1024; t += 64) { int e = 0;
#pragma unroll
            for (int k = 1; k < 8; ++k) e += (t * 256 >= off[k]) ? 1 : 0;
            __hip_atomic_store((gu32*)(ws + WS_TILE) + t, (unsigned)(t < ntile ? e : 0), RLX_AGENT); }
        if (lane == 0) __hip_atomic_store(ctl + CW_NTILES, (unsigned)ntile, RLX_AGENT);
    }
}
__device__ __forceinline__ void moe_gather(const Ctx& C, unsigned char* ws, int ntile) {
    const GAS int* perm = (const GAS int*)(ws + WS_PERM); const bf16* xb = (const bf16*)(ws + WS_XB); bf16* A = (bf16*)(ws + WS_AMOE);
    for (int s = C.gw; s < ntile * 256; s += C.NGW) { const int row = perm[s];
        v4u a = {0u, 0u, 0u, 0u}, b = {0u, 0u, 0u, 0u};
        if (row >= 0) { const GAS v4u* src = (const GAS v4u*)(xb + (size_t)row * DM) + C.lane; a = src[0]; b = src[64]; }
        GAS v4u* dst = (GAS v4u*)(A + (size_t)s * DM) + C.lane; dst[0] = a; dst[64] = b; }
}
struct MoeOrder {
    int nM, nN, nwg, G, c, t0; const gu32* tile_expert;
    __device__ __forceinline__ void init(int t0_, int nT, int nN_, int G_, int c_, const gu32* te) { t0 = t0_; nM = nT; nN = nN_; nwg = nM * nN; G = G_; c = c_; tile_expert = te; }
    __device__ __forceinline__ bool next(int i, pg8::Unit& u) const {
        const long L = (long)i * G + c; if (L >= nwg) return false;
        int wgid = (int)L; { const int q = nwg / pg8::NXCD, r = nwg % pg8::NXCD, xcd = wgid % pg8::NXCD, off = wgid / pg8::NXCD; wgid = (xcd < r ? xcd * (q + 1) : r * (q + 1) + (xcd - r) * q) + off; }
        const int nig = pg8::WGM * nN, gid = wgid / nig, fm = gid * pg8::WGM, gsz = (nM - fm) < pg8::WGM ? (nM - fm) : pg8::WGM;
        const int pm = t0 + fm + ((wgid % nig) % gsz), pn = (wgid % nig) / gsz;
        const int e = (int)__builtin_amdgcn_readfirstlane(__hip_atomic_load(tile_expert + pm, RLX_AGENT));
        u.pm = pm; u.pn = e * nN + pn; return true;
    }
    __device__ __forceinline__ void a_ready(const pg8::Unit&) const {}
    __device__ __forceinline__ void done(const pg8::Unit&) const {}
};

__device__ __forceinline__ void sb_phase(const Ctx& C, const bf16* H, bf16* O) {
    LAS unsigned char* wl = C.lds + C.wave * 16384; LAS unsigned char* Kt = wl; LAS unsigned char* Vt = wl + 4608; LAS unsigned char* stg = wl + 9216;
    const int lane = C.lane, r32 = lane & 31, hi = lane >> 5;
    for (int u = C.gw; u < BATCH * 8 * 128; u += C.NGW) {
        const int qt = u & 127, h = (u >> 7) & 7, b = u >> 10;
        const bf16* Hb = H + (size_t)b * SEQ * D_IN + h * 64;
        bf16x8 qf[4];
#pragma unroll
        for (int dk = 0; dk < 4; ++dk) qf[dk] = *(const GAS bf16x8*)(Hb + (size_t)(qt * 32 + r32) * D_IN + OFF_QSB + 16 * dk + 8 * hi);
        float R = 0.f; f32x16 oacc[2]; oacc[0] = f32x16{}; oacc[1] = f32x16{};
        for (int kt = qt; kt >= 0; --kt) {
            load_tile32(Hb + (size_t)(kt * 32) * D_IN + OFF_KSB, D_IN, Kt, lane); load_tile32(Hb + (size_t)(kt * 32) * D_IN + OFF_VSB, D_IN, Vt, lane);
            f32x16 acc = f32x16{};
#pragma unroll
            for (int dk = 0; dk < 4; ++dk) acc = mfma32(row_frag(Kt, r32, hi, dk), qf[dk], acc);
            const bool diag = (kt == qt);
            float z[16], lgv[16]; bool valid[16];
#pragma unroll
            for (int r = 0; r < 16; ++r) { z[r] = acc[r] * 0.125f; valid[r] = !diag || (crow(r, hi) < r32);
                const float e = ex2(-fabsf(z[r]) * LOG2E); const float sp = fmaxf(z[r], 0.f) + LN2 * lg2(1.0f + e); lgv[r] = valid[r] ? -sp : 0.f; }
            float G[4], PG[4], T[4];
#pragma unroll
            for (int g = 0; g < 4; ++g) { G[g] = (lgv[4 * g] + lgv[4 * g + 1]) + (lgv[4 * g + 2] + lgv[4 * g + 3]); PG[g] = __shfl_xor(G[g], 32); T[g] = G[g] + PG[g]; }
            float above[4]; above[3] = 0.f; above[2] = T[3]; above[1] = T[3] + T[2]; above[0] = T[3] + T[2] + T[1];
            float w[16];
#pragma unroll
            for (int g = 0; g < 4; ++g) { const float base = R + above[g] + (hi == 0 ? PG[g] : 0.f);
                float inc = 0.f;
#pragma unroll
                for (int i = 3; i >= 0; --i) { const int r = 4 * g + i; inc += lgv[r]; w[r] = valid[r] ? ex2((z[r] + base + inc) * LOG2E) : 0.f; } }
            R += (T[0] + T[1]) + (T[2] + T[3]);
            const bf16x8 pf0 = pack8(w), pf1 = pack8(w + 8);
#pragma unroll
            for (int db = 0; db < 2; ++db) {
                oacc[db] = mfma32(tr_frag(Vt, 4 * hi, 8 + 4 * hi, db, lane), pf0, oacc[db]);
                oacc[db] = mfma32(tr_frag(Vt, 16 + 4 * hi, 24 + 4 * hi, db, lane), pf1, oacc[db]); }
            if (__all(R < -88.0f)) break;
        }
#pragma unroll
        for (int db = 0; db < 2; ++db)
#pragma unroll
            for (int r = 0; r < 16; ++r) *(LAS unsigned short*)(stg + r32 * TP + (db * 32 + crow(r, hi)) * 2) = (unsigned short)cvtpk(oacc[db][r], 0.f);
#pragma unroll
        for (int i = 0; i < 4; ++i) { const int row = i * 8 + (lane >> 3), ch = lane & 7; const v4u v = *(const LAS v4u*)(stg + row * TP + ch * 16);
            *(GAS v4u*)(O + (size_t)(b * SEQ + qt * 32 + row) * DM + h * 64 + ch * 8) = v; }
    }
}

__device__ __forceinline__ void ret_kv_phase(const Ctx& C, const bf16* H, const float* rope, float* KV) {
    LAS unsigned char* wl = C.lds + C.wave * 16384; LAS unsigned char* Kt = wl; LAS unsigned char* Vt = wl + 4608;
    const int lane = C.lane, r32 = lane & 31, hi = lane >> 5;
    for (int u = C.gw; u < BATCH * 8 * 64; u += C.NGW) {
        const int c = u & 63, h = (u >> 6) & 7, b = u >> 9;
        const float l2g = log1pf(-ex2((float)(-5 - h))) * LOG2E;
        const bf16* Hb = H + ((size_t)b * SEQ + c * 64) * D_IN + h * 64;
        f32x16 acc[2][2]; acc[0][0] = f32x16{}; acc[0][1] = f32x16{}; acc[1][0] = f32x16{}; acc[1][1] = f32x16{};
        for (int jh = 0; jh < 2; ++jh) {
            load_tile32_rot<true>(Hb + (size_t)(32 * jh) * D_IN + OFF_KR, D_IN, rope, c * 64 + 32 * jh, 32 * jh, l2g, Kt, lane);
            load_tile32(Hb + (size_t)(32 * jh) * D_IN + OFF_VR, D_IN, Vt, lane);
#pragma unroll
            for (int m = 0; m < 2; ++m) {
                bf16x8 kf[2], vf[2];
#pragma unroll
                for (int a = 0; a < 2; ++a) { kf[a] = tr_frag(Kt, 16 * m + 8 * hi, 16 * m + 8 * hi + 4, a, lane); vf[a] = tr_frag(Vt, 16 * m + 8 * hi, 16 * m + 8 * hi + 4, a, lane); }
#pragma unroll
                for (int a = 0; a < 2; ++a)
#pragma unroll
                    for (int b2 = 0; b2 < 2; ++b2) acc[a][b2] = mfma32(kf[a], vf[b2], acc[a][b2]);
            }
        }
        float* dst = KV + ((size_t)((b * 8 + h) * 64 + c)) * 4096;
#pragma unroll
        for (int a = 0; a < 2; ++a)
#pragma unroll
            for (int b2 = 0; b2 < 2; ++b2)
#pragma unroll
                for (int r = 0; r < 16; ++r) dst[(crow(r, hi) + 32 * a) * 64 + r32 + 32 * b2] = acc[a][b2][r];
    }
}
__device__ __forceinline__ void ret_scan_phase(const Ctx& C, float* KV) {
    for (int idx = C.gw * 64 + C.lane; idx < BATCH * 8 * 4096; idx += C.NGW * 64) {
        const int bh = idx >> 12, el = idx & 4095, h = bh & 7;
        const float dc = ex2(64.0f * log1pf(-ex2((float)(-5 - h))) * LOG2E);
        float* p = KV + (size_t)bh * 64 * 4096 + el; float st = 0.f;
        for (int c0 = 0; c0 < 64; c0 += 8) { float t[8];
#pragma unroll
            for (int k = 0; k < 8; ++k) t[k] = p[(size_t)(c0 + k) * 4096];
#pragma unroll
            for (int k = 0; k < 8; ++k) { p[(size_t)(c0 + k) * 4096] = st; st = st * dc + t[k]; } }
    }
}
__device__ __forceinline__ void ret_out_phase(const Ctx& C, const bf16* H, const float* rope, const float* KV, const float* gn_g, bf16* O) {
    LAS unsigned char* wl = C.lds + C.wave * 16384; LAS unsigned char* Kt = wl; LAS unsigned char* Vt = wl + 4608; LAS unsigned char* St = wl + 9216;
    LAS float* stf = (LAS float*)wl;
    const int lane = C.lane, r32 = lane & 31, hi = lane >> 5;
    for (int u = C.gw; u < BATCH * 8 * 64 * 2; u += C.NGW) {
        const int ih = u & 1, c = (u >> 1) & 63, h = (u >> 7) & 7, b = u >> 10;
        const float l2g = log1pf(-ex2((float)(-5 - h))) * LOG2E;
        const bf16* Hb = H + ((size_t)b * SEQ + c * 64) * D_IN + h * 64;
        const int iq = 32 * ih + r32, pos = c * 64 + iq;
        bf16x8 qf[4];
        { v4u qr[4];
#pragma unroll
          for (int dk = 0; dk < 4; ++dk) qr[dk] = *(const GAS v4u*)(Hb + (size_t)iq * D_IN + OFF_QR + 16 * dk + 8 * hi);
#pragma unroll
          for (int dk = 0; dk < 2; ++dk) { const float* rp = rope + (size_t)pos * 64 + 16 * dk + 8 * hi;
              const f32x4 c0 = *(const GAS f32x4*)rp, c1 = *(const GAS f32x4*)(rp + 4), s0 = *(const GAS f32x4*)(rp + 32), s1 = *(const GAS f32x4*)(rp + 36);
              float o1[8], o2[8];
#pragma unroll
              for (int e = 0; e < 8; ++e) { const float x1 = bfel(qr[dk], e), x2 = bfel(qr[dk + 2], e), cc = e < 4 ? c0[e & 3] : c1[e & 3], ss = e < 4 ? s0[e & 3] : s1[e & 3];
                  o1[e] = (x1 * cc - x2 * ss) * 0.125f; o2[e] = (x1 * ss + x2 * cc) * 0.125f; }
              qf[dk] = pack8(o1); qf[dk + 2] = pack8(o2); } }
        f32x16 oacc[2]; oacc[0] = f32x16{}; oacc[1] = f32x16{};
        for (int jt = 0; jt <= ih; ++jt) {
            load_tile32_rot<false>(Hb + (size_t)(32 * jt) * D_IN + OFF_KR, D_IN, rope, c * 64 + 32 * jt, 32 * jt, 0.f, Kt, lane);
            load_tile32(Hb + (size_t)(32 * jt) * D_IN + OFF_VR, D_IN, Vt, lane);
            f32x16 acc = f32x16{};
#pragma unroll
            for (int dk = 0; dk < 4; ++dk) acc = mfma32(row_frag(Kt, r32, hi, dk), qf[dk], acc);
            float w[16];
#pragma unroll
            for (int r = 0; r < 16; ++r) { const int dl = iq - (32 * jt + crow(r, hi)); w[r] = dl >= 0 ? acc[r] * ex2((float)dl * l2g) : 0.f; }
            const bf16x8 pf0 = pack8(w), pf1 = pack8(w + 8);
#pragma unroll
            for (int eb = 0; eb < 2; ++eb) {
                oacc[eb] = mfma32(tr_frag(Vt, 4 * hi, 8 + 4 * hi, eb, lane), pf0, oacc[eb]);
                oacc[eb] = mfma32(tr_frag(Vt, 16 + 4 * hi, 24 + 4 * hi, eb, lane), pf1, oacc[eb]); }
        }
        f32x16 cacc[2]; cacc[0] = f32x16{}; cacc[1] = f32x16{};
        const float* Sg = KV + ((size_t)((b * 8 + h) * 64 + c)) * 4096;
        for (int half = 0; half < 2; ++half) {
#pragma unroll
            for (int i = 0; i < 4; ++i) { const int id = i * 64 + lane, row = id >> 3, ch = id & 7;
                const f32x4 a = *(const GAS f32x4*)(Sg + (size_t)(32 * half + row) * 64 + ch * 8), bb = *(const GAS f32x4*)(Sg + (size_t)(32 * half + row) * 64 + ch * 8 + 4);
                v4u t; t.x = cvtpk(a[0], a[1]); t.y = cvtpk(a[2], a[3]); t.z = cvtpk(bb[0], bb[1]); t.w = cvtpk(bb[2], bb[3]); *(LAS v4u*)(St + row * TP + ch * 16) = t; }
#pragma unroll
            for (int m2 = 0; m2 < 2; ++m2)
#pragma unroll
                for (int eb = 0; eb < 2; ++eb) cacc[eb] = mfma32(tr_frag(St, 16 * m2 + 8 * hi, 16 * m2 + 8 * hi + 4, eb, lane), qf[2 * half + m2], cacc[eb]);
        }
        const float dq = ex2((float)(iq + 1) * l2g);
        float x[2][16]; float s = 0.f;
#pragma unroll
        for (int eb = 0; eb < 2; ++eb)
#pragma unroll
            for (int r = 0; r < 16; ++r) { x[eb][r] = oacc[eb][r] + dq * cacc[eb][r]; s += x[eb][r]; }
        s += __shfl_xor(s, 32); const float mean = s * (1.0f / 64.0f); float s2 = 0.f;
#pragma unroll
        for (int eb = 0; eb < 2; ++eb)
#pragma unroll
            for (int r = 0; r < 16; ++r) { x[eb][r] -= mean; s2 += x[eb][r] * x[eb][r]; }
        s2 += __shfl_xor(s2, 32); const float rstd = 1.0f / sqrtf(s2 * (1.0f / 64.0f) + LN_EPS);
#pragma unroll
        for (int eb = 0; eb < 2; ++eb)
#pragma unroll
            for (int r = 0; r < 16; ++r) stf[r32 * 66 + 32 * eb + crow(r, hi)] = x[eb][r] * rstd;
#pragma unroll
        for (int i = 0; i < 4; ++i) { const int row = i * 8 + (lane >> 3), ch = lane & 7;
            const v4u gq = *(const GAS v4u*)(Hb + (size_t)(32 * ih + row) * D_IN + OFF_GR + ch * 8);
            const f32x4 g0 = *(const GAS f32x4*)(gn_g + h * 64 + ch * 8), g1 = *(const GAS f32x4*)(gn_g + h * 64 + ch * 8 + 4);
            float o[8];
#pragma unroll
            for (int e = 0; e < 8; ++e) { const float gate = bfel(gq, e), nv = stf[row * 66 + ch * 8 + e], gg = e < 4 ? g0[e & 3] : g1[e & 3];
                o[e] = gate * __builtin_amdgcn_rcpf(1.0f + ex2(-gate * LOG2E)) * nv * gg; }
            v4u t; t.x = cvtpk(o[0], o[1]); t.y = cvtpk(o[2], o[3]); t.z = cvtpk(o[4], o[5]); t.w = cvtpk(o[6], o[7]);
            *(GAS v4u*)(O + (size_t)(b * SEQ + c * 64 + 32 * ih + row) * DM + 512 + h * 64 + ch * 8) = t; }
    }
}

__device__ __forceinline__ void chunk_attn_phase(const Ctx& C, const bf16* QKV, const float* rel_bias, bf16* O) {
    LAS unsigned char* wl = C.lds + C.wave * 16384; LAS unsigned char* Kt = wl; LAS unsigned char* Vt = wl + 4608; LAS unsigned char* stg = wl + 9216; LAS float* tb = (LAS float*)(wl + 13824);
    const int lane = C.lane, r32 = lane & 31, hi = lane >> 5;
    const float C1 = 0.125f * LOG2E;
    int cur_h = -1;
    for (int u = C.gw; u < BATCH * 16 * 128; u += C.NGW) {
        const int qt = u & 127, h = (u >> 7) & 15, b = u >> 11, c = qt >> 1, iq = 32 * (qt & 1) + r32;
        if (h != cur_h) { for (int i = lane; i < 513; i += 64) tb[i] = rel_bias[h * 513 + i] * LOG2E; cur_h = h; }
        const bf16* Qb = QKV + (size_t)b * SEQ * NQKV + h * 64;
        bf16x8 qf[4];
#pragma unroll
        for (int dk = 0; dk < 4; ++dk) qf[dk] = *(const GAS bf16x8*)(Qb + (size_t)(qt * 32 + r32) * NQKV + 16 * dk + 8 * hi);
        float m = -1.0e30f, l = 0.f; f32x16 oacc[2]; oacc[0] = f32x16{}; oacc[1] = f32x16{};
        const int kc0 = c - 8 < 0 ? 0 : c - 8;
        for (int kt = 2 * kc0; kt <= 2 * c + 1; ++kt) {
            const int kc = kt >> 1;
            load_tile32(Qb + (size_t)(kt * 32) * NQKV + 1024, NQKV, Kt, lane); load_tile32(Qb + (size_t)(kt * 32) * NQKV + 2048, NQKV, Vt, lane);
            f32x16 acc = f32x16{};
#pragma unroll
            for (int dk = 0; dk < 4; ++dk) acc = mfma32(row_frag(Kt, r32, hi, dk), qf[dk], acc);
            float sv[16];
            if (c - kc >= 5) { const float bc = tb[512];
#pragma unroll
                for (int r = 0; r < 16; ++r) sv[r] = acc[r] * C1 + bc;
            } else { const int dl = 64 * (c - kc) + iq - 32 * (kt & 1);
#pragma unroll
                for (int r = 0; r < 16; ++r) { int rel = dl - crow(r, hi); rel = rel > 256 ? 256 : rel; rel = rel < -256 ? -256 : rel; sv[r] = acc[r] * C1 + tb[rel + 256]; } }
            float tm = sv[0];
#pragma unroll
            for (int r = 1; r < 16; ++r) tm = fmaxf(tm, sv[r]);
            tm = fmaxf(tm, __shfl_xor(tm, 32));
            const float mn = fmaxf(m, tm), al = ex2(m - mn); m = mn;
            float ps = 0.f, w[16];
#pragma unroll
            for (int r = 0; r < 16; ++r) { w[r] = ex2(sv[r] - mn); ps += w[r]; }
            l = l * al + ps;
#pragma unroll
            for (int r = 0; r < 16; ++r) { oacc[0][r] *= al; oacc[1][r] *= al; }
            const bf16x8 pf0 = pack8(w), pf1 = pack8(w + 8);
#pragma unroll
            for (int db = 0; db < 2; ++db) {
                oacc[db] = mfma32(tr_frag(Vt, 4 * hi, 8 + 4 * hi, db, lane), pf0, oacc[db]);
                oacc[db] = mfma32(tr_frag(Vt, 16 + 4 * hi, 24 + 4 * hi, db, lane), pf1, oacc[db]); }
        }
        l += __shfl_xor(l, 32); const float inv = 1.0f / l;
#pragma unroll
        for (int db = 0; db < 2; ++db)
#pragma unroll
            for (int r = 0; r < 16; ++r) *(LAS unsigned short*)(stg + r32 * TP + (db * 32 + crow(r, hi)) * 2) = (unsigned short)cvtpk(oacc[db][r] * inv, 0.f);
#pragma unroll
        for (int i = 0; i < 4; ++i) { const int row = i * 8 + (lane >> 3), ch = lane & 7; const v4u v = *(const LAS v4u*)(stg + row * TP + ch * 16);
            *(GAS v4u*)(O + (size_t)(b * SEQ + qt * 32 + row) * DM + h * 64 + ch * 8) = v; }
    }
}

struct Params { const float* in[23]; float* out; unsigned char* ws; };
__global__ void __launch_bounds__(NWAVES * 64, 2) fwd_kernel(Params p) {
    extern __shared__ __attribute__((aligned(16))) unsigned char lds_raw[];
    Ctx C;
    C.lds = (LAS unsigned char*)lds_raw; C.tid = threadIdx.x; C.lane = C.tid & 63; C.wave = __builtin_amdgcn_readfirstlane(C.tid >> 6);
    C.G = gridDim.x; { const int bx = blockIdx.x; C.vcu = (C.G % 8 == 0) ? (bx % 8) * (C.G / 8) + bx / 8 : bx; }
    C.gw = C.vcu * NWAVES + C.wave; C.NGW = C.G * NWAVES;
    unsigned char* ws = p.ws; gu32* ctl = (gu32*)(ws + WS_CTL);
    volatile LAS unsigned* MISC = (volatile LAS unsigned*)(C.lds + MISC_OFF);
    for (int u = C.tid; u < (LDS_BYTES - LDSCTL_OFF) / 4; u += NWAVES * 64) ((LAS unsigned*)(C.lds + LDSCTL_OFF))[u] = 0u;
    __syncthreads();
    XcdBarrier bar = xcd_barrier_post((unsigned*)(ctl + CW_BAR), MISC + 8);
#define GRID_BAR() xcd_barrier(bar)
    const int bx = (int)blockIdx.x;
    bf16* XB = (bf16*)(ws + WS_XB); bf16* OB = (bf16*)(ws + WS_O); bf16* MIX = (bf16*)(ws + WS_MIX);
    float* KV = (float*)(ws + WS_XB); const float* rope = (const float*)(ws + WS_ROPE);

    p0_prologue(C, p.in, ws);
    GRID_BAR();
    { pg8::Gemm g{XB, (const bf16*)(ws + WS_WIN), MTOK, D_IN, DM}; pg8::StaticOrder S; S.init(MTOK, D_IN, C.G, bx);
      pg8::EpiPlain E{(bf16*)(ws + WS_H), D_IN, 0, 0};
      pg8::gemm_phase<pg8::EpiPlain, pg8::StaticOrder, true, true>(C.lds, g, S, E); }
    GRID_BAR();
    sb_phase(C, (const bf16*)(ws + WS_H), OB);
    ret_kv_phase(C, (const bf16*)(ws + WS_H), rope, KV);
    GRID_BAR();
    ret_scan_phase(C, KV);
    GRID_BAR();
    ret_out_phase(C, (const bf16*)(ws + WS_H), rope, KV, p.in[4], OB);
    GRID_BAR();
    { pg8::Gemm g{OB, (const bf16*)(ws + WS_WO0), MTOK, DM, DM}; pg8::StaticOrder S; S.init(MTOK, DM, C.G, bx);
      pg8::EpiPlain E{MIX, DM, 0, 0};
      pg8::gemm_phase<pg8::EpiPlain, pg8::StaticOrder, true, true>(C.lds, g, S, E); }
    GRID_BAR();
    ln_phase<0>(C, p.in[0], MIX, p.in[1], p.in[2], p.out, XB, nullptr, nullptr, ws);
    GRID_BAR();
    { pg8::Gemm g{XB, (const bf16*)(ws + WS_WGU0), MTOK, 2 * FF0, DM}; pg8::StaticOrder S; S.init(MTOK, 2 * FF0, C.G, bx);
      pg8::EpiSwiGLU E{(bf16*)(ws + WS_HID0), FF0, 0, 0};
      pg8::gemm_phase<pg8::EpiSwiGLU, pg8::StaticOrder, true, true>(C.lds, g, S, E); }
    GRID_BAR();
    { pg8::Gemm g{(const bf16*)(ws + WS_HID0), (const bf16*)(ws + WS_WDN0), MTOK, DM, FF0}; pg8::StaticOrder S; S.init(MTOK, DM, C.G, bx);
      pg8::EpiPlain E{MIX, DM, 0, 0};
      pg8::gemm_phase<pg8::EpiPlain, pg8::StaticOrder, true, true>(C.lds, g, S, E); }
    GRID_BAR();
    ln_phase<0>(C, p.out, MIX, p.in[6], p.in[7], p.out, XB, nullptr, nullptr, ws);
    GRID_BAR();
    { pg8::Gemm g{XB, (const bf16*)(ws + WS_WQKV), MTOK, NQKV, DM}; pg8::StaticOrder S; S.init(MTOK, NQKV, C.G, bx);
      pg8::EpiPlain E{(bf16*)(ws + WS_QKV), NQKV, 0, 0};
      pg8::gemm_phase<pg8::EpiPlain, pg8::StaticOrder, true, true>(C.lds, g, S, E); }
    GRID_BAR();
    chunk_attn_phase(C, (const bf16*)(ws + WS_QKV), p.in[14], OB);
    GRID_BAR();
    { pg8::Gemm g{OB, (const bf16*)(ws + WS_WO1), MTOK, DM, DM}; pg8::StaticOrder S; S.init(MTOK, DM, C.G, bx);
      pg8::EpiPlain E{MIX, DM, 0, 0};
      pg8::gemm_phase<pg8::EpiPlain, pg8::StaticOrder, true, true>(C.lds, g, S, E); }
    GRID_BAR();
    ln_phase<1>(C, p.out, MIX, p.in[11], p.in[12], p.out, XB, p.in[18], p.in[19], ws);
    GRID_BAR();
    moe_assign(C, ws, ctl);
    GRID_BAR();
    const int ntile = (int)__builtin_amdgcn_readfirstlane(__hip_atomic_load(ctl + CW_NTILES, RLX_AGENT));
    moe_gather(C, ws, ntile);
    GRID_BAR();
    for (int t0 = 0; t0 < ntile; t0 += MOE_SLICE) {
        const int nT = (ntile - t0) < MOE_SLICE ? (ntile - t0) : MOE_SLICE;
        { pg8::Gemm g{(const bf16*)(ws + WS_AMOE), (const bf16*)(ws + WS_WGU1), MOE_ROWS, 2 * FF1, DM}; MoeOrder S; S.init(t0, nT, 2 * FF1 / 256, C.G, bx, (const gu32*)(ws + WS_TILE));
          pg8::EpiSwiGLU E{(bf16*)(ws + WS_HSL), FF1, 2 * FF1 / 256, t0};
          pg8::gemm_phase<pg8::EpiSwiGLU, MoeOrder, true, true>(C.lds, g, S, E); }
        GRID_BAR();
        { pg8::Gemm g{(const bf16*)(ws + WS_HSL) - (size_t)t0 * 256 * FF1, (const bf16*)(ws + WS_WDN1), MOE_ROWS, DM, FF1}; MoeOrder S; S.init(t0, nT, DM / 256, C.G, bx, (const gu32*)(ws + WS_TILE));
          pg8::EpiPlain E{(bf16*)(ws + WS_AMOE), DM, DM / 256, 0};
          pg8::gemm_phase<pg8::EpiPlain, MoeOrder, true, true>(C.lds, g, S, E); }
        GRID_BAR();
    }
    ln_phase<2>(C, p.out, (const bf16*)(ws + WS_AMOE), p.in[16], p.in[17], p.out, nullptr, nullptr, nullptr, ws);
#undef GRID_BAR
}

extern "C" void kernel_launch(void* const* d_in, const int* in_sizes, int n_in, void* d_out, int out_size, void* d_ws, size_t ws_size, hipStream_t stream) {
    static int grid = 0;
    if (grid == 0) {
        if (n_in != 23 || in_sizes[0] != MTOK * DM || out_size != MTOK * DM || ws_size < WS_END) {
            fprintf(stderr, "kernel_launch: unexpected shapes/workspace (n_in %d, in0 %d, out %d, ws %zu, need %zu); nothing launched\n", n_in, n_in > 0 ? in_sizes[0] : -1, out_size, ws_size, (size_t)WS_END); grid = -1; return; }
        int dev = 0, cus = 0, per_cu = 0;
        if (hipGetDevice(&dev) != hipSuccess || hipDeviceGetAttribute(&cus, hipDeviceAttributeMultiprocessorCount, dev) != hipSuccess) { grid = -1; return; }
        if (hipFuncSetAttribute((const void*)fwd_kernel, hipFuncAttributeMaxDynamicSharedMemorySize, LDS_BYTES) != hipSuccess) { fprintf(stderr, "kernel_launch: hipFuncSetAttribute failed\n"); grid = -1; return; }
        if (hipOccupancyMaxActiveBlocksPerMultiprocessor(&per_cu, (const void*)fwd_kernel, NWAVES * 64, LDS_BYTES) != hipSuccess || per_cu < 1)
            fprintf(stderr, "kernel_launch: note: occupancy query reports %d workgroups per CU\n", per_cu);
        (void)hipGetLastError();
        grid = cus;
    }
    if (grid < 0) return;
    if (hipMemsetAsync((char*)d_ws + WS_CTL, 0, CTL_ZERO_BYTES, stream) != hipSuccess) return;
    Params p{};
    for (int i = 0; i < 23; ++i) p.in[i] = (const float*)d_in[i];
    p.out = (float*)d_out; p.ws = (unsigned char*)d_ws;
    hipLaunchKernelGGL(fwd_kernel, dim3(grid), dim3(NWAVES * 64), LDS_BYTES, stream, p);
}
```

```cpp
#include <hip/hip_runtime.h>
#include <cstdio>
#include <cstdint>
namespace pg8 {
#define PG8_LAS __attribute__((address_space(3)))
typedef unsigned short bf16_t;
typedef short bf16x8 __attribute__((ext_vector_type(8)));
typedef float f32x4 __attribute__((ext_vector_type(4)));
typedef unsigned u32x4 __attribute__((ext_vector_type(4)));
constexpr int BM = 256, BK = 64, HALF = 128, HTB = HALF * BK * 2  , STAGE_BYTES = 8 * HTB, NXCD = 8, WGM = 8;

__host__ __device__ __forceinline__ int lds_byte(int r, int c) { const int st = (r >> 4) * 2 + (c >> 5), rr = r & 15, cc = c & 31, ob = rr * 64 + cc * 2; return st * 1024 + (ob ^ (((ob >> 9) & 1) << 5)); }
__host__ __device__ __forceinline__ void stage_rc(int b, int& R, int& C) { const int st = b / 1024, sb = b % 1024, swz = sb ^ (((sb >> 9) & 1) << 5); R = (st >> 1) * 16 + swz / 64; C = (st & 1) * 32 + (swz % 64) / 2; }
__host__ __device__ __forceinline__ int perm32(int rho) { const int n = rho >> 4, i = rho & 15; return 8 * (i >> 2) + 4 * n + (i & 3); }

struct Unit { int pm, pn; };
struct Gemm { const bf16_t* A; const bf16_t* Bt; int M, N, K; };

struct StaticOrder {
    int nM, nN, nwg, G, c;
    __host__ __device__ void init(int M, int N, int G_, int c_) { nM = M / BM; nN = N / BM; nwg = nM * nN; G = G_; c = c_; }
    __host__ __device__ bool next(int i, Unit& u) const {
        const long L = (long)i * G + c; if (L >= nwg) return false;
        int wgid = (int)L; { const int q = nwg / NXCD, r = nwg % NXCD, xcd = wgid % NXCD, off = wgid / NXCD; wgid = (xcd < r ? xcd * (q + 1) : r * (q + 1) + (xcd - r) * q) + off; }
        const int nig = WGM * nN, gid = wgid / nig, fm = gid * WGM, gsz = (nM - fm) < WGM ? (nM - fm) : WGM;
        u.pm = fm + ((wgid % nig) % gsz); u.pn = (wgid % nig) / gsz; return true;
    }
    __device__ __forceinline__ void a_ready(const Unit&) const {}
    __device__ __forceinline__ void done(const Unit&) const {}
};
__device__ __forceinline__ unsigned cvt_pk_bf16(float lo, float hi) { unsigned r; asm volatile("v_cvt_pk_bf16_f32 %0, %1, %2" : "=v"(r) : "v"(lo), "v"(hi)); return r; }
typedef float f32x2 __attribute__((ext_vector_type(2)));
__device__ __forceinline__ float silu_mul(float g, float u) { const float e = __builtin_amdgcn_exp2f(g * -1.44269504089f); return g * u * __builtin_amdgcn_rcpf(1.0f + e); }
struct EpiPlain {
    static constexpr bool PERM = true, AFTER_DRAIN = false;
    bf16_t* O; int ldc; int pn_mod; int pm_sub;
    __device__ __forceinline__ void operator()(const f32x4 (&acc)[2][2][4][2], const Unit& u, int wr, int wc, int fr, int fq) const {
        const int pn = pn_mod ? (u.pn % pn_mod) : u.pn;
        const int row0 = (u.pm - pm_sub) * BM + wr * 64 + fr, col0 = pn * BM + wc * 32 + 8 * fq;
#pragma unroll
        for (int ai = 0; ai < 2; ++ai)
#pragma unroll
            for (int m = 0; m < 4; ++m) { bf16_t* rowp = O + (size_t)(row0 + ai * HALF + m * 16) * ldc + col0;
#pragma unroll
                for (int bj = 0; bj < 2; ++bj) { const f32x4 v0 = acc[ai][bj][m][0], v1 = acc[ai][bj][m][1];
                    u32x4 w; w.x = cvt_pk_bf16(v0[0], v0[1]); w.y = cvt_pk_bf16(v0[2], v0[3]); w.z = cvt_pk_bf16(v1[0], v1[1]); w.w = cvt_pk_bf16(v1[2], v1[3]);
                    *(u32x4*)(rowp + bj * HALF) = w; } }
    }
};
struct EpiSwiGLU {
    static constexpr bool PERM = true, AFTER_DRAIN = false;
    bf16_t* O; int ldc; int pn_mod; int pm_sub;
    __device__ __forceinline__ void operator()(const f32x4 (&acc)[2][2][4][2], const Unit& u, int wr, int wc, int fr, int fq) const {
        const int pn = pn_mod ? (u.pn % pn_mod) : u.pn;
        const int row0 = (u.pm - pm_sub) * BM + wr * 64 + fr, col0 = pn * HALF + wc * 32 + 8 * fq;
#pragma unroll
        for (int ai = 0; ai < 2; ++ai)
#pragma unroll
            for (int m = 0; m < 4; ++m) { bf16_t* rowp = O + (size_t)(row0 + ai * HALF + m * 16) * ldc + col0;
                const f32x4 g0 = acc[ai][0][m][0], g1 = acc[ai][0][m][1], u0 = acc[ai][1][m][0], u1 = acc[ai][1][m][1];
                u32x4 w; w.x = cvt_pk_bf16(silu_mul(g0[0], u0[0]), silu_mul(g0[1], u0[1])); w.y = cvt_pk_bf16(silu_mul(g0[2], u0[2]), silu_mul(g0[3], u0[3]));
                w.z = cvt_pk_bf16(silu_mul(g1[0], u1[0]), silu_mul(g1[1], u1[1])); w.w = cvt_pk_bf16(silu_mul(g1[2], u1[2]), silu_mul(g1[3], u1[3]));
                *(u32x4*)rowp = w; }
    }
};
template <class Epi, class Sched, bool ALIGN_EPI = false, bool SP2 = false>
__device__ __forceinline__ void gemm_phase(PG8_LAS unsigned char* lds, const Gemm g, const Sched& S, const Epi& E) {
    const int tid = threadIdx.x, wid = __builtin_amdgcn_readfirstlane(tid >> 6), lane = tid & 63, wr = wid >> 2, wc = wid & 3, fr = lane & 15, fq = lane >> 4;
    const int K = g.K, nt = K / BK;
    unsigned voffA[2], voffB[2];
#pragma unroll
    for (int i = 0; i < 2; ++i) { int R, C; stage_rc(tid * 16 + i * 8192, R, C); const int Rb = Epi::PERM ? ((R & ~31) + perm32(R & 31)) : R;
        voffA[i] = (unsigned)(R * K + C) * 2u; voffB[i] = (unsigned)(Rb * K + C) * 2u; }
    const size_t kstep = (size_t)(BK * 2);
    const size_t hstep = (size_t)HALF * K * 2;
    const size_t tstep = 2 * hstep;
    const unsigned ldsw = (unsigned)wid * 1024u;
    const int aoff = lds_byte(wr * 64 + fr, fq * 8), boff = lds_byte(wc * 32 + fr, fq * 8);
#define PG8_SA(b, h) (((b) * 2 + (h)) * HTB)
#define PG8_SB(b, h) ((4 + (b) * 2 + (h)) * HTB)
#define PG8_STAGE(bufoff, gbase, voff) do { _Pragma("unroll") for (int _i = 0; _i < 2; ++_i) \
        __builtin_amdgcn_global_load_lds((const unsigned*)((const char*)(gbase) + (voff)[_i]), (PG8_LAS unsigned*)(lds + (bufoff) + ldsw + _i * 8192), 16, 0, 0); } while (0)
#define PG8_LDA(dst, b, h) do { _Pragma("unroll") for (int m = 0; m < 4; ++m) _Pragma("unroll") for (int k = 0; k < 2; ++k) dst[m][k] = *(const PG8_LAS bf16x8*)(lds + PG8_SA(b, h) + aoff + m * 2048 + k * 1024); } while (0)
#define PG8_LDB(dst, b, h) do { _Pragma("unroll") for (int n = 0; n < 2; ++n) _Pragma("unroll") for (int k = 0; k < 2; ++k) dst[n][k] = *(const PG8_LAS bf16x8*)(lds + PG8_SB(b, h) + boff + n * 2048 + k * 1024); } while (0)
#define PG8_MMA(ai, bj, At, Bt) do { __builtin_amdgcn_s_setprio(1); _Pragma("unroll") for (int m = 0; m < 4; ++m) _Pragma("unroll") for (int n = 0; n < 2; ++n) _Pragma("unroll") for (int k = 0; k < 2; ++k) \
        acc[ai][bj][m][n] = __builtin_amdgcn_mfma_f32_16x16x32_bf16(Bt[n][k], At[m][k], acc[ai][bj][m][n], 0, 0, 0); __builtin_amdgcn_s_setprio(0); } while (0)
#define PG8_WAIT_V(n) asm volatile("s_waitcnt vmcnt(" #n ")" ::: "memory")
#define PG8_WAIT_L(n) asm volatile("s_waitcnt lgkmcnt(" #n ")" ::: "memory")
#define PG8_BAR __builtin_amdgcn_s_barrier()
#define PG8_SCHED __builtin_amdgcn_sched_barrier(0)
    Unit cur, nxt; int ui = 0;
    if (!S.next(0, cur)) return;
    f32x4 acc[2][2][4][2];
#pragma unroll
    for (int a = 0; a < 2; ++a)
#pragma unroll
        for (int b = 0; b < 2; ++b)
#pragma unroll
            for (int m = 0; m < 4; ++m)
#pragma unroll
                for (int n = 0; n < 2; ++n) acc[a][b][m][n] = (f32x4){0.f, 0.f, 0.f, 0.f};
    bf16x8 At[4][2], B0[2][2], B1[2][2];
    const char* cA = (const char*)g.A + (size_t)cur.pm * tstep; const char* cB = (const char*)g.Bt + (size_t)cur.pn * tstep;
    S.a_ready(cur);
    if constexpr (SP2) {
        PG8_STAGE(PG8_SB(0, 0), cB, voffB); PG8_STAGE(PG8_SB(0, 1), cB + hstep, voffB); PG8_STAGE(PG8_SA(0, 0), cA, voffA); PG8_STAGE(PG8_SA(0, 1), cA + hstep, voffA);
        if (wr == 1) PG8_BAR;
        PG8_WAIT_V(2); PG8_BAR;
        PG8_STAGE(PG8_SB(1, 0), cB + kstep, voffB); PG8_STAGE(PG8_SA(1, 0), cA + kstep, voffA); PG8_STAGE(PG8_SB(1, 1), cB + hstep + kstep, voffB);
        PG8_WAIT_V(6); PG8_BAR;
    } else {
        PG8_STAGE(PG8_SB(0, 0), cB, voffB); PG8_STAGE(PG8_SA(0, 0), cA, voffA); PG8_STAGE(PG8_SB(0, 1), cB + hstep, voffB); PG8_STAGE(PG8_SA(0, 1), cA + hstep, voffA);
        if (wr == 1) PG8_BAR;
        PG8_WAIT_V(4); PG8_BAR;
        PG8_STAGE(PG8_SB(1, 0), cB + kstep, voffB); PG8_STAGE(PG8_SA(1, 0), cA + kstep, voffA); PG8_STAGE(PG8_SB(1, 1), cB + hstep + kstep, voffB);
        PG8_WAIT_V(6); PG8_BAR;
    }
    for (;;) {
        const bool has_next = S.next(ui + 1, nxt);
        const char* nA = has_next ? (const char*)g.A + (size_t)nxt.pm * tstep : cA; const char* nB = has_next ? (const char*)g.Bt + (size_t)nxt.pn * tstep : cB;
        for (int t = 0; t < nt; t += 2) {
            const bool last = (t == nt - 2);
            const char* a1 = cA + (size_t)(t + 1) * kstep;
            const char* a2 = last ? nA : cA + (size_t)(t + 2) * kstep; const char* b2 = last ? nB : cB + (size_t)(t + 2) * kstep;
            const char* a3 = a2 + kstep; const char* b3 = b2 + kstep;
            if (last && has_next) S.a_ready(nxt);
            if constexpr (SP2) {
            PG8_LDB(B0, 0, 0); PG8_LDB(B1, 0, 1); PG8_SCHED; PG8_LDA(At, 0, 0); PG8_STAGE(PG8_SA(1, 1), a1 + hstep, voffA);
            PG8_WAIT_V(8); PG8_WAIT_L(0); PG8_BAR; PG8_MMA(0, 0, At, B0); PG8_MMA(0, 1, At, B1); PG8_BAR; PG8_SCHED;
            PG8_LDA(At, 0, 1); PG8_STAGE(PG8_SB(0, 0), b2, voffB); PG8_STAGE(PG8_SB(0, 1), b2 + hstep, voffB); PG8_STAGE(PG8_SA(0, 0), a2, voffA);
            PG8_WAIT_V(8); PG8_WAIT_L(0); PG8_BAR; PG8_MMA(1, 0, At, B0); PG8_MMA(1, 1, At, B1); PG8_BAR; PG8_SCHED;
            PG8_LDB(B0, 1, 0); PG8_LDB(B1, 1, 1); PG8_SCHED; PG8_LDA(At, 1, 0); PG8_STAGE(PG8_SA(0, 1), a2 + hstep, voffA);
            PG8_WAIT_V(8); PG8_WAIT_L(0); PG8_BAR; PG8_MMA(0, 0, At, B0); PG8_MMA(0, 1, At, B1); PG8_BAR; PG8_SCHED;
            PG8_LDA(At, 1, 1); PG8_STAGE(PG8_SB(1, 0), b3, voffB); PG8_STAGE(PG8_SB(1, 1), b3 + hstep, voffB); PG8_STAGE(PG8_SA(1, 0), a3, voffA);
            PG8_WAIT_V(8); PG8_WAIT_L(0); PG8_BAR; PG8_MMA(1, 0, At, B0); PG8_MMA(1, 1, At, B1); PG8_BAR; PG8_SCHED;
            } else {
            PG8_LDB(B0, 0, 0); PG8_SCHED; PG8_LDA(At, 0, 0); PG8_STAGE(PG8_SA(1, 1), a1 + hstep, voffA);
            PG8_WAIT_L(8); PG8_BAR; PG8_WAIT_L(0); PG8_MMA(0, 0, At, B0); PG8_BAR; PG8_SCHED;
            PG8_LDB(B1, 0, 1); PG8_STAGE(PG8_SB(0, 0), b2, voffB);
            PG8_BAR; PG8_WAIT_L(0); PG8_MMA(0, 1, At, B1); PG8_BAR;
            PG8_LDA(At, 0, 1); PG8_STAGE(PG8_SA(0, 0), a2, voffA);
            PG8_BAR; PG8_WAIT_L(0); PG8_MMA(1, 0, At, B0); PG8_BAR; PG8_SCHED;
            PG8_STAGE(PG8_SB(0, 1), b2 + hstep, voffB);
            PG8_WAIT_V(6); PG8_BAR; PG8_MMA(1, 1, At, B1); PG8_BAR;
            PG8_LDB(B0, 1, 0); PG8_SCHED; PG8_LDA(At, 1, 0); PG8_STAGE(PG8_SA(0, 1), a2 + hstep, voffA);
            PG8_WAIT_L(8); PG8_BAR; PG8_WAIT_L(0); PG8_MMA(0, 0, At, B0); PG8_BAR; PG8_SCHED;
            PG8_LDB(B1, 1, 1); PG8_STAGE(PG8_SB(1, 0), b3, voffB);
            PG8_BAR; PG8_WAIT_L(0); PG8_MMA(0, 1, At, B1); PG8_BAR;
            PG8_LDA(At, 1, 1); PG8_STAGE(PG8_SA(1, 0), a3, voffA);
            PG8_BAR; PG8_WAIT_L(0); PG8_MMA(1, 0, At, B0); PG8_BAR; PG8_SCHED;
            PG8_STAGE(PG8_SB(1, 1), b3 + hstep, voffB);
            PG8_WAIT_V(6); PG8_BAR; PG8_MMA(1, 1, At, B1); PG8_BAR;
            }
        }
        if constexpr (ALIGN_EPI) { if (wr == 0) PG8_BAR; }
        if constexpr (!Epi::AFTER_DRAIN) { E(acc, cur, wr, wc, fr, fq); S.done(cur); }
        if (!has_next) break;
#pragma unroll
        for (int a = 0; a < 2; ++a)
#pragma unroll
            for (int b = 0; b < 2; ++b)
#pragma unroll
                for (int m = 0; m < 4; ++m)
#pragma unroll
                    for (int n = 0; n < 2; ++n) acc[a][b][m][n] = (f32x4){0.f, 0.f, 0.f, 0.f};
        cur = nxt; cA = nA; cB = nB; ++ui;
        if constexpr (ALIGN_EPI) { if (wr == 1) PG8_BAR; }
    }
    PG8_WAIT_V(0);
    if constexpr (!ALIGN_EPI) { if (wr == 0) PG8_BAR; }
    PG8_BAR;
    if constexpr (Epi::AFTER_DRAIN) { E.fused(acc, cur, wr, wc, fr, fq, lds, wid, lane); S.done(cur); }
#undef PG8_SA
#undef PG8_SB
#undef PG8_STAGE
#undef PG8_LDA
#undef PG8_LDB
#undef PG8_MMA
#undef PG8_WAIT_V
#undef PG8_WAIT_L
#undef PG8_BAR
#undef PG8_SCHED
}
}
#define GAS __attribute__((address_space(1)))
#define LAS __attribute__((address_space(3)))
typedef unsigned short bf16;
typedef unsigned v4u __attribute__((ext_vector_type(4)));
typedef float f32x4 __attribute__((ext_vector_type(4)));
typedef short bf16x8 __attribute__((ext_vector_type(8)));
typedef GAS unsigned gu32;
typedef GAS unsigned long long gu64;
#define RLX_AGENT __ATOMIC_RELAXED, __HIP_MEMORY_SCOPE_AGENT
#define LDS_WAIT() asm volatile("s_waitcnt lgkmcnt(0)" ::: "memory")
#define VM_WAIT() asm volatile("s_waitcnt vmcnt(0)" ::: "memory")
__device__ __forceinline__ unsigned long long rt() { return __builtin_amdgcn_s_memrealtime(); }
__device__ __forceinline__ unsigned f2bf(float f) { unsigned u = __builtin_bit_cast(unsigned, f); return (u + 0x7fffu + ((u >> 16) & 1u)) >> 16; }
__device__ __forceinline__ unsigned pk2(float lo, float hi) { return f2bf(lo) | (f2bf(hi) << 16); }

#define XB_TMO      128
#define XB_XCNT(j)  (256  + 64 * (j))
#define XB_XSUB(j)  (1280 + 64 * (j))
#define XB_XGEN(j)  (2304 + 64 * (j))
#define XB_TOP      3328
#define XB_TOPGEN   3392
#define XCD_BAR_WORDS 3456
#define XB_SPIN_CAP (1u << 18)

__device__ __forceinline__ unsigned xb_ld(unsigned* p)              { return __hip_atomic_load(p, __ATOMIC_RELAXED, __HIP_MEMORY_SCOPE_AGENT); }
__device__ __forceinline__ unsigned xb_add(unsigned* p, unsigned v) { return __hip_atomic_fetch_add(p, v, __ATOMIC_RELAXED, __HIP_MEMORY_SCOPE_AGENT); }
__device__ __forceinline__ unsigned xb_xcc_id() { return (unsigned)__builtin_amdgcn_s_getreg((3 << 11) | 20) & 0xFu; }
#define XB_SPIN(cond, bar) do { unsigned _sp = 0; while (cond) { __builtin_amdgcn_s_sleep(1); \
    if ((++_sp & 255u) == 0u) { if (xb_ld(&(bar)[XB_TMO])) break; if (_sp > XB_SPIN_CAP) { atomicAdd(&(bar)[XB_TMO], 1u); break; } } } } while (0)

struct XcdBarrier {
    unsigned* bar; unsigned x;
    volatile LAS unsigned* st;
};

__device__ __forceinline__ XcdBarrier xcd_barrier_post(unsigned* bar, volatile LAS unsigned* st) {
    XcdBarrier b; b.bar = bar; b.x = xb_xcc_id(); b.st = st;
    if (threadIdx.x == 0) (void)xb_add(&bar[XB_XCNT(b.x)], 1u);
    return b;
}
__device__ __forceinline__ void xcd_barrier_complete(unsigned* bar, unsigned x, unsigned& nloc, unsigned& nx) {
    const unsigned G = gridDim.x * gridDim.y * gridDim.z;
    unsigned sum, cnt, mine, sp = 0u;
    for (;;) {
        sum = 0u; cnt = 0u; mine = 0u;
#pragma unroll
        for (unsigned j = 0; j < 16; ++j) { const unsigned c = xb_ld(&bar[XB_XCNT(j)]); sum += c; cnt += (c > 0u) ? 1u : 0u; mine = (j == x) ? c : mine; }
        if (sum == G) break;
        __builtin_amdgcn_s_sleep(1);
        if ((++sp & 255u) == 0u) { if (xb_ld(&bar[XB_TMO])) break; if (sp > XB_SPIN_CAP) { atomicAdd(&bar[XB_TMO], 1u); break; } }
    }
    nloc = mine > 0u ? mine : 1u; nx = cnt > 0u ? cnt : 1u;
}

__device__ __forceinline__ void xcd_barrier(const XcdBarrier& b) {
    asm volatile("s_waitcnt vmcnt(0)" ::: "memory");
    __syncthreads();
    if (threadIdx.x == 0) {
        unsigned* bar = b.bar;
        __builtin_amdgcn_s_waitcnt(0);
        unsigned nloc = b.st[0], nx = b.st[1];
        if (nloc == 0u) { xcd_barrier_complete(bar, b.x, nloc, nx); b.st[0] = nloc; b.st[1] = nx; }
        const unsigned old = xb_add(&bar[XB_XSUB(b.x)], 1u);
        const unsigned gen = old / nloc;
        if (old + 1u == (gen + 1u) * nloc) {
            __builtin_amdgcn_fence(__ATOMIC_RELEASE, "agent");
            asm volatile("s_waitcnt vmcnt(0)" ::: "memory");
            const unsigned og = xb_add(&bar[XB_TOP], 1u);
            const unsigned tg = og / nx;
            if (og + 1u == (tg + 1u) * nx) xb_add(&bar[XB_TOPGEN], 1u);
            else XB_SPIN(xb_ld(&bar[XB_TOPGEN]) == tg, bar);
            __builtin_amdgcn_fence(__ATOMIC_ACQUIRE, "agent");
            xb_add(&bar[XB_XGEN(b.x)], 1u);
            asm volatile("s_waitcnt vmcnt(0)" ::: "memory");
        } else {
            XB_SPIN(xb_ld(&bar[XB_XGEN(b.x)]) == gen, bar);
            __builtin_amdgcn_fence(__ATOMIC_ACQUIRE, "agent");
            asm volatile("s_waitcnt vmcnt(0)" ::: "memory");
        }
    }
    __syncthreads();
}

constexpr int NWAVES = 8;
constexpr int BATCH = 16, SEQ = 4096, DM = 1024, MTOK = BATCH * SEQ;
constexpr int D_IN = 3584, FF0 = 2816, FF1 = 3584, NEXP = 8, NQKV = 3072;
constexpr int OFF_QSB = 0, OFF_KSB = 512, OFF_VSB = 1024, OFF_QR = 1536, OFF_KR = 2048, OFF_VR = 2560, OFF_GR = 3072;
constexpr float LN_EPS = 1e-5f, ALPHA = 1.41421356237309515f;
constexpr float LOG2E = 1.44269504088896341f, LN2 = 0.69314718055994531f;
constexpr int MOE_MAXTILES = 520, MOE_SLICE = 128, MOE_ROWS = MOE_MAXTILES * 256;

constexpr size_t MiB = 1u << 20;
constexpr size_t WS_CTL = 0, CTL_ZERO_BYTES = 1 * MiB;
constexpr size_t WS_TOKE = 1 * MiB;
constexpr size_t WS_TOKG = WS_TOKE + (size_t)MTOK * 4;
constexpr size_t WS_TOKS = WS_TOKG + (size_t)MTOK * 8;
constexpr size_t WS_PERM = WS_TOKS + (size_t)MTOK * 8;
constexpr size_t WS_WCNT = WS_PERM + (size_t)MOE_ROWS * 4;
constexpr size_t WS_TILE = WS_WCNT + 4096 * 8 * 4;
static_assert(WS_TILE + 4096 <= 4 * MiB, "misc map");
constexpr size_t WS_ROPE = 4 * MiB;
constexpr size_t WS_WIN = 5 * MiB, WS_WO0 = 12 * MiB, WS_WGU0 = 14 * MiB, WS_WDN0 = 25 * MiB, WS_WQKV = 31 * MiB, WS_WO1 = 37 * MiB, WS_WGU1 = 39 * MiB, WS_WDN1 = 151 * MiB;
constexpr size_t WS_XB = 208 * MiB;
constexpr size_t WS_O = 336 * MiB;
constexpr size_t WS_BIG = 464 * MiB;
constexpr size_t WS_H = WS_BIG, WS_HID0 = WS_BIG, WS_QKV = WS_BIG, WS_AMOE = WS_BIG;
constexpr size_t WS_MIX = WS_BIG + 352 * MiB;
constexpr size_t WS_HSL = WS_BIG + 260 * MiB;
constexpr size_t WS_END = 948 * MiB;
static_assert(WS_WDN1 + (size_t)NEXP * DM * FF1 * 2 <= WS_XB && WS_HSL + (size_t)MOE_SLICE * 256 * FF1 * 2 <= WS_END && WS_MIX + (size_t)MTOK * DM * 2 <= WS_END, "ws map");
static_assert((size_t)MOE_ROWS * DM * 2 <= 260 * MiB && (size_t)MTOK * FF0 * 2 <= 352 * MiB, "ws map 2");
constexpr int CW_BAR = 4096;
constexpr int CW_NTILES = 16384;

constexpr int RING_BYTES = 131072, LDSCTL_OFF = RING_BYTES, MISC_OFF = LDSCTL_OFF + 320, LDS_BYTES = 147456;
constexpr int TP = 144;

typedef short s16x4 __attribute__((ext_vector_type(4)));
typedef float f32x16 __attribute__((ext_vector_type(16)));
typedef unsigned u32x2 __attribute__((ext_vector_type(2)));
typedef float f32x2 __attribute__((ext_vector_type(2)));
typedef __bf16 bf16x2_t __attribute__((ext_vector_type(2)));
typedef int i32x2 __attribute__((ext_vector_type(2)));
typedef int i32x4 __attribute__((ext_vector_type(4)));

__device__ __forceinline__ unsigned cvtpk(float lo, float hi) { f32x2 v = {lo, hi}; bf16x2_t b = __builtin_convertvector(v, bf16x2_t); return __builtin_bit_cast(unsigned, b); }
__device__ __forceinline__ float bflo(unsigned w) { return __uint_as_float(w << 16); }
__device__ __forceinline__ float bfhi(unsigned w) { return __uint_as_float(w & 0xffff0000u); }
__device__ __forceinline__ float bfel(const v4u& a, int e) { const unsigned w = a[e >> 1]; return (e & 1) ? bfhi(w) : bflo(w); }
__device__ __forceinline__ int crow(int r, int hi) { return (r & 3) + 8 * (r >> 2) + 4 * hi; }
__device__ __forceinline__ float ex2(float x) { return __builtin_amdgcn_exp2f(x); }
__device__ __forceinline__ float lg2(float x) { return __builtin_amdgcn_logf(x); }
__device__ __forceinline__ f32x16 mfma32(bf16x8 x, bf16x8 y, f32x16 c) { return __builtin_amdgcn_mfma_f32_32x32x16_bf16(x, y, c, 0, 0, 0); }
__device__ __forceinline__ float wave_sum(float v) {
#pragma unroll
    for (int o = 1; o < 64; o <<= 1) v += __shfl_xor(v, o);
    return v;
}
typedef short v4i16_t __attribute__((ext_vector_type(4)));
__device__ __forceinline__ s16x4 trrd(const LAS unsigned char* p) { return __builtin_bit_cast(s16x4, __builtin_amdgcn_ds_read_tr16_b64_v4i16((LAS v4i16_t*)p)); }
__device__ __forceinline__ bf16x8 row_frag(const LAS unsigned char* tile, int r32, int hi, int dk) { return *(const LAS bf16x8*)(tile + r32 * TP + (16 * dk + 8 * hi) * 2); }
__device__ __forceinline__ bf16x8 tr_frag(const LAS unsigned char* tile, int rowA, int rowB, int cb, int lane) {
    const int q = (lane & 15) >> 2, p = lane & 3, blk = (lane >> 4) & 1;
    const int co = cb * 64 + blk * 32 + p * 8;
    const s16x4 lo = trrd(tile + (rowA + q) * TP + co), hi4 = trrd(tile + (rowB + q) * TP + co);
    return (bf16x8){lo[0], lo[1], lo[2], lo[3], hi4[0], hi4[1], hi4[2], hi4[3]};
}
__device__ __forceinline__ void load_tile32(const bf16* g, size_t ldg, LAS unsigned char* tile, int lane) {
#pragma unroll
    for (int i = 0; i < 4; ++i) { const int id = i * 64 + lane, row = id >> 3, ch = id & 7;
        const v4u v = *(const GAS v4u*)(g + (size_t)row * ldg + ch * 8); *(LAS v4u*)(tile + row * TP + ch * 16) = v; }
}
template <bool DECAY>
__device__ __forceinline__ void load_tile32_rot(const bf16* g, size_t ldg, const float* rope, int pos0, int j0, float l2g, LAS unsigned char* tile, int lane) {
#pragma unroll
    for (int i = 0; i < 2; ++i) { const int id = i * 64 + lane, row = id >> 2, ch = id & 3;
        const v4u a = *(const GAS v4u*)(g + (size_t)row * ldg + ch * 8), bq = *(const GAS v4u*)(g + (size_t)row * ldg + 32 + ch * 8);
        const float* rp = rope + (size_t)(pos0 + row) * 64 + ch * 8;
        const f32x4 c0 = *(const GAS f32x4*)rp, c1 = *(const GAS f32x4*)(rp + 4), s0 = *(const GAS f32x4*)(rp + 32), s1 = *(const GAS f32x4*)(rp + 36);
        const float sc = DECAY ? ex2((float)(63 - (j0 + row)) * l2g) : 1.0f;
        float o1[8], o2[8];
#pragma unroll
        for (int e = 0; e < 8; ++e) { const float x1 = bfel(a, e), x2 = bfel(bq, e), c = e < 4 ? c0[e & 3] : c1[e & 3], s = e < 4 ? s0[e & 3] : s1[e & 3];
            o1[e] = (x1 * c - x2 * s) * sc; o2[e] = (x1 * s + x2 * c) * sc; }
        v4u w1, w2;
#pragma unroll
        for (int e = 0; e < 4; ++e) { w1[e] = cvtpk(o1[2 * e], o1[2 * e + 1]); w2[e] = cvtpk(o2[2 * e], o2[2 * e + 1]); }
        *(LAS v4u*)(tile + row * TP + ch * 16) = w1; *(LAS v4u*)(tile + row * TP + 64 + ch * 16) = w2; }
}
__device__ __forceinline__ bf16x8 pack8(const float* w) { v4u t; t.x = cvtpk(w[0], w[1]); t.y = cvtpk(w[2], w[3]); t.z = cvtpk(w[4], w[5]); t.w = cvtpk(w[6], w[7]); return __builtin_bit_cast(bf16x8, t); }

struct Ctx { LAS unsigned char* lds; int tid, lane, wave, vcu, G, gw, NGW; };

__device__ __forceinline__ void p0_transpose_item(const float* W, int K, int N, bf16* WT, int rs128, int radd, LAS float* scr, int item, int lane) {
    const int nblk = N / 32, kb = item / nblk, nb = item % nblk, k0 = 64 * kb, n0 = 32 * nb;
    const int drow0 = (n0 >> 7) * rs128 + (n0 & 127) + radd;
#pragma unroll 8
    for (int i = 0; i < 32; ++i) { const int kk = 2 * i + (lane >> 5); scr[kk * 33 + (lane & 31)] = W[(size_t)(k0 + kk) * N + n0 + (lane & 31)]; }
    LDS_WAIT(); asm volatile("" ::: "memory");
    const int c = lane & 7;
#pragma unroll
    for (int j = 0; j < 4; ++j) { const int n = (lane >> 3) + 8 * j; const LAS float* s = scr + (8 * c) * 33 + n;
        v4u o; o.x = cvtpk(s[0 * 33], s[1 * 33]); o.y = cvtpk(s[2 * 33], s[3 * 33]); o.z = cvtpk(s[4 * 33], s[5 * 33]); o.w = cvtpk(s[6 * 33], s[7 * 33]);
        *(GAS v4u*)(WT + (size_t)(drow0 + n) * K + k0 + 8 * c) = o; }
    LDS_WAIT(); asm volatile("" ::: "memory");
}
__device__ __forceinline__ void p0_prologue(const Ctx& C, const float* const* in, unsigned char* ws) {
    LAS float* scr = (LAS float*)(C.lds + C.wave * 16384);
    constexpr int I_WIN = 16 * (D_IN / 32), I_WO = 16 * 32, I_G0 = 16 * (FF0 / 32), I_D0 = (FF0 / 64) * 32, I_QKV = 16 * (NQKV / 32), I_ME = 16 * (FF1 / 32), I_MD = (FF1 / 64) * 32;
    static_assert(I_ME == 1792 && I_MD == 1792, "moe items");
    constexpr int NITEMS = I_WIN + I_WO + 2 * I_G0 + I_D0 + I_QKV + I_WO + NEXP * (2 * I_ME + I_MD);
    for (int it = C.gw; it < NITEMS; it += C.NGW) {
        int r = it;
        if (r < I_WIN) { p0_transpose_item(in[3], DM, D_IN, (bf16*)(ws + WS_WIN), 128, 0, scr, r, C.lane); continue; } r -= I_WIN;
        if (r < I_WO) { p0_transpose_item(in[5], DM, DM, (bf16*)(ws + WS_WO0), 128, 0, scr, r, C.lane); continue; } r -= I_WO;
        if (r < I_G0) { p0_transpose_item(in[8], DM, FF0, (bf16*)(ws + WS_WGU0), 256, 0, scr, r, C.lane); continue; } r -= I_G0;
        if (r < I_G0) { p0_transpose_item(in[9], DM, FF0, (bf16*)(ws + WS_WGU0), 256, 128, scr, r, C.lane); continue; } r -= I_G0;
        if (r < I_D0) { p0_transpose_item(in[10], FF0, DM, (bf16*)(ws + WS_WDN0), 128, 0, scr, r, C.lane); continue; } r -= I_D0;
        if (r < I_QKV) { p0_transpose_item(in[13], DM, NQKV, (bf16*)(ws + WS_WQKV), 128, 0, scr, r, C.lane); continue; } r -= I_QKV;
        if (r < I_WO) { p0_transpose_item(in[15], DM, DM, (bf16*)(ws + WS_WO1), 128, 0, scr, r, C.lane); continue; } r -= I_WO;
        if (r < NEXP * I_ME) { const int e = r / I_ME; p0_transpose_item(in[20] + (size_t)e * DM * FF1, DM, FF1, (bf16*)(ws + WS_WGU1) + (size_t)e * 2 * FF1 * DM, 256, 0, scr, r % I_ME, C.lane); continue; } r -= NEXP * I_ME;
        if (r < NEXP * I_ME) { const int e = r / I_ME; p0_transpose_item(in[21] + (size_t)e * DM * FF1, DM, FF1, (bf16*)(ws + WS_WGU1) + (size_t)e * 2 * FF1 * DM, 256, 128, scr, r % I_ME, C.lane); continue; } r -= NEXP * I_ME;
        { const int e = r / I_MD; p0_transpose_item(in[22] + (size_t)e * FF1 * DM, FF1, DM, (bf16*)(ws + WS_WDN1) + (size_t)e * DM * FF1, 128, 0, scr, r % I_MD, C.lane); }
    }
    { const float* x = in[0]; bf16* xb = (bf16*)(ws + WS_XB); const size_t n8 = (size_t)MTOK * DM / 8;
      for (size_t i = (size_t)C.gw * 64 + C.lane; i < n8; i += (size_t)C.NGW * 64) {
          const f32x4 a = *(const GAS f32x4*)(x + 8 * i), b = *(const GAS f32x4*)(x + 8 * i + 4);
          v4u o; o.x = cvtpk(a[0], a[1]); o.y = cvtpk(a[2], a[3]); o.z = cvtpk(b[0], b[1]); o.w = cvtpk(b[2], b[3]); *(GAS v4u*)(xb + 8 * i) = o; } }
    { float* rope = (float*)(ws + WS_ROPE);
      for (int idx = C.gw * 64 + C.lane; idx < SEQ * 32; idx += C.NGW * 64) { const int pos = idx >> 5, i = idx & 31;
          double f = 1.0; for (int k = 0; k < i; ++k) f *= 0.74989420933245582;
          const float invf = (float)f, ang = (float)pos * invf;
          double rev = (double)ang * 0.15915494309189535; rev -= __builtin_rint(rev);
          rope[pos * 64 + i] = __builtin_amdgcn_cosf((float)rev); rope[pos * 64 + 32 + i] = __builtin_amdgcn_sinf((float)rev); } }
}

template <int MODE, bool XF32>
__device__ __forceinline__ void ln_phase(const Ctx& C, const void* xprev, const bf16* fsrc, const float* gam, const float* bet, float* xout, bf16* xb,
                                         const float* w_router, const float* b_router, unsigned char* ws) {
    const int lane = C.lane;
    LAS float* wrT = (LAS float*)C.lds;
    if (MODE == 1) {
        for (int idx = C.tid; idx < DM * NEXP; idx += NWAVES * 64) { const int d = idx >> 3, e = idx & 7; wrT[e * DM + d] = w_router[idx]; }
        int* perm = (int*)(ws + WS_PERM);
        for (int idx = C.gw * 64 + lane; idx < MOE_ROWS; idx += C.NGW * 64) perm[idx] = -1;
        __syncthreads();
    }
    f32x4 gv[4], bv[4];
#pragma unroll
    for (int j = 0; j < 4; ++j) { gv[j] = ((const GAS f32x4*)gam)[lane + 64 * j]; bv[j] = ((const GAS f32x4*)bet)[lane + 64 * j]; }
    int cnt0 = 0, cnt1 = 0, cnt2 = 0, cnt3 = 0, cnt4 = 0, cnt5 = 0, cnt6 = 0, cnt7 = 0;
    for (int row = C.gw; row < MTOK; row += C.NGW) {
        f32x4 xin[4];
        if (XF32) { const GAS f32x4* xr = (const GAS f32x4*)((const float*)xprev + (size_t)row * DM) + lane;
#pragma unroll
            for (int j = 0; j < 4; ++j) xin[j] = xr[64 * j];
        } else { const GAS u32x2* xr = (const GAS u32x2*)((const bf16*)xprev + (size_t)row * DM) + lane;
#pragma unroll
            for (int j = 0; j < 4; ++j) { const u32x2 a = xr[64 * j]; xin[j] = (f32x4){bflo(a.x), bfhi(a.x), bflo(a.y), bfhi(a.y)}; } }
        f32x4 v[4];
        if (MODE == 2) {
            const i32x2 sl = *(const GAS i32x2*)(ws + WS_TOKS + (size_t)row * 8); const f32x2 gt = *(const GAS f32x2*)(ws + WS_TOKG + (size_t)row * 8);
            const GAS u32x2* y1 = (const GAS u32x2*)(fsrc + (size_t)sl.x * DM) + lane; const GAS u32x2* y2 = (const GAS u32x2*)(fsrc + (size_t)sl.y * DM) + lane;
#pragma unroll
            for (int j = 0; j < 4; ++j) { const u32x2 a = y1[64 * j], b = y2[64 * j]; const f32x4 xv = xin[j];
                v[j][0] = xv[0] * ALPHA + (gt.x * bflo(a.x) + gt.y * bflo(b.x)); v[j][1] = xv[1] * ALPHA + (gt.x * bfhi(a.x) + gt.y * bfhi(b.x));
                v[j][2] = xv[2] * ALPHA + (gt.x * bflo(a.y) + gt.y * bflo(b.y)); v[j][3] = xv[3] * ALPHA + (gt.x * bfhi(a.y) + gt.y * bfhi(b.y)); }
        } else {
            const GAS u32x2* mr = (const GAS u32x2*)(fsrc + (size_t)row * DM) + lane;
#pragma unroll
            for (int j = 0; j < 4; ++j) { const u32x2 a = mr[64 * j]; const f32x4 xv = xin[j];
                v[j][0] = xv[0] * ALPHA + bflo(a.x); v[j][1] = xv[1] * ALPHA + bfhi(a.x); v[j][2] = xv[2] * ALPHA + bflo(a.y); v[j][3] = xv[3] * ALPHA + bfhi(a.y); }
        }
        float s = 0.f;
#pragma unroll
        for (int j = 0; j < 4; ++j) s += (v[j][0] + v[j][1]) + (v[j][2] + v[j][3]);
        const float mean = wave_sum(s) * (1.0f / DM); float s2 = 0.f;
#pragma unroll
        for (int j = 0; j < 4; ++j) { v[j] = v[j] - mean; s2 += (v[j][0] * v[j][0] + v[j][1] * v[j][1]) + (v[j][2] * v[j][2] + v[j][3] * v[j][3]); }
        const float rstd = 1.0f / sqrtf(wave_sum(s2) * (1.0f / DM) + LN_EPS);
#pragma unroll
        for (int j = 0; j < 4; ++j) v[j] = v[j] * rstd * gv[j] + bv[j];
        if (MODE == 2) { GAS f32x4* xo = (GAS f32x4*)(xout + (size_t)row * DM) + lane;
#pragma unroll
            for (int j = 0; j < 4; ++j) xo[64 * j] = v[j]; }
        if (MODE != 2) { GAS u32x2* bo = (GAS u32x2*)(xb + (size_t)row * DM) + lane;
#pragma unroll
            for (int j = 0; j < 4; ++j) { u32x2 w; w.x = cvtpk(v[j][0], v[j][1]); w.y = cvtpk(v[j][2], v[j][3]); bo[64 * j] = w; } }
        if (MODE == 1) {
            float lg[8];
#pragma unroll
            for (int e = 0; e < 8; ++e) { float a = 0.f;
#pragma unroll
                for (int j = 0; j < 4; ++j) { const f32x4 w = *(const LAS f32x4*)(wrT + e * DM + 4 * lane + 256 * j); a += (v[j][0] * w[0] + v[j][1] * w[1]) + (v[j][2] * w[2] + v[j][3] * w[3]); }
                lg[e] = wave_sum(a) + b_router[e]; }
            int e1 = 0; float v1 = lg[0];
#pragma unroll
            for (int e = 1; e < 8; ++e) if (lg[e] > v1) { v1 = lg[e]; e1 = e; }
            int e2 = -1; float v2 = -3.0e38f;
#pragma unroll
            for (int e = 0; e < 8; ++e) if (e != e1 && lg[e] > v2) { v2 = lg[e]; e2 = e; }
            const float g1 = 1.0f / (1.0f + __expf(v2 - v1)), g2 = 1.0f - g1;
            if (lane == 0) { *(GAS int*)(ws + WS_TOKE + (size_t)row * 4) = e1 | (e2 << 8); *(GAS f32x2*)(ws + WS_TOKG + (size_t)row * 8) = (f32x2){g1, g2}; }
            cnt0 += (e1 == 0) + (e2 == 0); cnt1 += (e1 == 1) + (e2 == 1); cnt2 += (e1 == 2) + (e2 == 2); cnt3 += (e1 == 3) + (e2 == 3);
            cnt4 += (e1 == 4) + (e2 == 4); cnt5 += (e1 == 5) + (e2 == 5); cnt6 += (e1 == 6) + (e2 == 6); cnt7 += (e1 == 7) + (e2 == 7);
        }
    }
    if (MODE == 1) {
        int myc = cnt0; myc = lane == 1 ? cnt1 : myc; myc = lane == 2 ? cnt2 : myc; myc = lane == 3 ? cnt3 : myc; myc = lane == 4 ? cnt4 : myc; myc = lane == 5 ? cnt5 : myc; myc = lane == 6 ? cnt6 : myc; myc = lane == 7 ? cnt7 : myc;
        if (lane < 8) *(GAS int*)(ws + WS_WCNT + ((size_t)C.gw * 8 + lane) * 4) = myc;
    }
}

__device__ __forceinline__ void moe_assign(const Ctx& C, unsigned char* ws, gu32* ctl) {
    const int lane = C.lane;
    const GAS int* wcnt = (const GAS int*)(ws + WS_WCNT);
    int tot[8], pre[8];
#pragma unroll
    for (int e = 0; e < 8; ++e) { tot[e] = 0; pre[e] = 0; }
    for (int w = lane; w < C.NGW; w += 64) { const i32x4 a = *(const GAS i32x4*)(wcnt + w * 8), b = *(const GAS i32x4*)(wcnt + w * 8 + 4); const bool lo = w < C.gw;
        tot[0] += a.x; tot[1] += a.y; tot[2] += a.z; tot[3] += a.w; tot[4] += b.x; tot[5] += b.y; tot[6] += b.z; tot[7] += b.w;
        if (lo) { pre[0] += a.x; pre[1] += a.y; pre[2] += a.z; pre[3] += a.w; pre[4] += b.x; pre[5] += b.y; pre[6] += b.z; pre[7] += b.w; } }
    int off[9]; off[0] = 0;
#pragma unroll
    for (int e = 0; e < 8; ++e) {
#pragma unroll
        for (int o = 1; o < 64; o <<= 1) { tot[e] += __shfl_xor(tot[e], o); pre[e] += __shfl_xor(pre[e], o); }
        off[e + 1] = off[e] + ((tot[e] + 255) & ~255); }
    const GAS int* toke = (const GAS int*)(ws + WS_TOKE); GAS int* perm = (GAS int*)(ws + WS_PERM);
    int base[8];
#pragma unroll
    for (int e = 0; e < 8; ++e) base[e] = off[e] + pre[e];
    for (int i0 = 0; C.gw + i0 * C.NGW < MTOK; i0 += 64) {
        const int row = C.gw + (i0 + lane) * C.NGW; const bool live = row < MTOK;
        const int ee = live ? toke[row] : 0xffff; const int e1 = ee & 0xff, e2 = (ee >> 8) & 0xff;
        int s1 = 0, s2 = 0; const unsigned long long lower = (1ull << lane) - 1ull;
#pragma unroll
        for (int e = 0; e < 8; ++e) { const unsigned long long m1 = __ballot(live && e1 == e), m2 = __ballot(live && e2 == e);
            const int rank = __popcll(m1 & lower) + __popcll(m2 & lower);
            if (e1 == e) s1 = base[e] + rank; if (e2 == e) s2 = base[e] + rank;
            base[e] += __popcll(m1) + __popcll(m2); }
        if (live) { perm[s1] = row; perm[s2] = row; *(GAS i32x2*)(ws + WS_TOKS + (size_t)row * 8) = (i32x2){s1, s2}; }
    }
    if (C.gw == 0) {
        const int ntile = off[8] >> 8;
        for (int t = lane; t < 1024; t += 64) { int e = 0;
#pragma unroll
            for (int k = 1; k < 8; ++k) e += (t * 256 >= off[k]) ? 1 : 0;
            __hip_atomic_store((gu32*)(ws + WS_TILE) + t, (unsigned)(t < ntile ? e : 0), RLX_AGENT); }
        if (lane == 0) __hip_atomic_store(ctl + CW_NTILES, (unsigned)ntile, RLX_AGENT);
    }
}
__device__ __forceinline__ void moe_gather(const Ctx& C, unsigned char* ws, int ntile) {
    const GAS int* perm = (const GAS int*)(ws + WS_PERM); const bf16* xb = (const bf16*)(ws + WS_XB); bf16* A = (bf16*)(ws + WS_AMOE);
    for (int s = C.gw; s < ntile * 256; s += C.NGW) { const int row = perm[s];
        v4u a = {0u, 0u, 0u, 0u}, b = {0u, 0u, 0u, 0u};
        if (row >= 0) { const GAS v4u* src = (const GAS v4u*)(xb + (size_t)row * DM) + C.lane; a = src[0]; b = src[64]; }
        GAS v4u* dst = (GAS v4u*)(A + (size_t)s * DM) + C.lane; dst[0] = a; dst[64] = b; }
}
struct MoeOrder {
    int nM, nN, nwg, G, c, t0; const gu32* tile_expert;
    __device__ __forceinline__ void init(int t0_, int nT, int nN_, int G_, int c_, const gu32* te) { t0 = t0_; nM = nT; nN = nN_; nwg = nM * nN; G = G_; c = c_; tile_expert = te; }
    __device__ __forceinline__ bool next(int i, pg8::Unit& u) const {
        const long L = (long)i * G + c; if (L >= nwg) return false;
        int wgid = (int)L; { const int q = nwg / pg8::NXCD, r = nwg % pg8::NXCD, xcd = wgid % pg8::NXCD, off = wgid / pg8::NXCD; wgid = (xcd < r ? xcd * (q + 1) : r * (q + 1) + (xcd - r) * q) + off; }
        const int nig = pg8::WGM * nN, gid = wgid / nig, fm = gid * pg8::WGM, gsz = (nM - fm) < pg8::WGM ? (nM - fm) : pg8::WGM;
        const int pm = t0 + fm + ((wgid % nig) % gsz), pn = (wgid % nig) / gsz;
        const int e = (int)__builtin_amdgcn_readfirstlane(__hip_atomic_load(tile_expert + pm, RLX_AGENT));
        u.pm = pm; u.pn = e * nN + pn; return true;
    }
    __device__ __forceinline__ void a_ready(const pg8::Unit&) const {}
    __device__ __forceinline__ void done(const pg8::Unit&) const {}
};

__device__ __forceinline__ void sb_phase(const Ctx& C, const bf16* H, bf16* O) {
    LAS unsigned char* wl = C.lds + C.wave * 16384; LAS unsigned char* Kt = wl; LAS unsigned char* Vt = wl + 4608; LAS unsigned char* stg = wl + 9216;
    const int lane = C.lane, r32 = lane & 31, hi = lane >> 5;
    for (int u = C.gw; u < BATCH * 8 * 128; u += C.NGW) {
        const int qt = u & 127, h = (u >> 7) & 7, b = u >> 10;
        const bf16* Hb = H + (size_t)b * SEQ * D_IN + h * 64;
        bf16x8 qf[4];
#pragma unroll
        for (int dk = 0; dk < 4; ++dk) qf[dk] = *(const GAS bf16x8*)(Hb + (size_t)(qt * 32 + r32) * D_IN + OFF_QSB + 16 * dk + 8 * hi);
        float R = 0.f; f32x16 oacc[2]; oacc[0] = f32x16{}; oacc[1] = f32x16{};
        for (int kt = qt; kt >= 0; --kt) {
            load_tile32(Hb + (size_t)(kt * 32) * D_IN + OFF_KSB, D_IN, Kt, lane); load_tile32(Hb + (size_t)(kt * 32) * D_IN + OFF_VSB, D_IN, Vt, lane);
            f32x16 acc = f32x16{};
#pragma unroll
            for (int dk = 0; dk < 4; ++dk) acc = mfma32(row_frag(Kt, r32, hi, dk), qf[dk], acc);
            const bool diag = (kt == qt);
            float z[16], lgv[16]; bool valid[16];
#pragma unroll
            for (int r = 0; r < 16; ++r) { z[r] = acc[r] * 0.125f; valid[r] = !diag || (crow(r, hi) < r32);
                const float e = ex2(-fabsf(z[r]) * LOG2E); const float sp = fmaxf(z[r], 0.f) + LN2 * lg2(1.0f + e); lgv[r] = valid[r] ? -sp : 0.f; }
            float G[4], PG[4], T[4];
#pragma unroll
            for (int g = 0; g < 4; ++g) { G[g] = (lgv[4 * g] + lgv[4 * g + 1]) + (lgv[4 * g + 2] + lgv[4 * g + 3]); PG[g] = __shfl_xor(G[g], 32); T[g] = G[g] + PG[g]; }
            float above[4]; above[3] = 0.f; above[2] = T[3]; above[1] = T[3] + T[2]; above[0] = T[3] + T[2] + T[1];
            float w[16];
#pragma unroll
            for (int g = 0; g < 4; ++g) { const float base = R + above[g] + (hi == 0 ? PG[g] : 0.f);
                float inc = 0.f;
#pragma unroll
                for (int i = 3; i >= 0; --i) { const int r = 4 * g + i; inc += lgv[r]; w[r] = valid[r] ? ex2((z[r] + base + inc) * LOG2E) : 0.f; } }
            R += (T[0] + T[1]) + (T[2] + T[3]);
            const bf16x8 pf0 = pack8(w), pf1 = pack8(w + 8);
#pragma unroll
            for (int db = 0; db < 2; ++db) {
                oacc[db] = mfma32(tr_frag(Vt, 4 * hi, 8 + 4 * hi, db, lane), pf0, oacc[db]);
                oacc[db] = mfma32(tr_frag(Vt, 16 + 4 * hi, 24 + 4 * hi, db, lane), pf1, oacc[db]); }
            if (__all(R < -88.0f)) break;
        }
#pragma unroll
        for (int db = 0; db < 2; ++db)
#pragma unroll
            for (int r = 0; r < 16; ++r) *(LAS unsigned short*)(stg + r32 * TP + (db * 32 + crow(r, hi)) * 2) = (unsigned short)cvtpk(oacc[db][r], 0.f);
#pragma unroll
        for (int i = 0; i < 4; ++i) { const int row = i * 8 + (lane >> 3), ch = lane & 7; const v4u v = *(const LAS v4u*)(stg + row * TP + ch * 16);
            *(GAS v4u*)(O + (size_t)(b * SEQ + qt * 32 + row) * DM + h * 64 + ch * 8) = v; }
    }
}

__device__ __forceinline__ void ret_kv_phase(const Ctx& C, const bf16* H, const float* rope, float* KV) {
    LAS unsigned char* wl = C.lds + C.wave * 16384; LAS unsigned char* Kt = wl; LAS unsigned char* Vt = wl + 4608;
    const int lane = C.lane, r32 = lane & 31, hi = lane >> 5;
    for (int u = C.gw; u < BATCH * 8 * 64; u += C.NGW) {
        const int c = u & 63, h = (u >> 6) & 7, b = u >> 9;
        const float l2g = log1pf(-ex2((float)(-5 - h))) * LOG2E;
        const bf16* Hb = H + ((size_t)b * SEQ + c * 64) * D_IN + h * 64;
        f32x16 acc[2][2]; acc[0][0] = f32x16{}; acc[0][1] = f32x16{}; acc[1][0] = f32x16{}; acc[1][1] = f32x16{};
        for (int jh = 0; jh < 2; ++jh) {
            load_tile32_rot<true>(Hb + (size_t)(32 * jh) * D_IN + OFF_KR, D_IN, rope, c * 64 + 32 * jh, 32 * jh, l2g, Kt, lane);
            load_tile32(Hb + (size_t)(32 * jh) * D_IN + OFF_VR, D_IN, Vt, lane);
#pragma unroll
            for (int m = 0; m < 2; ++m) {
                bf16x8 kf[2], vf[2];
#pragma unroll
                for (int a = 0; a < 2; ++a) { kf[a] = tr_frag(Kt, 16 * m + 8 * hi, 16 * m + 8 * hi + 4, a, lane); vf[a] = tr_frag(Vt, 16 * m + 8 * hi, 16 * m + 8 * hi + 4, a, lane); }
#pragma unroll
                for (int a = 0; a < 2; ++a)
#pragma unroll
                    for (int b2 = 0; b2 < 2; ++b2) acc[a][b2] = mfma32(kf[a], vf[b2], acc[a][b2]);
            }
        }
        float* dst = KV + ((size_t)((b * 8 + h) * 64 + c)) * 4096;
#pragma unroll
        for (int a = 0; a < 2; ++a)
#pragma unroll
            for (int b2 = 0; b2 < 2; ++b2)
#pragma unroll
                for (int r = 0; r < 16; ++r) dst[(crow(r, hi) + 32 * a) * 64 + r32 + 32 * b2] = acc[a][b2][r];
    }
}
__device__ __forceinline__ void ret_scan_phase(const Ctx& C, float* KV) {
    for (int idx = C.gw * 64 + C.lane; idx < BATCH * 8 * 4096; idx += C.NGW * 64) {
        const int bh = idx >> 12, el = idx & 4095, h = bh & 7;
        const float dc = ex2(64.0f * log1pf(-ex2((float)(-5 - h))) * LOG2E);
        float* p = KV + (size_t)bh * 64 * 4096 + el; float st = 0.f;
        for (int c0 = 0; c0 < 64; c0 += 8) { float t[8];
#pragma unroll
            for (int k = 0; k < 8; ++k) t[k] = p[(size_t)(c0 + k) * 4096];
#pragma unroll
            for (int k = 0; k < 8; ++k) { p[(size_t)(c0 + k) * 4096] = st; st = st * dc + t[k]; } }
    }
}
__device__ __forceinline__ void ret_out_phase(const Ctx& C, const bf16* H, const float* rope, const float* KV, const float* gn_g, bf16* O) {
    LAS unsigned char* wl = C.lds + C.wave * 16384; LAS unsigned char* Kt = wl; LAS unsigned char* Vt = wl + 4608; LAS unsigned char* St = wl + 9216;
    LAS float* stf = (LAS float*)wl;
    const int lane = C.lane, r32 = lane & 31, hi = lane >> 5;
    for (int u = C.gw; u < BATCH * 8 * 64 * 2; u += C.NGW) {
        const int ih = u & 1, c = (u >> 1) & 63, h = (u >> 7) & 7, b = u >> 10;
        const float l2g = log1pf(-ex2((float)(-5 - h))) * LOG2E;
        const bf16* Hb = H + ((size_t)b * SEQ + c * 64) * D_IN + h * 64;
        const int iq = 32 * ih + r32, pos = c * 64 + iq;
        bf16x8 qf[4];
        { v4u qr[4];
#pragma unroll
          for (int dk = 0; dk < 4; ++dk) qr[dk] = *(const GAS v4u*)(Hb + (size_t)iq * D_IN + OFF_QR + 16 * dk + 8 * hi);
#pragma unroll
          for (int dk = 0; dk < 2; ++dk) { const float* rp = rope + (size_t)pos * 64 + 16 * dk + 8 * hi;
              const f32x4 c0 = *(const GAS f32x4*)rp, c1 = *(const GAS f32x4*)(rp + 4), s0 = *(const GAS f32x4*)(rp + 32), s1 = *(const GAS f32x4*)(rp + 36);
              float o1[8], o2[8];
#pragma unroll
              for (int e = 0; e < 8; ++e) { const float x1 = bfel(qr[dk], e), x2 = bfel(qr[dk + 2], e), cc = e < 4 ? c0[e & 3] : c1[e & 3], ss = e < 4 ? s0[e & 3] : s1[e & 3];
                  o1[e] = (x1 * cc - x2 * ss) * 0.125f; o2[e] = (x1 * ss + x2 * cc) * 0.125f; }
              qf[dk] = pack8(o1); qf[dk + 2] = pack8(o2); } }
        f32x16 oacc[2]; oacc[0] = f32x16{}; oacc[1] = f32x16{};
        for (int jt = 0; jt <= ih; ++jt) {
            load_tile32_rot<false>(Hb + (size_t)(32 * jt) * D_IN + OFF_KR, D_IN, rope, c * 64 + 32 * jt, 32 * jt, 0.f, Kt, lane);
            load_tile32(Hb + (size_t)(32 * jt) * D_IN + OFF_VR, D_IN, Vt, lane);
            f32x16 acc = f32x16{};
#pragma unroll
            for (int dk = 0; dk < 4; ++dk) acc = mfma32(row_frag(Kt, r32, hi, dk), qf[dk], acc);
            float w[16];
#pragma unroll
            for (int r = 0; r < 16; ++r) { const int dl = iq - (32 * jt + crow(r, hi)); w[r] = dl >= 0 ? acc[r] * ex2((float)dl * l2g) : 0.f; }
            const bf16x8 pf0 = pack8(w), pf1 = pack8(w + 8);
#pragma unroll
            for (int eb = 0; eb < 2; ++eb) {
                oacc[eb] = mfma32(tr_frag(Vt, 4 * hi, 8 + 4 * hi, eb, lane), pf0, oacc[eb]);
                oacc[eb] = mfma32(tr_frag(Vt, 16 + 4 * hi, 24 + 4 * hi, eb, lane), pf1, oacc[eb]); }
        }
        f32x16 cacc[2]; cacc[0] = f32x16{}; cacc[1] = f32x16{};
        const float* Sg = KV + ((size_t)((b * 8 + h) * 64 + c)) * 4096;
        for (int half = 0; half < 2; ++half) {
#pragma unroll
            for (int i = 0; i < 4; ++i) { const int id = i * 64 + lane, row = id >> 3, ch = id & 7;
                const f32x4 a = *(const GAS f32x4*)(Sg + (size_t)(32 * half + row) * 64 + ch * 8), bb = *(const GAS f32x4*)(Sg + (size_t)(32 * half + row) * 64 + ch * 8 + 4);
                v4u t; t.x = cvtpk(a[0], a[1]); t.y = cvtpk(a[2], a[3]); t.z = cvtpk(bb[0], bb[1]); t.w = cvtpk(bb[2], bb[3]); *(LAS v4u*)(St + row * TP + ch * 16) = t; }
#pragma unroll
            for (int m2 = 0; m2 < 2; ++m2)
#pragma unroll
                for (int eb = 0; eb < 2; ++eb) cacc[eb] = mfma32(tr_frag(St, 16 * m2 + 8 * hi, 16 * m2 + 8 * hi + 4, eb, lane), qf[2 * half + m2], cacc[eb]);
        }
        const float dq = ex2((float)(iq + 1) * l2g);
        float x[2][16]; float s = 0.f;
#pragma unroll
        for (int eb = 0; eb < 2; ++eb)
#pragma unroll
            for (int r = 0; r < 16; ++r) { x[eb][r] = oacc[eb][r] + dq * cacc[eb][r]; s += x[eb][r]; }
        s += __shfl_xor(s, 32); const float mean = s * (1.0f / 64.0f); float s2 = 0.f;
#pragma unroll
        for (int eb = 0; eb < 2; ++eb)
#pragma unroll
            for (int r = 0; r < 16; ++r) { x[eb][r] -= mean; s2 += x[eb][r] * x[eb][r]; }
        s2 += __shfl_xor(s2, 32); const float rstd = 1.0f / sqrtf(s2 * (1.0f / 64.0f) + LN_EPS);
#pragma unroll
        for (int eb = 0; eb < 2; ++eb)
#pragma unroll
            for (int r = 0; r < 16; ++r) stf[r32 * 66 + 32 * eb + crow(r, hi)] = x[eb][r] * rstd;
#pragma unroll
        for (int i = 0; i < 4; ++i) { const int row = i * 8 + (lane >> 3), ch = lane & 7;
            const v4u gq = *(const GAS v4u*)(Hb + (size_t)(32 * ih + row) * D_IN + OFF_GR + ch * 8);
            const f32x4 g0 = *(const GAS f32x4*)(gn_g + h * 64 + ch * 8), g1 = *(const GAS f32x4*)(gn_g + h * 64 + ch * 8 + 4);
            float o[8];
#pragma unroll
            for (int e = 0; e < 8; ++e) { const float gate = bfel(gq, e), nv = stf[row * 66 + ch * 8 + e], gg = e < 4 ? g0[e & 3] : g1[e & 3];
                o[e] = gate * __builtin_amdgcn_rcpf(1.0f + ex2(-gate * LOG2E)) * nv * gg; }
            v4u t; t.x = cvtpk(o[0], o[1]); t.y = cvtpk(o[2], o[3]); t.z = cvtpk(o[4], o[5]); t.w = cvtpk(o[6], o[7]);
            *(GAS v4u*)(O + (size_t)(b * SEQ + c * 64 + 32 * ih + row) * DM + 512 + h * 64 + ch * 8) = t; }
    }
}

__device__ __forceinline__ void chunk_attn_phase(const Ctx& C, const bf16* QKV, const float* rel_bias, bf16* O) {
    LAS unsigned char* wl = C.lds + C.wave * 16384; LAS unsigned char* Kt = wl; LAS unsigned char* Vt = wl + 4608; LAS unsigned char* stg = wl + 9216; LAS float* tb = (LAS float*)(wl + 13824);
    const int lane = C.lane, r32 = lane & 31, hi = lane >> 5;
    const float C1 = 0.125f * LOG2E;
    int cur_h = -1;
    for (int u = C.gw; u < BATCH * 16 * 128; u += C.NGW) {
        const int qt = u & 127, h = (u >> 7) & 15, b = u >> 11, c = qt >> 1, iq = 32 * (qt & 1) + r32;
        if (h != cur_h) { for (int i = lane; i < 513; i += 64) tb[i] = rel_bias[h * 513 + i] * LOG2E; cur_h = h; }
        const bf16* Qb = QKV + (size_t)b * SEQ * NQKV + h * 64;
        bf16x8 qf[4];
#pragma unroll
        for (int dk = 0; dk < 4; ++dk) qf[dk] = *(const GAS bf16x8*)(Qb + (size_t)(qt * 32 + r32) * NQKV + 16 * dk + 8 * hi);
        float m = -1.0e30f, l = 0.f; f32x16 oacc[2]; oacc[0] = f32x16{}; oacc[1] = f32x16{};
        const int kc0 = c - 8 < 0 ? 0 : c - 8;
        for (int kt = 2 * kc0; kt <= 2 * c + 1; ++kt) {
            const int kc = kt >> 1;
            load_tile32(Qb + (size_t)(kt * 32) * NQKV + 1024, NQKV, Kt, lane); load_tile32(Qb + (size_t)(kt * 32) * NQKV + 2048, NQKV, Vt, lane);
            f32x16 acc = f32x16{};
#pragma unroll
            for (int dk = 0; dk < 4; ++dk) acc = mfma32(row_frag(Kt, r32, hi, dk), qf[dk], acc);
            float sv[16];
            if (c - kc >= 5) { const float bc = tb[512];
#pragma unroll
                for (int r = 0; r < 16; ++r) sv[r] = acc[r] * C1 + bc;
            } else { const int dl = 64 * (c - kc) + iq - 32 * (kt & 1);
#pragma unroll
                for (int r = 0; r < 16; ++r) { int rel = dl - crow(r, hi); rel = rel > 256 ? 256 : rel; rel = rel < -256 ? -256 : rel; sv[r] = acc[r] * C1 + tb[rel + 256]; } }
            float tm = sv[0];
#pragma unroll
            for (int r = 1; r < 16; ++r) tm = fmaxf(tm, sv[r]);
            tm = fmaxf(tm, __shfl_xor(tm, 32));
            const float mn = fmaxf(m, tm), al = ex2(m - mn); m = mn;
            float ps = 0.f, w[16];
#pragma unroll
            for (int r = 0; r < 16; ++r) { w[r] = ex2(sv[r] - mn); ps += w[r]; }
            l = l * al + ps;
#pragma unroll
            for (int r = 0; r < 16; ++r) { oacc[0][r] *= al; oacc[1][r] *= al; }
            const bf16x8 pf0 = pack8(w), pf1 = pack8(w + 8);
#pragma unroll
            for (int db = 0; db < 2; ++db) {
                oacc[db] = mfma32(tr_frag(Vt, 4 * hi, 8 + 4 * hi, db, lane), pf0, oacc[db]);
                oacc[db] = mfma32(tr_frag(Vt, 16 + 4 * hi, 24 + 4 * hi, db, lane), pf1, oacc[db]); }
        }
        l += __shfl_xor(l, 32); const float inv = 1.0f / l;
#pragma unroll
        for (int db = 0; db < 2; ++db)
#pragma unroll
            for (int r = 0; r < 16; ++r) *(LAS unsigned short*)(stg + r32 * TP + (db * 32 + crow(r, hi)) * 2) = (unsigned short)cvtpk(oacc[db][r] * inv, 0.f);
#pragma unroll
        for (int i = 0; i < 4; ++i) { const int row = i * 8 + (lane >> 3), ch = lane & 7; const v4u v = *(const LAS v4u*)(stg + row * TP + ch * 16);
            *(GAS v4u*)(O + (size_t)(b * SEQ + qt * 32 + row) * DM + h * 64 + ch * 8) = v; }
    }
}

struct Params { const float* in[23]; float* out; unsigned char* ws; };
__global__ void __launch_bounds__(NWAVES * 64, 2) fwd_kernel(Params p) {
    extern __shared__ __attribute__((aligned(16))) unsigned char lds_raw[];
    Ctx C;
    C.lds = (LAS unsigned char*)lds_raw; C.tid = threadIdx.x; C.lane = C.tid & 63; C.wave = __builtin_amdgcn_readfirstlane(C.tid >> 6);
    C.G = gridDim.x; { const int bx = blockIdx.x; C.vcu = (C.G % 8 == 0) ? (bx % 8) * (C.G / 8) + bx / 8 : bx; }
    C.gw = C.vcu * NWAVES + C.wave; C.NGW = C.G * NWAVES;
    unsigned char* ws = p.ws; gu32* ctl = (gu32*)(ws + WS_CTL);
    volatile LAS unsigned* MISC = (volatile LAS unsigned*)(C.lds + MISC_OFF);
    for (int u = C.tid; u < (LDS_BYTES - LDSCTL_OFF) / 4; u += NWAVES * 64) ((LAS unsigned*)(C.lds + LDSCTL_OFF))[u] = 0u;
    __syncthreads();
    XcdBarrier bar = xcd_barrier_post((unsigned*)(ctl + CW_BAR), MISC + 8);
#define GRID_BAR() xcd_barrier(bar)
    const int bx = (int)blockIdx.x;
    bf16* XB = (bf16*)(ws + WS_XB); bf16* OB = (bf16*)(ws + WS_O); bf16* MIX = (bf16*)(ws + WS_MIX);
    float* KV = (float*)(ws + WS_XB); const float* rope = (const float*)(ws + WS_ROPE);

    p0_prologue(C, p.in, ws);
    GRID_BAR();
    { pg8::Gemm g{XB, (const bf16*)(ws + WS_WIN), MTOK, D_IN, DM}; pg8::StaticOrder S; S.init(MTOK, D_IN, C.G, bx);
      pg8::EpiPlain E{(bf16*)(ws + WS_H), D_IN, 0, 0};
      pg8::gemm_phase<pg8::EpiPlain, pg8::StaticOrder, true, true>(C.lds, g, S, E); }
    GRID_BAR();
    sb_phase(C, (const bf16*)(ws + WS_H), OB);
    ret_kv_phase(C, (const bf16*)(ws + WS_H), rope, KV);
    GRID_BAR();
    ret_scan_phase(C, KV);
    GRID_BAR();
    ret_out_phase(C, (const bf16*)(ws + WS_H), rope, KV, p.in[4], OB);
    GRID_BAR();
    { pg8::Gemm g{OB, (const bf16*)(ws + WS_WO0), MTOK, DM, DM}; pg8::StaticOrder S; S.init(MTOK, DM, C.G, bx);
      pg8::EpiPlain E{MIX, DM, 0, 0};
      pg8::gemm_phase<pg8::EpiPlain, pg8::StaticOrder, true, true>(C.lds, g, S, E); }
    GRID_BAR();
    ln_phase<0, true>(C, p.in[0], MIX, p.in[1], p.in[2], nullptr, XB, nullptr, nullptr, ws);
    GRID_BAR();
    { pg8::Gemm g{XB, (const bf16*)(ws + WS_WGU0), MTOK, 2 * FF0, DM}; pg8::StaticOrder S; S.init(MTOK, 2 * FF0, C.G, bx);
      pg8::EpiSwiGLU E{(bf16*)(ws + WS_HID0), FF0, 0, 0};
      pg8::gemm_phase<pg8::EpiSwiGLU, pg8::StaticOrder, true, true>(C.lds, g, S, E); }
    GRID_BAR();
    { pg8::Gemm g{(const bf16*)(ws + WS_HID0), (const bf16*)(ws + WS_WDN0), MTOK, DM, FF0}; pg8::StaticOrder S; S.init(MTOK, DM, C.G, bx);
      pg8::EpiPlain E{MIX, DM, 0, 0};
      pg8::gemm_phase<pg8::EpiPlain, pg8::StaticOrder, true, true>(C.lds, g, S, E); }
    GRID_BAR();
    ln_phase<0, false>(C, XB, MIX, p.in[6], p.in[7], nullptr, XB, nullptr, nullptr, ws);
    GRID_BAR();
    { pg8::Gemm g{XB, (const bf16*)(ws + WS_WQKV), MTOK, NQKV, DM}; pg8::StaticOrder S; S.init(MTOK, NQKV, C.G, bx);
      pg8::EpiPlain E{(bf16*)(ws + WS_QKV), NQKV, 0, 0};
      pg8::gemm_phase<pg8::EpiPlain, pg8::StaticOrder, true, true>(C.lds, g, S, E); }
    GRID_BAR();
    chunk_attn_phase(C, (const bf16*)(ws + WS_QKV), p.in[14], OB);
    GRID_BAR();
    { pg8::Gemm g{OB, (const bf16*)(ws + WS_WO1), MTOK, DM, DM}; pg8::StaticOrder S; S.init(MTOK, DM, C.G, bx);
      pg8::EpiPlain E{MIX, DM, 0, 0};
      pg8::gemm_phase<pg8::EpiPlain, pg8::StaticOrder, true, true>(C.lds, g, S, E); }
    GRID_BAR();
    ln_phase<1, false>(C, XB, MIX, p.in[11], p.in[12], nullptr, XB, p.in[18], p.in[19], ws);
    GRID_BAR();
    moe_assign(C, ws, ctl);
    GRID_BAR();
    const int ntile = (int)__builtin_amdgcn_readfirstlane(__hip_atomic_load(ctl + CW_NTILES, RLX_AGENT));
    moe_gather(C, ws, ntile);
    GRID_BAR();
    for (int t0 = 0; t0 < ntile; t0 += MOE_SLICE) {
        const int nT = (ntile - t0) < MOE_SLICE ? (ntile - t0) : MOE_SLICE;
        { pg8::Gemm g{(const bf16*)(ws + WS_AMOE), (const bf16*)(ws + WS_WGU1), MOE_ROWS, 2 * FF1, DM}; MoeOrder S; S.init(t0, nT, 2 * FF1 / 256, C.G, bx, (const gu32*)(ws + WS_TILE));
          pg8::EpiSwiGLU E{(bf16*)(ws + WS_HSL), FF1, 2 * FF1 / 256, t0};
          pg8::gemm_phase<pg8::EpiSwiGLU, MoeOrder, true, true>(C.lds, g, S, E); }
        GRID_BAR();
        { pg8::Gemm g{(const bf16*)(ws + WS_HSL) - (size_t)t0 * 256 * FF1, (const bf16*)(ws + WS_WDN1), MOE_ROWS, DM, FF1}; MoeOrder S; S.init(t0, nT, DM / 256, C.G, bx, (const gu32*)(ws + WS_TILE));
          pg8::EpiPlain E{(bf16*)(ws + WS_AMOE), DM, DM / 256, 0};
          pg8::gemm_phase<pg8::EpiPlain, MoeOrder, true, true>(C.lds, g, S, E); }
        GRID_BAR();
    }
    ln_phase<2, false>(C, XB, (const bf16*)(ws + WS_AMOE), p.in[16], p.in[17], p.out, nullptr, nullptr, nullptr, ws);
#undef GRID_BAR
}

extern "C" void kernel_launch(void* const* d_in, const int* in_sizes, int n_in, void* d_out, int out_size, void* d_ws, size_t ws_size, hipStream_t stream) {
    static int grid = 0;
    if (grid == 0) {
        if (n_in != 23 || in_sizes[0] != MTOK * DM || out_size != MTOK * DM || ws_size < WS_END) {
            fprintf(stderr, "kernel_launch: unexpected shapes/workspace (n_in %d, in0 %d, out %d, ws %zu, need %zu); nothing launched\n", n_in, n_in > 0 ? in_sizes[0] : -1, out_size, ws_size, (size_t)WS_END); grid = -1; return; }
        int dev = 0, cus = 0, per_cu = 0;
        if (hipGetDevice(&dev) != hipSuccess || hipDeviceGetAttribute(&cus, hipDeviceAttributeMultiprocessorCount, dev) != hipSuccess) { grid = -1; return; }
        if (hipFuncSetAttribute((const void*)fwd_kernel, hipFuncAttributeMaxDynamicSharedMemorySize, LDS_BYTES) != hipSuccess) { fprintf(stderr, "kernel_launch: hipFuncSetAttribute failed\n"); grid = -1; return; }
        if (hipOccupancyMaxActiveBlocksPerMultiprocessor(&per_cu, (const void*)fwd_kernel, NWAVES * 64, LDS_BYTES) != hipSuccess || per_cu < 1)
            fprintf(stderr, "kernel_launch: note: occupancy query reports %d workgroups per CU\n", per_cu);
        (void)hipGetLastError();
        grid = cus;
    }
    if (grid < 0) return;
    if (hipMemsetAsync((char*)d_ws + WS_CTL, 0, CTL_ZERO_BYTES, stream) != hipSuccess) return;
    Params p{};
    for (int i = 0; i < 23; ++i) p.in[i] = (const float*)d_in[i];
    p.out = (float*)d_out; p.ws = (unsigned char*)d_ws;
    hipLaunchKernelGGL(fwd_kernel, dim3(grid), dim3(NWAVES * 64), LDS_BYTES, stream, p);
}
```

```cpp
#include <hip/hip_runtime.h>
#include <cstdio>
#include <cstdint>
namespace pg8 {
#define PG8_LAS __attribute__((address_space(3)))
typedef unsigned short bf16_t;
typedef short bf16x8 __attribute__((ext_vector_type(8)));
typedef float f32x4 __attribute__((ext_vector_type(4)));
typedef unsigned u32x4 __attribute__((ext_vector_type(4)));
constexpr int BM = 256, BK = 64, HALF = 128, HTB = HALF * BK * 2  , STAGE_BYTES = 8 * HTB, NXCD = 8, WGM = 8;

__host__ __device__ __forceinline__ int lds_byte(int r, int c) { const int st = (r >> 4) * 2 + (c >> 5), rr = r & 15, cc = c & 31, ob = rr * 64 + cc * 2; return st * 1024 + (ob ^ (((ob >> 9) & 1) << 5)); }
__host__ __device__ __forceinline__ void stage_rc(int b, int& R, int& C) { const int st = b / 1024, sb = b % 1024, swz = sb ^ (((sb >> 9) & 1) << 5); R = (st >> 1) * 16 + swz / 64; C = (st & 1) * 32 + (swz % 64) / 2; }
__host__ __device__ __forceinline__ int perm32(int rho) { const int n = rho >> 4, i = rho & 15; return 8 * (i >> 2) + 4 * n + (i & 3); }

struct Unit { int pm, pn; };
struct Gemm { const bf16_t* A; const bf16_t* Bt; int M, N, K; };

struct StaticOrder {
    int nM, nN, nwg, G, c;
    __host__ __device__ void init(int M, int N, int G_, int c_) { nM = M / BM; nN = N / BM; nwg = nM * nN; G = G_; c = c_; }
    __host__ __device__ bool next(int i, Unit& u) const {
        const long L = (long)i * G + c; if (L >= nwg) return false;
        int wgid = (int)L; { const int q = nwg / NXCD, r = nwg % NXCD, xcd = wgid % NXCD, off = wgid / NXCD; wgid = (xcd < r ? xcd * (q + 1) : r * (q + 1) + (xcd - r) * q) + off; }
        const int nig = WGM * nN, gid = wgid / nig, fm = gid * WGM, gsz = (nM - fm) < WGM ? (nM - fm) : WGM;
        u.pm = fm + ((wgid % nig) % gsz); u.pn = (wgid % nig) / gsz; return true;
    }
    __device__ __forceinline__ void a_ready(const Unit&) const {}
    __device__ __forceinline__ void done(const Unit&) const {}
};
__device__ __forceinline__ unsigned cvt_pk_bf16(float lo, float hi) { unsigned r; asm volatile("v_cvt_pk_bf16_f32 %0, %1, %2" : "=v"(r) : "v"(lo), "v"(hi)); return r; }
typedef float f32x2 __attribute__((ext_vector_type(2)));
__device__ __forceinline__ float silu_mul(float g, float u) { const float e = __builtin_amdgcn_exp2f(g * -1.44269504089f); return g * u * __builtin_amdgcn_rcpf(1.0f + e); }
struct EpiPlain {
    static constexpr bool PERM = true, AFTER_DRAIN = false;
    bf16_t* O; int ldc; int pn_mod; int pm_sub;
    __device__ __forceinline__ void operator()(const f32x4 (&acc)[2][2][4][2], const Unit& u, int wr, int wc, int fr, int fq) const {
        const int pn = pn_mod ? (u.pn % pn_mod) : u.pn;
        const int row0 = (u.pm - pm_sub) * BM + wr * 64 + fr, col0 = pn * BM + wc * 32 + 8 * fq;
#pragma unroll
        for (int ai = 0; ai < 2; ++ai)
#pragma unroll
            for (int m = 0; m < 4; ++m) { bf16_t* rowp = O + (size_t)(row0 + ai * HALF + m * 16) * ldc + col0;
#pragma unroll
                for (int bj = 0; bj < 2; ++bj) { const f32x4 v0 = acc[ai][bj][m][0], v1 = acc[ai][bj][m][1];
                    u32x4 w; w.x = cvt_pk_bf16(v0[0], v0[1]); w.y = cvt_pk_bf16(v0[2], v0[3]); w.z = cvt_pk_bf16(v1[0], v1[1]); w.w = cvt_pk_bf16(v1[2], v1[3]);
                    *(u32x4*)(rowp + bj * HALF) = w; } }
    }
};
struct EpiSwiGLU {
    static constexpr bool PERM = true, AFTER_DRAIN = false;
    bf16_t* O; int ldc; int pn_mod; int pm_sub;
    __device__ __forceinline__ void operator()(const f32x4 (&acc)[2][2][4][2], const Unit& u, int wr, int wc, int fr, int fq) const {
        const int pn = pn_mod ? (u.pn % pn_mod) : u.pn;
        const int row0 = (u.pm - pm_sub) * BM + wr * 64 + fr, col0 = pn * HALF + wc * 32 + 8 * fq;
#pragma unroll
        for (int ai = 0; ai < 2; ++ai)
#pragma unroll
            for (int m = 0; m < 4; ++m) { bf16_t* rowp = O + (size_t)(row0 + ai * HALF + m * 16) * ldc + col0;
                const f32x4 g0 = acc[ai][0][m][0], g1 = acc[ai][0][m][1], u0 = acc[ai][1][m][0], u1 = acc[ai][1][m][1];
                u32x4 w; w.x = cvt_pk_bf16(silu_mul(g0[0], u0[0]), silu_mul(g0[1], u0[1])); w.y = cvt_pk_bf16(silu_mul(g0[2], u0[2]), silu_mul(g0[3], u0[3]));
                w.z = cvt_pk_bf16(silu_mul(g1[0], u1[0]), silu_mul(g1[1], u1[1])); w.w = cvt_pk_bf16(silu_mul(g1[2], u1[2]), silu_mul(g1[3], u1[3]));
                *(u32x4*)rowp = w; }
    }
};
typedef int i32x4_t __attribute__((ext_vector_type(4)));
typedef int i32x8_t __attribute__((ext_vector_type(8)));
typedef unsigned u32x2_t __attribute__((ext_vector_type(2)));
__device__ __forceinline__ i32x8_t cat8(bf16x8 a, bf16x8 b) { const i32x4_t x = __builtin_bit_cast(i32x4_t, a), y = __builtin_bit_cast(i32x4_t, b); return __builtin_shufflevector(x, y, 0, 1, 2, 3, 4, 5, 6, 7); }
__device__ __forceinline__ unsigned pk4_fp8(float a, float b, float c, float d) { int w = __builtin_amdgcn_cvt_pk_fp8_f32(a, b, 0, false); w = __builtin_amdgcn_cvt_pk_fp8_f32(c, d, w, true); return (unsigned)w; }
struct EpiSwiGLU8 {
    static constexpr bool PERM = true, AFTER_DRAIN = false;
    unsigned char* O; int ldc; int pn_mod; int pm_sub; const float* sa; const float* sb;
    __device__ __forceinline__ void operator()(const f32x4 (&acc)[2][2][4][2], const Unit& u, int wr, int wc, int fr, int fq) const {
        const int pn = u.pn % pn_mod;
        const int row0 = u.pm * BM + wr * 64 + fr, col0 = pn * HALF + wc * 32 + 8 * fq, bcol = u.pn * BM + wc * 32 + 8 * fq;
        const f32x4 sg0 = *(const f32x4*)(sb + bcol), sg1 = *(const f32x4*)(sb + bcol + 4), su0 = *(const f32x4*)(sb + bcol + HALF), su1 = *(const f32x4*)(sb + bcol + HALF + 4);
#pragma unroll
        for (int ai = 0; ai < 2; ++ai)
#pragma unroll
            for (int m = 0; m < 4; ++m) { const int r = row0 + ai * HALF + m * 16; const float a = sa[r];
                const f32x4 g0 = acc[ai][0][m][0] * (sg0 * a), g1 = acc[ai][0][m][1] * (sg1 * a), u0 = acc[ai][1][m][0] * (su0 * a), u1 = acc[ai][1][m][1] * (su1 * a);
                u32x2_t w; w.x = pk4_fp8(silu_mul(g0[0], u0[0]), silu_mul(g0[1], u0[1]), silu_mul(g0[2], u0[2]), silu_mul(g0[3], u0[3]));
                w.y = pk4_fp8(silu_mul(g1[0], u1[0]), silu_mul(g1[1], u1[1]), silu_mul(g1[2], u1[2]), silu_mul(g1[3], u1[3]));
                *(u32x2_t*)(O + (size_t)(r - pm_sub * BM) * ldc + col0) = w; }
    }
};
struct EpiPlain8 {
    static constexpr bool PERM = true, AFTER_DRAIN = false;
    bf16_t* O; int ldc; int pn_mod; const float* sb;
    __device__ __forceinline__ void operator()(const f32x4 (&acc)[2][2][4][2], const Unit& u, int wr, int wc, int fr, int fq) const {
        const int pn = u.pn % pn_mod;
        const int row0 = u.pm * BM + wr * 64 + fr, col0 = pn * BM + wc * 32 + 8 * fq, bcol = u.pn * BM + wc * 32 + 8 * fq;
        f32x4 sv[2][2];
#pragma unroll
        for (int bj = 0; bj < 2; ++bj) { sv[bj][0] = *(const f32x4*)(sb + bcol + bj * HALF); sv[bj][1] = *(const f32x4*)(sb + bcol + bj * HALF + 4); }
#pragma unroll
        for (int ai = 0; ai < 2; ++ai)
#pragma unroll
            for (int m = 0; m < 4; ++m) { bf16_t* rowp = O + (size_t)(row0 + ai * HALF + m * 16) * ldc + col0;
#pragma unroll
                for (int bj = 0; bj < 2; ++bj) { const f32x4 v0 = acc[ai][bj][m][0] * sv[bj][0], v1 = acc[ai][bj][m][1] * sv[bj][1];
                    u32x4 w; w.x = cvt_pk_bf16(v0[0], v0[1]); w.y = cvt_pk_bf16(v0[2], v0[3]); w.z = cvt_pk_bf16(v1[0], v1[1]); w.w = cvt_pk_bf16(v1[2], v1[3]);
                    *(u32x4*)(rowp + bj * HALF) = w; } }
    }
};
template <class Epi, class Sched, bool ALIGN_EPI = false, bool SP2 = false, int DT = 0  >
__device__ __forceinline__ void gemm_phase(PG8_LAS unsigned char* lds, const Gemm g, const Sched& S, const Epi& E) {
    int tid_ = threadIdx.x; asm volatile("" : "+v"(tid_));
    const int tid = tid_, wid = __builtin_amdgcn_readfirstlane(tid >> 6), lane = tid & 63, wr = wid >> 2, wc = wid & 3, fr = lane & 15, fq = lane >> 4;
    const int K = g.K, nt = K / BK;
    unsigned voffA[2], voffB[2];
#pragma unroll
    for (int i = 0; i < 2; ++i) { int R, C; stage_rc(tid * 16 + i * 8192, R, C); const int Rb = Epi::PERM ? ((R & ~31) + perm32(R & 31)) : R;
        voffA[i] = (unsigned)(R * K + C) * 2u; voffB[i] = (unsigned)(Rb * K + C) * 2u; }
    const size_t kstep = (size_t)(BK * 2);
    const size_t hstep = (size_t)HALF * K * 2;
    const size_t tstep = 2 * hstep;
    const unsigned ldsw = (unsigned)wid * 1024u;
    const int aoff = lds_byte(wr * 64 + fr, fq * 8), boff = lds_byte(wc * 32 + fr, fq * 8);
#define PG8_SA(b, h) (((b) * 2 + (h)) * HTB)
#define PG8_SB(b, h) ((4 + (b) * 2 + (h)) * HTB)
#define PG8_STAGE(bufoff, gbase, voff) do { _Pragma("unroll") for (int _i = 0; _i < 2; ++_i) \
        __builtin_amdgcn_global_load_lds((const unsigned*)((const char*)(gbase) + (voff)[_i]), (PG8_LAS unsigned*)(lds + (bufoff) + ldsw + _i * 8192), 16, 0, 0); } while (0)
#define PG8_LDA(dst, b, h) do { _Pragma("unroll") for (int m = 0; m < 4; ++m) _Pragma("unroll") for (int k = 0; k < 2; ++k) dst[m][k] = *(const PG8_LAS bf16x8*)(lds + PG8_SA(b, h) + aoff + m * 2048 + k * 1024); } while (0)
#define PG8_LDB(dst, b, h) do { _Pragma("unroll") for (int n = 0; n < 2; ++n) _Pragma("unroll") for (int k = 0; k < 2; ++k) dst[n][k] = *(const PG8_LAS bf16x8*)(lds + PG8_SB(b, h) + boff + n * 2048 + k * 1024); } while (0)
#define PG8_MMA(ai, bj, At, Bt) do { __builtin_amdgcn_s_setprio(1); if constexpr (DT == 0) { _Pragma("unroll") for (int m = 0; m < 4; ++m) _Pragma("unroll") for (int n = 0; n < 2; ++n) _Pragma("unroll") for (int k = 0; k < 2; ++k) \
        acc[ai][bj][m][n] = __builtin_amdgcn_mfma_f32_16x16x32_bf16(Bt[n][k], At[m][k], acc[ai][bj][m][n], 0, 0, 0); } else { _Pragma("unroll") for (int m = 0; m < 4; ++m) _Pragma("unroll") for (int n = 0; n < 2; ++n) \
        asm volatile("v_mfma_f32_16x16x128_f8f6f4 %0, %1, %2, %0" : "+v"(acc[ai][bj][m][n]) : "v"(cat8(Bt[n][0], Bt[n][1])), "v"(cat8(At[m][0], At[m][1]))); } __builtin_amdgcn_s_setprio(0); } while (0)
#define PG8_WAIT_V(n) asm volatile("s_waitcnt vmcnt(" #n ")" ::: "memory")
#define PG8_WAIT_L(n) asm volatile("s_waitcnt lgkmcnt(" #n ")" ::: "memory")
#define PG8_BAR __builtin_amdgcn_s_barrier()
#define PG8_SCHED __builtin_amdgcn_sched_barrier(0)
    Unit cur, nxt; int ui = 0;
    if (!S.next(0, cur)) return;
    f32x4 acc[2][2][4][2];
#pragma unroll
    for (int a = 0; a < 2; ++a)
#pragma unroll
        for (int b = 0; b < 2; ++b)
#pragma unroll
            for (int m = 0; m < 4; ++m)
#pragma unroll
                for (int n = 0; n < 2; ++n) acc[a][b][m][n] = (f32x4){0.f, 0.f, 0.f, 0.f};
    bf16x8 At[4][2], B0[2][2], B1[2][2];
    const char* cA = (const char*)g.A + (size_t)cur.pm * tstep; const char* cB = (const char*)g.Bt + (size_t)cur.pn * tstep;
    S.a_ready(cur);
    if constexpr (SP2) {
        PG8_STAGE(PG8_SB(0, 0), cB, voffB); PG8_STAGE(PG8_SB(0, 1), cB + hstep, voffB); PG8_STAGE(PG8_SA(0, 0), cA, voffA); PG8_STAGE(PG8_SA(0, 1), cA + hstep, voffA);
        if (wr == 1) PG8_BAR;
        PG8_WAIT_V(2); PG8_BAR;
        PG8_STAGE(PG8_SB(1, 0), cB + kstep, voffB); PG8_STAGE(PG8_SA(1, 0), cA + kstep, voffA); PG8_STAGE(PG8_SB(1, 1), cB + hstep + kstep, voffB);
        PG8_WAIT_V(6); PG8_BAR;
    } else {
        PG8_STAGE(PG8_SB(0, 0), cB, voffB); PG8_STAGE(PG8_SA(0, 0), cA, voffA); PG8_STAGE(PG8_SB(0, 1), cB + hstep, voffB); PG8_STAGE(PG8_SA(0, 1), cA + hstep, voffA);
        if (wr == 1) PG8_BAR;
        PG8_WAIT_V(4); PG8_BAR;
        PG8_STAGE(PG8_SB(1, 0), cB + kstep, voffB); PG8_STAGE(PG8_SA(1, 0), cA + kstep, voffA); PG8_STAGE(PG8_SB(1, 1), cB + hstep + kstep, voffB);
        PG8_WAIT_V(6); PG8_BAR;
    }
    for (;;) {
        const bool has_next = S.next(ui + 1, nxt);
        const char* nA = has_next ? (const char*)g.A + (size_t)nxt.pm * tstep : cA; const char* nB = has_next ? (const char*)g.Bt + (size_t)nxt.pn * tstep : cB;
        for (int t = 0; t < nt; t += 2) {
            const bool last = (t == nt - 2);
            const char* a1 = cA + (size_t)(t + 1) * kstep;
            const char* a2 = last ? nA : cA + (size_t)(t + 2) * kstep; const char* b2 = last ? nB : cB + (size_t)(t + 2) * kstep;
            const char* a3 = a2 + kstep; const char* b3 = b2 + kstep;
            if (last && has_next) S.a_ready(nxt);
            if constexpr (SP2) {
            PG8_LDB(B0, 0, 0); PG8_LDB(B1, 0, 1); PG8_SCHED; PG8_LDA(At, 0, 0); PG8_STAGE(PG8_SA(1, 1), a1 + hstep, voffA);
            PG8_WAIT_V(8); PG8_WAIT_L(0); PG8_BAR; PG8_MMA(0, 0, At, B0); PG8_MMA(0, 1, At, B1); PG8_BAR; PG8_SCHED;
            PG8_LDA(At, 0, 1); PG8_STAGE(PG8_SB(0, 0), b2, voffB); PG8_STAGE(PG8_SB(0, 1), b2 + hstep, voffB); PG8_STAGE(PG8_SA(0, 0), a2, voffA);
            PG8_WAIT_V(8); PG8_WAIT_L(0); PG8_BAR; PG8_MMA(1, 0, At, B0); PG8_MMA(1, 1, At, B1); PG8_BAR; PG8_SCHED;
            PG8_LDB(B0, 1, 0); PG8_LDB(B1, 1, 1); PG8_SCHED; PG8_LDA(At, 1, 0); PG8_STAGE(PG8_SA(0, 1), a2 + hstep, voffA);
            PG8_WAIT_V(8); PG8_WAIT_L(0); PG8_BAR; PG8_MMA(0, 0, At, B0); PG8_MMA(0, 1, At, B1); PG8_BAR; PG8_SCHED;
            PG8_LDA(At, 1, 1); PG8_STAGE(PG8_SB(1, 0), b3, voffB); PG8_STAGE(PG8_SB(1, 1), b3 + hstep, voffB); PG8_STAGE(PG8_SA(1, 0), a3, voffA);
            PG8_WAIT_V(8); PG8_WAIT_L(0); PG8_BAR; PG8_MMA(1, 0, At, B0); PG8_MMA(1, 1, At, B1); PG8_BAR; PG8_SCHED;
            } else {
            PG8_LDB(B0, 0, 0); PG8_SCHED; PG8_LDA(At, 0, 0); PG8_STAGE(PG8_SA(1, 1), a1 + hstep, voffA);
            PG8_WAIT_L(8); PG8_BAR; PG8_WAIT_L(0); PG8_MMA(0, 0, At, B0); PG8_BAR; PG8_SCHED;
            PG8_LDB(B1, 0, 1); PG8_STAGE(PG8_SB(0, 0), b2, voffB);
            PG8_BAR; PG8_WAIT_L(0); PG8_MMA(0, 1, At, B1); PG8_BAR;
            PG8_LDA(At, 0, 1); PG8_STAGE(PG8_SA(0, 0), a2, voffA);
            PG8_BAR; PG8_WAIT_L(0); PG8_MMA(1, 0, At, B0); PG8_BAR; PG8_SCHED;
            PG8_STAGE(PG8_SB(0, 1), b2 + hstep, voffB);
            PG8_WAIT_V(6); PG8_BAR; PG8_MMA(1, 1, At, B1); PG8_BAR;
            PG8_LDB(B0, 1, 0); PG8_SCHED; PG8_LDA(At, 1, 0); PG8_STAGE(PG8_SA(0, 1), a2 + hstep, voffA);
            PG8_WAIT_L(8); PG8_BAR; PG8_WAIT_L(0); PG8_MMA(0, 0, At, B0); PG8_BAR; PG8_SCHED;
            PG8_LDB(B1, 1, 1); PG8_STAGE(PG8_SB(1, 0), b3, voffB);
            PG8_BAR; PG8_WAIT_L(0); PG8_MMA(0, 1, At, B1); PG8_BAR;
            PG8_LDA(At, 1, 1); PG8_STAGE(PG8_SA(1, 0), a3, voffA);
            PG8_BAR; PG8_WAIT_L(0); PG8_MMA(1, 0, At, B0); PG8_BAR; PG8_SCHED;
            PG8_STAGE(PG8_SB(1, 1), b3 + hstep, voffB);
            PG8_WAIT_V(6); PG8_BAR; PG8_MMA(1, 1, At, B1); PG8_BAR;
            }
        }
        if constexpr (DT == 1) {
            asm volatile("s_nop 15\n\ts_nop 15\n\ts_nop 15\n\ts_nop 15\n\ts_nop 15\n\ts_nop 15" : "+v"(acc[0][0][0][0]), "+v"(acc[0][0][0][1]), "+v"(acc[0][0][1][0]), "+v"(acc[0][0][1][1]), "+v"(acc[0][0][2][0]), "+v"(acc[0][0][2][1]), "+v"(acc[0][0][3][0]), "+v"(acc[0][0][3][1]));
            asm volatile("" : "+v"(acc[0][1][0][0]), "+v"(acc[0][1][0][1]), "+v"(acc[0][1][1][0]), "+v"(acc[0][1][1][1]), "+v"(acc[0][1][2][0]), "+v"(acc[0][1][2][1]), "+v"(acc[0][1][3][0]), "+v"(acc[0][1][3][1]));
            asm volatile("" : "+v"(acc[1][0][0][0]), "+v"(acc[1][0][0][1]), "+v"(acc[1][0][1][0]), "+v"(acc[1][0][1][1]), "+v"(acc[1][0][2][0]), "+v"(acc[1][0][2][1]), "+v"(acc[1][0][3][0]), "+v"(acc[1][0][3][1]));
            asm volatile("" : "+v"(acc[1][1][0][0]), "+v"(acc[1][1][0][1]), "+v"(acc[1][1][1][0]), "+v"(acc[1][1][1][1]), "+v"(acc[1][1][2][0]), "+v"(acc[1][1][2][1]), "+v"(acc[1][1][3][0]), "+v"(acc[1][1][3][1]));
        }
        if constexpr (ALIGN_EPI) { if (wr == 0) PG8_BAR; }
        if constexpr (!Epi::AFTER_DRAIN) { E(acc, cur, wr, wc, fr, fq); S.done(cur); }
        if (!has_next) break;
#pragma unroll
        for (int a = 0; a < 2; ++a)
#pragma unroll
            for (int b = 0; b < 2; ++b)
#pragma unroll
                for (int m = 0; m < 4; ++m)
#pragma unroll
                    for (int n = 0; n < 2; ++n) acc[a][b][m][n] = (f32x4){0.f, 0.f, 0.f, 0.f};
        cur = nxt; cA = nA; cB = nB; ++ui;
        if constexpr (ALIGN_EPI) { if (wr == 1) PG8_BAR; }
    }
    PG8_WAIT_V(0);
    if constexpr (!ALIGN_EPI) { if (wr == 0) PG8_BAR; }
    PG8_BAR;
    if constexpr (Epi::AFTER_DRAIN) { E.fused(acc, cur, wr, wc, fr, fq, lds, wid, lane); S.done(cur); }
#undef PG8_SA
#undef PG8_SB
#undef PG8_STAGE
#undef PG8_LDA
#undef PG8_LDB
#undef PG8_MMA
#undef PG8_WAIT_V
#undef PG8_WAIT_L
#undef PG8_BAR
#undef PG8_SCHED
}
}
#define GAS __attribute__((address_space(1)))
#define LAS __attribute__((address_space(3)))
typedef unsigned short bf16;
typedef unsigned v4u __attribute__((ext_vector_type(4)));
typedef float f32x4 __attribute__((ext_vector_type(4)));
typedef short bf16x8 __attribute__((ext_vector_type(8)));
typedef GAS unsigned gu32;
typedef GAS unsigned long long gu64;
#define RLX_AGENT __ATOMIC_RELAXED, __HIP_MEMORY_SCOPE_AGENT
#define LDS_WAIT() asm volatile("s_waitcnt lgkmcnt(0)" ::: "memory")
#define VM_WAIT() asm volatile("s_waitcnt vmcnt(0)" ::: "memory")
__device__ __forceinline__ unsigned long long rt() { return __builtin_amdgcn_s_memrealtime(); }
__device__ __forceinline__ unsigned f2bf(float f) { unsigned u = __builtin_bit_cast(unsigned, f); return (u + 0x7fffu + ((u >> 16) & 1u)) >> 16; }
__device__ __forceinline__ unsigned pk2(float lo, float hi) { return f2bf(lo) | (f2bf(hi) << 16); }

#define XB_TMO      128
#define XB_XCNT(j)  (256  + 64 * (j))
#define XB_XSUB(j)  (1280 + 64 * (j))
#define XB_XGEN(j)  (2304 + 64 * (j))
#define XB_TOP      3328
#define XB_TOPGEN   3392
#define XCD_BAR_WORDS 3456
#define XB_SPIN_CAP (1u << 18)

__device__ __forceinline__ unsigned xb_ld(unsigned* p)              { return __hip_atomic_load(p, __ATOMIC_RELAXED, __HIP_MEMORY_SCOPE_AGENT); }
__device__ __forceinline__ unsigned xb_add(unsigned* p, unsigned v) { return __hip_atomic_fetch_add(p, v, __ATOMIC_RELAXED, __HIP_MEMORY_SCOPE_AGENT); }
__device__ __forceinline__ unsigned xb_xcc_id() { return (unsigned)__builtin_amdgcn_s_getreg((3 << 11) | 20) & 0xFu; }
#define XB_SPIN(cond, bar) do { unsigned _sp = 0; while (cond) { __builtin_amdgcn_s_sleep(1); \
    if ((++_sp & 255u) == 0u) { if (xb_ld(&(bar)[XB_TMO])) break; if (_sp > XB_SPIN_CAP) { atomicAdd(&(bar)[XB_TMO], 1u); break; } } } } while (0)

struct XcdBarrier {
    unsigned* bar; unsigned x;
    volatile LAS unsigned* st;
};

__device__ __forceinline__ XcdBarrier xcd_barrier_post(unsigned* bar, volatile LAS unsigned* st) {
    XcdBarrier b; b.bar = bar; b.x = xb_xcc_id(); b.st = st;
    if (threadIdx.x == 0) (void)xb_add(&bar[XB_XCNT(b.x)], 1u);
    return b;
}
__device__ __forceinline__ void xcd_barrier_complete(unsigned* bar, unsigned x, unsigned& nloc, unsigned& nx) {
    const unsigned G = gridDim.x * gridDim.y * gridDim.z;
    unsigned sum, cnt, mine, sp = 0u;
    for (;;) {
        sum = 0u; cnt = 0u; mine = 0u;
#pragma unroll
        for (unsigned j = 0; j < 16; ++j) { const unsigned c = xb_ld(&bar[XB_XCNT(j)]); sum += c; cnt += (c > 0u) ? 1u : 0u; mine = (j == x) ? c : mine; }
        if (sum == G) break;
        __builtin_amdgcn_s_sleep(1);
        if ((++sp & 255u) == 0u) { if (xb_ld(&bar[XB_TMO])) break; if (sp > XB_SPIN_CAP) { atomicAdd(&bar[XB_TMO], 1u); break; } }
    }
    nloc = mine > 0u ? mine : 1u; nx = cnt > 0u ? cnt : 1u;
}

__device__ __forceinline__ void xcd_barrier(const XcdBarrier& b) {
    asm volatile("s_waitcnt vmcnt(0)" ::: "memory");
    __syncthreads();
    if (threadIdx.x == 0) {
        unsigned* bar = b.bar;
        __builtin_amdgcn_s_waitcnt(0);
        unsigned nloc = b.st[0], nx = b.st[1];
        if (nloc == 0u) { xcd_barrier_complete(bar, b.x, nloc, nx); b.st[0] = nloc; b.st[1] = nx; }
        const unsigned old = xb_add(&bar[XB_XSUB(b.x)], 1u);
        const unsigned gen = old / nloc;
        if (old + 1u == (gen + 1u) * nloc) {
            __builtin_amdgcn_fence(__ATOMIC_RELEASE, "agent");
            asm volatile("s_waitcnt vmcnt(0)" ::: "memory");
            const unsigned og = xb_add(&bar[XB_TOP], 1u);
            const unsigned tg = og / nx;
            if (og + 1u == (tg + 1u) * nx) xb_add(&bar[XB_TOPGEN], 1u);
            else XB_SPIN(xb_ld(&bar[XB_TOPGEN]) == tg, bar);
            __builtin_amdgcn_fence(__ATOMIC_ACQUIRE, "agent");
            xb_add(&bar[XB_XGEN(b.x)], 1u);
            asm volatile("s_waitcnt vmcnt(0)" ::: "memory");
        } else {
            XB_SPIN(xb_ld(&bar[XB_XGEN(b.x)]) == gen, bar);
            __builtin_amdgcn_fence(__ATOMIC_ACQUIRE, "agent");
            asm volatile("s_waitcnt vmcnt(0)" ::: "memory");
        }
    }
    __syncthreads();
}

constexpr int NWAVES = 8;
constexpr int BATCH = 16, SEQ = 4096, DM = 1024, MTOK = BATCH * SEQ;
constexpr int D_IN = 3584, FF0 = 2816, FF1 = 3584, NEXP = 8, NQKV = 3072;
constexpr int OFF_QSB = 0, OFF_KSB = 512, OFF_VSB = 1024, OFF_QR = 1536, OFF_KR = 2048, OFF_VR = 2560, OFF_GR = 3072;
constexpr float LN_EPS = 1e-5f, ALPHA = 1.41421356237309515f;
constexpr float LOG2E = 1.44269504088896341f, LN2 = 0.69314718055994531f;
constexpr int MOE_MAXTILES = 520, MOE_SLICE = 256, MOE_ROWS = MOE_MAXTILES * 256;

constexpr size_t MiB = 1u << 20;
constexpr size_t WS_CTL = 0, CTL_ZERO_BYTES = 1 * MiB;
constexpr size_t WS_TOKE = 1 * MiB;
constexpr size_t WS_TOKG = WS_TOKE + (size_t)MTOK * 4;
constexpr size_t WS_TOKS = WS_TOKG + (size_t)MTOK * 8;
constexpr size_t WS_PERM = WS_TOKS + (size_t)MTOK * 8;
constexpr size_t WS_WCNT = WS_PERM + (size_t)MOE_ROWS * 4;
constexpr size_t WS_TILE = WS_WCNT + 4096 * 8 * 4;
constexpr size_t WS_SBGU = WS_TILE + 4096;
constexpr size_t WS_SBDN = WS_SBGU + (size_t)NEXP * 2 * FF1 * 4;
constexpr size_t WS_XS = WS_SBDN + (size_t)NEXP * DM * 4;
constexpr size_t WS_SAS = WS_XS + (size_t)MTOK * 4;
static_assert(WS_SAS + (size_t)MOE_ROWS * 4 <= 5 * MiB, "misc map");
constexpr size_t WS_ROPE = 5 * MiB;
constexpr size_t WS_WIN = 6 * MiB, WS_WO0 = 13 * MiB, WS_WGU0 = 15 * MiB, WS_WDN0 = 26 * MiB, WS_WQKV = 32 * MiB, WS_WO1 = 38 * MiB;
constexpr size_t WS_WGU1Q = 40 * MiB, WS_WDN1Q = 96 * MiB;
constexpr size_t WS_XQ = 124 * MiB;
constexpr size_t WS_XB = 188 * MiB;
constexpr size_t WS_O = 316 * MiB;
constexpr size_t WS_BIG = 444 * MiB;
constexpr size_t WS_H = WS_BIG, WS_HID0 = WS_BIG, WS_QKV = WS_BIG;
constexpr size_t WS_MIX = WS_BIG + 352 * MiB;
constexpr size_t WS_AMOE = 316 * MiB;
constexpr size_t WS_Y = 446 * MiB;
constexpr size_t WS_HSL = 706 * MiB;
constexpr size_t WS_END = 930 * MiB;
static_assert(WS_WDN1Q + (size_t)NEXP * DM * FF1 <= WS_XQ && WS_HSL + (size_t)MOE_SLICE * 256 * FF1 <= WS_END && WS_MIX + (size_t)MTOK * DM * 2 <= WS_END, "ws map");
static_assert(WS_AMOE + (size_t)MOE_ROWS * DM <= WS_Y && WS_Y + (size_t)MOE_ROWS * DM * 2 <= WS_HSL && (size_t)MTOK * FF0 * 2 <= 352 * MiB && WS_BIG + (size_t)MTOK * D_IN * 2 <= WS_END, "ws map 2");
constexpr size_t OUT_WGU1 = 0, OUT_WDN1 = 112 * MiB;
constexpr int CW_BAR = 4096;
constexpr int CW_NTILES = 16384;

constexpr int RING_BYTES = 131072, LDSCTL_OFF = RING_BYTES, MISC_OFF = LDSCTL_OFF + 320, LDS_BYTES = 147456;
constexpr int TP = 144;

typedef short s16x4 __attribute__((ext_vector_type(4)));
typedef float f32x16 __attribute__((ext_vector_type(16)));
typedef unsigned u32x2 __attribute__((ext_vector_type(2)));
typedef float f32x2 __attribute__((ext_vector_type(2)));
typedef __bf16 bf16x2_t __attribute__((ext_vector_type(2)));
typedef int i32x2 __attribute__((ext_vector_type(2)));
typedef int i32x4 __attribute__((ext_vector_type(4)));

__device__ __forceinline__ unsigned cvtpk(float lo, float hi) { f32x2 v = {lo, hi}; bf16x2_t b = __builtin_convertvector(v, bf16x2_t); return __builtin_bit_cast(unsigned, b); }
__device__ __forceinline__ float bflo(unsigned w) { return __uint_as_float(w << 16); }
__device__ __forceinline__ float bfhi(unsigned w) { return __uint_as_float(w & 0xffff0000u); }
__device__ __forceinline__ float bfel(const v4u& a, int e) { const unsigned w = a[e >> 1]; return (e & 1) ? bfhi(w) : bflo(w); }
__device__ __forceinline__ int crow(int r, int hi) { return (r & 3) + 8 * (r >> 2) + 4 * hi; }
__device__ __forceinline__ float ex2(float x) { return __builtin_amdgcn_exp2f(x); }
__device__ __forceinline__ float lg2(float x) { return __builtin_amdgcn_logf(x); }
__device__ __forceinline__ f32x16 mfma32(bf16x8 x, bf16x8 y, f32x16 c) { return __builtin_amdgcn_mfma_f32_32x32x16_bf16(x, y, c, 0, 0, 0); }
__device__ __forceinline__ float wave_sum(float v) {
#pragma unroll
    for (int o = 1; o < 64; o <<= 1) v += __shfl_xor(v, o);
    return v;
}
typedef short v4i16_t __attribute__((ext_vector_type(4)));
__device__ __forceinline__ s16x4 trrd(const LAS unsigned char* p) { return __builtin_bit_cast(s16x4, __builtin_amdgcn_ds_read_tr16_b64_v4i16((LAS v4i16_t*)p)); }
__device__ __forceinline__ bf16x8 row_frag(const LAS unsigned char* tile, int r32, int hi, int dk) { return *(const LAS bf16x8*)(tile + r32 * TP + (16 * dk + 8 * hi) * 2); }
__device__ __forceinline__ bf16x8 tr_frag(const LAS unsigned char* tile, int rowA, int rowB, int cb, int lane) {
    const int q = (lane & 15) >> 2, p = lane & 3, blk = (lane >> 4) & 1;
    const int co = cb * 64 + blk * 32 + p * 8;
    const s16x4 lo = trrd(tile + (rowA + q) * TP + co), hi4 = trrd(tile + (rowB + q) * TP + co);
    return (bf16x8){lo[0], lo[1], lo[2], lo[3], hi4[0], hi4[1], hi4[2], hi4[3]};
}
__device__ __forceinline__ void load_tile32(const bf16* g, size_t ldg, LAS unsigned char* tile, int lane) {
#pragma unroll
    for (int i = 0; i < 4; ++i) { const int id = i * 64 + lane, row = id >> 3, ch = id & 7;
        const v4u v = *(const GAS v4u*)(g + (size_t)row * ldg + ch * 8); *(LAS v4u*)(tile + row * TP + ch * 16) = v; }
}
template <bool DECAY>
__device__ __forceinline__ void load_tile32_rot(const bf16* g, size_t ldg, const float* rope, int pos0, int j0, float l2g, LAS unsigned char* tile, int lane) {
#pragma unroll
    for (int i = 0; i < 2; ++i) { const int id = i * 64 + lane, row = id >> 2, ch = id & 3;
        const v4u a = *(const GAS v4u*)(g + (size_t)row * ldg + ch * 8), bq = *(const GAS v4u*)(g + (size_t)row * ldg + 32 + ch * 8);
        const float* rp = rope + (size_t)(pos0 + row) * 64 + ch * 8;
        const f32x4 c0 = *(const GAS f32x4*)rp, c1 = *(const GAS f32x4*)(rp + 4), s0 = *(const GAS f32x4*)(rp + 32), s1 = *(const GAS f32x4*)(rp + 36);
        const float sc = DECAY ? ex2((float)(63 - (j0 + row)) * l2g) : 1.0f;
        float o1[8], o2[8];
#pragma unroll
        for (int e = 0; e < 8; ++e) { const float x1 = bfel(a, e), x2 = bfel(bq, e), c = e < 4 ? c0[e & 3] : c1[e & 3], s = e < 4 ? s0[e & 3] : s1[e & 3];
            o1[e] = (x1 * c - x2 * s) * sc; o2[e] = (x1 * s + x2 * c) * sc; }
        v4u w1, w2;
#pragma unroll
        for (int e = 0; e < 4; ++e) { w1[e] = cvtpk(o1[2 * e], o1[2 * e + 1]); w2[e] = cvtpk(o2[2 * e], o2[2 * e + 1]); }
        *(LAS v4u*)(tile + row * TP + ch * 16) = w1; *(LAS v4u*)(tile + row * TP + 64 + ch * 16) = w2; }
}
__device__ __forceinline__ bf16x8 pack8(const float* w) { v4u t; t.x = cvtpk(w[0], w[1]); t.y = cvtpk(w[2], w[3]); t.z = cvtpk(w[4], w[5]); t.w = cvtpk(w[6], w[7]); return __builtin_bit_cast(bf16x8, t); }

struct Ctx { LAS unsigned char* lds; int tid, lane, wave, vcu, G, gw, NGW; };
__device__ __forceinline__ int launder(int x) { asm volatile("" : "+v"(x)); return x; }

__device__ __forceinline__ void p0_transpose_item(const float* W, int K, int N, bf16* WT, int rs128, int radd, LAS float* scr, int item, int lane) {
    const int nblk = N / 32, kb = item / nblk, nb = item % nblk, k0 = 64 * kb, n0 = 32 * nb;
    const int drow0 = (n0 >> 7) * rs128 + (n0 & 127) + radd;
#pragma unroll 8
    for (int i = 0; i < 32; ++i) { const int kk = 2 * i + (lane >> 5); scr[kk * 33 + (lane & 31)] = W[(size_t)(k0 + kk) * N + n0 + (lane & 31)]; }
    LDS_WAIT(); asm volatile("" ::: "memory");
    const int c = lane & 7;
#pragma unroll
    for (int j = 0; j < 4; ++j) { const int n = (lane >> 3) + 8 * j; const LAS float* s = scr + (8 * c) * 33 + n;
        v4u o; o.x = cvtpk(s[0 * 33], s[1 * 33]); o.y = cvtpk(s[2 * 33], s[3 * 33]); o.z = cvtpk(s[4 * 33], s[5 * 33]); o.w = cvtpk(s[6 * 33], s[7 * 33]);
        *(GAS v4u*)(WT + (size_t)(drow0 + n) * K + k0 + 8 * c) = o; }
    LDS_WAIT(); asm volatile("" ::: "memory");
}
__device__ __forceinline__ void p0_prologue(const Ctx& C, const float* const* in, unsigned char* ws, unsigned char* outb) {
    LAS float* scr = (LAS float*)(C.lds + C.wave * 16384);
    constexpr int I_WIN = 16 * (D_IN / 32), I_WO = 16 * 32, I_G0 = 16 * (FF0 / 32), I_D0 = (FF0 / 64) * 32, I_QKV = 16 * (NQKV / 32), I_ME = 16 * (FF1 / 32), I_MD = (FF1 / 64) * 32;
    static_assert(I_ME == 1792 && I_MD == 1792, "moe items");
    constexpr int NITEMS = I_WIN + I_WO + 2 * I_G0 + I_D0 + I_QKV + I_WO + NEXP * (2 * I_ME + I_MD);
    for (int it = C.gw; it < NITEMS; it += C.NGW) {
        int r = it;
        if (r < I_WIN) { p0_transpose_item(in[3], DM, D_IN, (bf16*)(ws + WS_WIN), 128, 0, scr, r, C.lane); continue; } r -= I_WIN;
        if (r < I_WO) { p0_transpose_item(in[5], DM, DM, (bf16*)(ws + WS_WO0), 128, 0, scr, r, C.lane); continue; } r -= I_WO;
        if (r < I_G0) { p0_transpose_item(in[8], DM, FF0, (bf16*)(ws + WS_WGU0), 256, 0, scr, r, C.lane); continue; } r -= I_G0;
        if (r < I_G0) { p0_transpose_item(in[9], DM, FF0, (bf16*)(ws + WS_WGU0), 256, 128, scr, r, C.lane); continue; } r -= I_G0;
        if (r < I_D0) { p0_transpose_item(in[10], FF0, DM, (bf16*)(ws + WS_WDN0), 128, 0, scr, r, C.lane); continue; } r -= I_D0;
        if (r < I_QKV) { p0_transpose_item(in[13], DM, NQKV, (bf16*)(ws + WS_WQKV), 128, 0, scr, r, C.lane); continue; } r -= I_QKV;
        if (r < I_WO) { p0_transpose_item(in[15], DM, DM, (bf16*)(ws + WS_WO1), 128, 0, scr, r, C.lane); continue; } r -= I_WO;
        if (r < NEXP * I_ME) { const int e = r / I_ME; p0_transpose_item(in[20] + (size_t)e * DM * FF1, DM, FF1, (bf16*)(outb + OUT_WGU1) + (size_t)e * 2 * FF1 * DM, 256, 0, scr, r % I_ME, C.lane); continue; } r -= NEXP * I_ME;
        if (r < NEXP * I_ME) { const int e = r / I_ME; p0_transpose_item(in[21] + (size_t)e * DM * FF1, DM, FF1, (bf16*)(outb + OUT_WGU1) + (size_t)e * 2 * FF1 * DM, 256, 128, scr, r % I_ME, C.lane); continue; } r -= NEXP * I_ME;
        { const int e = r / I_MD; p0_transpose_item(in[22] + (size_t)e * FF1 * DM, FF1, DM, (bf16*)(outb + OUT_WDN1) + (size_t)e * DM * FF1, 128, 0, scr, r % I_MD, C.lane); }
    }
    { const float* x = in[0]; bf16* xb = (bf16*)(ws + WS_XB); const size_t n8 = (size_t)MTOK * DM / 8;
      for (size_t i = (size_t)C.gw * 64 + C.lane; i < n8; i += (size_t)C.NGW * 64) {
          const f32x4 a = *(const GAS f32x4*)(x + 8 * i), b = *(const GAS f32x4*)(x + 8 * i + 4);
          v4u o; o.x = cvtpk(a[0], a[1]); o.y = cvtpk(a[2], a[3]); o.z = cvtpk(b[0], b[1]); o.w = cvtpk(b[2], b[3]); *(GAS v4u*)(xb + 8 * i) = o; } }
    { float* rope = (float*)(ws + WS_ROPE);
      for (int idx = C.gw * 64 + C.lane; idx < SEQ * 32; idx += C.NGW * 64) { const int pos = idx >> 5, i = idx & 31;
          double f = 1.0; for (int k = 0; k < i; ++k) f *= 0.74989420933245582;
          const float invf = (float)f, ang = (float)pos * invf;
          double rev = (double)ang * 0.15915494309189535; rev -= __builtin_rint(rev);
          rope[pos * 64 + i] = __builtin_amdgcn_cosf((float)rev); rope[pos * 64 + 32 + i] = __builtin_amdgcn_sinf((float)rev); } }
}


template <int NCH>
__device__ __forceinline__ void quant_rows_fp8(const Ctx& C, const bf16* src, int nrows, unsigned char* dst, float* scale) {
    constexpr int K = NCH * 512;
    for (int row = C.gw; row < nrows; row += C.NGW) {
        const GAS v4u* sp = (const GAS v4u*)(src + (size_t)row * K) + C.lane;
        v4u buf[NCH]; float am = 0.f;
#pragma unroll
        for (int i = 0; i < NCH; ++i) { buf[i] = sp[64 * i];
#pragma unroll
            for (int e = 0; e < 8; ++e) am = fmaxf(am, fabsf(bfel(buf[i], e))); }
#pragma unroll
        for (int o = 1; o < 64; o <<= 1) am = fmaxf(am, __shfl_xor(am, o));
        am = fmaxf(am, 1.0e-30f); const float inv = 384.0f / am;
        GAS u32x2* dp = (GAS u32x2*)(dst + (size_t)row * K) + C.lane;
#pragma unroll
        for (int i = 0; i < NCH; ++i) { u32x2 w;
            w.x = pg8::pk4_fp8(bfel(buf[i], 0) * inv, bfel(buf[i], 1) * inv, bfel(buf[i], 2) * inv, bfel(buf[i], 3) * inv);
            w.y = pg8::pk4_fp8(bfel(buf[i], 4) * inv, bfel(buf[i], 5) * inv, bfel(buf[i], 6) * inv, bfel(buf[i], 7) * inv); dp[64 * i] = w; }
        if (C.lane == 0) scale[row] = am * (1.0f / 384.0f);
    }
}

template <int MODE, bool XF32>
__device__ __forceinline__ void ln_phase(const Ctx& C, const void* xprev, const bf16* fsrc, const float* gam, const float* bet, float* xout, bf16* xb,
                                         const float* w_router, const float* b_router, unsigned char* ws) {
    const int lane = launder(C.lane);
    LAS float* wrT = (LAS float*)C.lds;
    if (MODE == 1) {
        for (int idx = C.tid; idx < DM * NEXP; idx += NWAVES * 64) { const int d = idx >> 3, e = idx & 7; wrT[e * DM + d] = w_router[idx]; }
        int* perm = (int*)(ws + WS_PERM);
        for (int idx = C.gw * 64 + lane; idx < MOE_ROWS; idx += C.NGW * 64) perm[idx] = -1;
        __syncthreads();
    }
    f32x4 gv[4], bv[4];
#pragma unroll
    for (int j = 0; j < 4; ++j) { gv[j] = ((const GAS f32x4*)gam)[lane + 64 * j]; bv[j] = ((const GAS f32x4*)bet)[lane + 64 * j]; }
    int cnt0 = 0, cnt1 = 0, cnt2 = 0, cnt3 = 0, cnt4 = 0, cnt5 = 0, cnt6 = 0, cnt7 = 0;
    for (int row = C.gw; row < MTOK; row += C.NGW) {
        f32x4 xin[4];
        if (XF32) { const GAS f32x4* xr = (const GAS f32x4*)((const float*)xprev + (size_t)row * DM) + lane;
#pragma unroll
            for (int j = 0; j < 4; ++j) xin[j] = xr[64 * j];
        } else { const GAS u32x2* xr = (const GAS u32x2*)((const bf16*)xprev + (size_t)row * DM) + lane;
#pragma unroll
            for (int j = 0; j < 4; ++j) { const u32x2 a = xr[64 * j]; xin[j] = (f32x4){bflo(a.x), bfhi(a.x), bflo(a.y), bfhi(a.y)}; } }
        f32x4 v[4];
        if (MODE == 2) {
            const i32x2 sl = *(const GAS i32x2*)(ws + WS_TOKS + (size_t)row * 8); const f32x2 gt = *(const GAS f32x2*)(ws + WS_TOKG + (size_t)row * 8);
            const GAS u32x2* y1 = (const GAS u32x2*)(fsrc + (size_t)sl.x * DM) + lane; const GAS u32x2* y2 = (const GAS u32x2*)(fsrc + (size_t)sl.y * DM) + lane;
#pragma unroll
            for (int j = 0; j < 4; ++j) { const u32x2 a = y1[64 * j], b = y2[64 * j]; const f32x4 xv = xin[j];
                v[j][0] = xv[0] * ALPHA + (gt.x * bflo(a.x) + gt.y * bflo(b.x)); v[j][1] = xv[1] * ALPHA + (gt.x * bfhi(a.x) + gt.y * bfhi(b.x));
                v[j][2] = xv[2] * ALPHA + (gt.x * bflo(a.y) + gt.y * bflo(b.y)); v[j][3] = xv[3] * ALPHA + (gt.x * bfhi(a.y) + gt.y * bfhi(b.y)); }
        } else {
            const GAS u32x2* mr = (const GAS u32x2*)(fsrc + (size_t)row * DM) + lane;
#pragma unroll
            for (int j = 0; j < 4; ++j) { const u32x2 a = mr[64 * j]; const f32x4 xv = xin[j];
                v[j][0] = xv[0] * ALPHA + bflo(a.x); v[j][1] = xv[1] * ALPHA + bfhi(a.x); v[j][2] = xv[2] * ALPHA + bflo(a.y); v[j][3] = xv[3] * ALPHA + bfhi(a.y); }
        }
        float s = 0.f;
#pragma unroll
        for (int j = 0; j < 4; ++j) s += (v[j][0] + v[j][1]) + (v[j][2] + v[j][3]);
        const float mean = wave_sum(s) * (1.0f / DM); float s2 = 0.f;
#pragma unroll
        for (int j = 0; j < 4; ++j) { v[j] = v[j] - mean; s2 += (v[j][0] * v[j][0] + v[j][1] * v[j][1]) + (v[j][2] * v[j][2] + v[j][3] * v[j][3]); }
        const float rstd = 1.0f / sqrtf(wave_sum(s2) * (1.0f / DM) + LN_EPS);
#pragma unroll
        for (int j = 0; j < 4; ++j) v[j] = v[j] * rstd * gv[j] + bv[j];
        if (MODE == 2) { GAS f32x4* xo = (GAS f32x4*)(xout + (size_t)row * DM) + lane;
#pragma unroll
            for (int j = 0; j < 4; ++j) xo[64 * j] = v[j]; }
        if (MODE != 2) { GAS u32x2* bo = (GAS u32x2*)(xb + (size_t)row * DM) + lane;
#pragma unroll
            for (int j = 0; j < 4; ++j) { u32x2 w; w.x = cvtpk(v[j][0], v[j][1]); w.y = cvtpk(v[j][2], v[j][3]); bo[64 * j] = w; } }
        if (MODE == 1) {
            float am = 0.f;
#pragma unroll
            for (int j = 0; j < 4; ++j) am = fmaxf(am, fmaxf(fmaxf(fabsf(v[j][0]), fabsf(v[j][1])), fmaxf(fabsf(v[j][2]), fabsf(v[j][3]))));
#pragma unroll
            for (int o = 1; o < 64; o <<= 1) am = fmaxf(am, __shfl_xor(am, o));
            am = fmaxf(am, 1.0e-30f); const float qi = 384.0f / am;
            GAS unsigned* xq = (GAS unsigned*)(ws + WS_XQ + (size_t)row * DM) + lane;
#pragma unroll
            for (int j = 0; j < 4; ++j) xq[64 * j] = pg8::pk4_fp8(v[j][0] * qi, v[j][1] * qi, v[j][2] * qi, v[j][3] * qi);
            if (lane == 0) *(GAS float*)(ws + WS_XS + (size_t)row * 4) = am * (1.0f / 384.0f);
            float lg[8];
#pragma unroll
            for (int e = 0; e < 8; ++e) { float a = 0.f;
#pragma unroll
                for (int j = 0; j < 4; ++j) { const f32x4 w = *(const LAS f32x4*)(wrT + e * DM + 4 * lane + 256 * j); a += (v[j][0] * w[0] + v[j][1] * w[1]) + (v[j][2] * w[2] + v[j][3] * w[3]); }
                lg[e] = wave_sum(a) + b_router[e]; }
            int e1 = 0; float v1 = lg[0];
#pragma unroll
            for (int e = 1; e < 8; ++e) if (lg[e] > v1) { v1 = lg[e]; e1 = e; }
            int e2 = -1; float v2 = -3.0e38f;
#pragma unroll
            for (int e = 0; e < 8; ++e) if (e != e1 && lg[e] > v2) { v2 = lg[e]; e2 = e; }
            const float g1 = 1.0f / (1.0f + __expf(v2 - v1)), g2 = 1.0f - g1;
            if (lane == 0) { *(GAS int*)(ws + WS_TOKE + (size_t)row * 4) = e1 | (e2 << 8); *(GAS f32x2*)(ws + WS_TOKG + (size_t)row * 8) = (f32x2){g1, g2}; }
            cnt0 += (e1 == 0) + (e2 == 0); cnt1 += (e1 == 1) + (e2 == 1); cnt2 += (e1 == 2) + (e2 == 2); cnt3 += (e1 == 3) + (e2 == 3);
            cnt4 += (e1 == 4) + (e2 == 4); cnt5 += (e1 == 5) + (e2 == 5); cnt6 += (e1 == 6) + (e2 == 6); cnt7 += (e1 == 7) + (e2 == 7);
        }
    }
    if (MODE == 1) {
        int myc = cnt0; myc = lane == 1 ? cnt1 : myc; myc = lane == 2 ? cnt2 : myc; myc = lane == 3 ? cnt3 : myc; myc = lane == 4 ? cnt4 : myc; myc = lane == 5 ? cnt5 : myc; myc = lane == 6 ? cnt6 : myc; myc = lane == 7 ? cnt7 : myc;
        if (lane < 8) *(GAS int*)(ws + WS_WCNT + ((size_t)C.gw * 8 + lane) * 4) = myc;
    }
}

__device__ __forceinline__ void moe_assign(const Ctx& C, unsigned char* ws, gu32* ctl) {
    const int lane = launder(C.lane);
    const GAS int* wcnt = (const GAS int*)(ws + WS_WCNT);
    int tot[8], pre[8];
#pragma unroll
    for (int e = 0; e < 8; ++e) { tot[e] = 0; pre[e] = 0; }
    for (int w = lane; w < C.NGW; w += 64) { const i32x4 a = *(const GAS i32x4*)(wcnt + w * 8), b = *(const GAS i32x4*)(wcnt + w * 8 + 4); const bool lo = w < C.gw;
        tot[0] += a.x; tot[1] += a.y; tot[2] += a.z; tot[3] += a.w; tot[4] += b.x; tot[5] += b.y; tot[6] += b.z; tot[7] += b.w;
        if (lo) { pre[0] += a.x; pre[1] += a.y; pre[2] += a.z; pre[3] += a.w; pre[4] += b.x; pre[5] += b.y; pre[6] += b.z; pre[7] += b.w; } }
    int off[9]; off[0] = 0;
#pragma unroll
    for (int e = 0; e < 8; ++e) {
#pragma unroll
        for (int o = 1; o < 64; o <<= 1) { tot[e] += __shfl_xor(tot[e], o); pre[e] += __shfl_xor(pre[e], o); }
        off[e + 1] = off[e] + ((tot[e] + 255) & ~255); }
    const GAS int* toke = (const GAS int*)(ws + WS_TOKE); GAS int* perm = (GAS int*)(ws + WS_PERM);
    int base[8];
#pragma unroll
    for (int e = 0; e < 8; ++e) base[e] = off[e] + pre[e];
    for (int i0 = 0; C.gw + i0 * C.NGW < MTOK; i0 += 64) {
        const int row = C.gw + (i0 + lane) * C.NGW; const bool live = row < MTOK;
        const int ee = live ? toke[row] : 0xffff; const int e1 = ee & 0xff, e2 = (ee >> 8) & 0xff;
        int s1 = 0, s2 = 0; const unsigned long long lower = (1ull << lane) - 1ull;
#pragma unroll
        for (int e = 0; e < 8; ++e) { const unsigned long long m1 = __ballot(live && e1 == e), m2 = __ballot(live && e2 == e);
            const int rank = __popcll(m1 & lower) + __popcll(m2 & lower);
            if (e1 == e) s1 = base[e] + rank; if (e2 == e) s2 = base[e] + rank;
            base[e] += __popcll(m1) + __popcll(m2); }
        if (live) { perm[s1] = row; perm[s2] = row; *(GAS i32x2*)(ws + WS_TOKS + (size_t)row * 8) = (i32x2){s1, s2}; }
    }
    if (C.gw == 0) {
        const int ntile = off[8] >> 8;
        for (int t = lane; t < 1024; t += 64) { int e = 0;
#pragma unroll
            for (int k = 1; k < 8; ++k) e += (t * 256 >= off[k]) ? 1 : 0;
            __hip_atomic_store((gu32*)(ws + WS_TILE) + t, (unsigned)(t < ntile ? e : 0), RLX_AGENT); }
        if (lane == 0) __hip_atomic_store(ctl + CW_NTILES, (unsigned)ntile, RLX_AGENT);
    }
}
__device__ __forceinline__ void moe_gather(const Ctx& C, unsigned char* ws, int ntile) {
    const GAS int* perm = (const GAS int*)(ws + WS_PERM); const unsigned char* xq = ws + WS_XQ; unsigned char* A = ws + WS_AMOE;
    const GAS float* xs = (const GAS float*)(ws + WS_XS); GAS float* sas = (GAS float*)(ws + WS_SAS);
    for (int s = C.gw; s < ntile * 256; s += C.NGW) { const int row = perm[s];
        v4u a = {0u, 0u, 0u, 0u}; float sc = 0.f;
        if (row >= 0) { a = ((const GAS v4u*)(xq + (size_t)row * DM))[C.lane]; sc = xs[row]; }
        ((GAS v4u*)(A + (size_t)s * DM))[C.lane] = a; if (C.lane == 0) sas[s] = sc; }
}
struct MoeOrder {
    int nM, nN, nwg, G, c, t0; const gu32* tile_expert;
    __device__ __forceinline__ void init(int t0_, int nT, int nN_, int G_, int c_, const gu32* te) { t0 = t0_; nM = nT; nN = nN_; nwg = nM * nN; G = G_; c = c_; tile_expert = te; }
    __device__ __forceinline__ bool next(int i, pg8::Unit& u) const {
        const long L = (long)i * G + c; if (L >= nwg) return false;
        int wgid = (int)L; { const int q = nwg / pg8::NXCD, r = nwg % pg8::NXCD, xcd = wgid % pg8::NXCD, off = wgid / pg8::NXCD; wgid = (xcd < r ? xcd * (q + 1) : r * (q + 1) + (xcd - r) * q) + off; }
        const int nig = pg8::WGM * nN, gid = wgid / nig, fm = gid * pg8::WGM, gsz = (nM - fm) < pg8::WGM ? (nM - fm) : pg8::WGM;
        const int pm = t0 + fm + ((wgid % nig) % gsz), pn = (wgid % nig) / gsz;
        const int e = (int)__builtin_amdgcn_readfirstlane(__hip_atomic_load(tile_expert + pm, RLX_AGENT));
        u.pm = pm; u.pn = e * nN + pn; return true;
    }
    __device__ __forceinline__ void a_ready(const pg8::Unit&) const {}
    __device__ __forceinline__ void done(const pg8::Unit&) const {}
};

__device__ __forceinline__ void sb_phase(const Ctx& C, const bf16* H, bf16* O) {
    LAS unsigned char* wl = C.lds + C.wave * 16384; LAS unsigned char* Kt = wl; LAS unsigned char* Vt = wl + 4608; LAS unsigned char* stg = wl + 9216;
    const int lane = launder(C.lane), r32 = lane & 31, hi = lane >> 5;
    for (int u = C.gw; u < BATCH * 8 * 128; u += C.NGW) {
        const int qt = u & 127, h = (u >> 7) & 7, b = u >> 10;
        const bf16* Hb = H + (size_t)b * SEQ * D_IN + h * 64;
        bf16x8 qf[4];
#pragma unroll
        for (int dk = 0; dk < 4; ++dk) qf[dk] = *(const GAS bf16x8*)(Hb + (size_t)(qt * 32 + r32) * D_IN + OFF_QSB + 16 * dk + 8 * hi);
        float R = 0.f; f32x16 oacc[2]; oacc[0] = f32x16{}; oacc[1] = f32x16{};
        for (int kt = qt; kt >= 0; --kt) {
            load_tile32(Hb + (size_t)(kt * 32) * D_IN + OFF_KSB, D_IN, Kt, lane); load_tile32(Hb + (size_t)(kt * 32) * D_IN + OFF_VSB, D_IN, Vt, lane);
            f32x16 acc = f32x16{};
#pragma unroll
            for (int dk = 0; dk < 4; ++dk) acc = mfma32(row_frag(Kt, r32, hi, dk), qf[dk], acc);
            const bool diag = (kt == qt);
            float z[16], lgv[16]; bool valid[16];
#pragma unroll
            for (int r = 0; r < 16; ++r) { z[r] = acc[r] * 0.125f; valid[r] = !diag || (crow(r, hi) < r32);
                const float e = ex2(-fabsf(z[r]) * LOG2E); const float sp = fmaxf(z[r], 0.f) + LN2 * lg2(1.0f + e); lgv[r] = valid[r] ? -sp : 0.f; }
            float G[4], PG[4], T[4];
#pragma unroll
            for (int g = 0; g < 4; ++g) { G[g] = (lgv[4 * g] + lgv[4 * g + 1]) + (lgv[4 * g + 2] + lgv[4 * g + 3]); PG[g] = __shfl_xor(G[g], 32); T[g] = G[g] + PG[g]; }
            float above[4]; above[3] = 0.f; above[2] = T[3]; above[1] = T[3] + T[2]; above[0] = T[3] + T[2] + T[1];
            float w[16];
#pragma unroll
            for (int g = 0; g < 4; ++g) { const float base = R + above[g] + (hi == 0 ? PG[g] : 0.f);
                float inc = 0.f;
#pragma unroll
                for (int i = 3; i >= 0; --i) { const int r = 4 * g + i; inc += lgv[r]; w[r] = valid[r] ? ex2((z[r] + base + inc) * LOG2E) : 0.f; } }
            R += (T[0] + T[1]) + (T[2] + T[3]);
            const bf16x8 pf0 = pack8(w), pf1 = pack8(w + 8);
#pragma unroll
            for (int db = 0; db < 2; ++db) {
                oacc[db] = mfma32(tr_frag(Vt, 4 * hi, 8 + 4 * hi, db, lane), pf0, oacc[db]);
                oacc[db] = mfma32(tr_frag(Vt, 16 + 4 * hi, 24 + 4 * hi, db, lane), pf1, oacc[db]); }
            if (__all(R < -88.0f)) break;
        }
#pragma unroll
        for (int db = 0; db < 2; ++db)
#pragma unroll
            for (int r = 0; r < 16; ++r) *(LAS unsigned short*)(stg + r32 * TP + (db * 32 + crow(r, hi)) * 2) = (unsigned short)cvtpk(oacc[db][r], 0.f);
#pragma unroll
        for (int i = 0; i < 4; ++i) { const int row = i * 8 + (lane >> 3), ch = lane & 7; const v4u v = *(const LAS v4u*)(stg + row * TP + ch * 16);
            *(GAS v4u*)(O + (size_t)(b * SEQ + qt * 32 + row) * DM + h * 64 + ch * 8) = v; }
    }
}

__device__ __forceinline__ void ret_kv_phase(const Ctx& C, const bf16* H, const float* rope, float* KV) {
    LAS unsigned char* wl = C.lds + C.wave * 16384; LAS unsigned char* Kt = wl; LAS unsigned char* Vt = wl + 4608;
    const int lane = launder(C.lane), r32 = lane & 31, hi = lane >> 5;
    for (int u = C.gw; u < BATCH * 8 * 64; u += C.NGW) {
        const int c = u & 63, h = (u >> 6) & 7, b = u >> 9;
        const float l2g = log1pf(-ex2((float)(-5 - h))) * LOG2E;
        const bf16* Hb = H + ((size_t)b * SEQ + c * 64) * D_IN + h * 64;
        f32x16 acc[2][2]; acc[0][0] = f32x16{}; acc[0][1] = f32x16{}; acc[1][0] = f32x16{}; acc[1][1] = f32x16{};
        for (int jh = 0; jh < 2; ++jh) {
            load_tile32_rot<true>(Hb + (size_t)(32 * jh) * D_IN + OFF_KR, D_IN, rope, c * 64 + 32 * jh, 32 * jh, l2g, Kt, lane);
            load_tile32(Hb + (size_t)(32 * jh) * D_IN + OFF_VR, D_IN, Vt, lane);
#pragma unroll
            for (int m = 0; m < 2; ++m) {
                bf16x8 kf[2], vf[2];
#pragma unroll
                for (int a = 0; a < 2; ++a) { kf[a] = tr_frag(Kt, 16 * m + 8 * hi, 16 * m + 8 * hi + 4, a, lane); vf[a] = tr_frag(Vt, 16 * m + 8 * hi, 16 * m + 8 * hi + 4, a, lane); }
#pragma unroll
                for (int a = 0; a < 2; ++a)
#pragma unroll
                    for (int b2 = 0; b2 < 2; ++b2) acc[a][b2] = mfma32(kf[a], vf[b2], acc[a][b2]);
            }
        }
        float* dst = KV + ((size_t)((b * 8 + h) * 64 + c)) * 4096;
#pragma unroll
        for (int a = 0; a < 2; ++a)
#pragma unroll
            for (int b2 = 0; b2 < 2; ++b2)
#pragma unroll
                for (int r = 0; r < 16; ++r) dst[(crow(r, hi) + 32 * a) * 64 + r32 + 32 * b2] = acc[a][b2][r];
    }
}
__device__ __forceinline__ void ret_scan_phase(const Ctx& C, float* KV) {
    for (int idx = C.gw * 64 + C.lane; idx < BATCH * 8 * 4096; idx += C.NGW * 64) {
        const int bh = idx >> 12, el = idx & 4095, h = bh & 7;
        const float dc = ex2(64.0f * log1pf(-ex2((float)(-5 - h))) * LOG2E);
        float* p = KV + (size_t)bh * 64 * 4096 + el; float st = 0.f;
        for (int c0 = 0; c0 < 64; c0 += 8) { float t[8];
#pragma unroll
            for (int k = 0; k < 8; ++k) t[k] = p[(size_t)(c0 + k) * 4096];
#pragma unroll
            for (int k = 0; k < 8; ++k) { p[(size_t)(c0 + k) * 4096] = st; st = st * dc + t[k]; } }
    }
}
__device__ __forceinline__ void ret_out_phase(const Ctx& C, const bf16* H, const float* rope, const float* KV, const float* gn_g, bf16* O) {
    LAS unsigned char* wl = C.lds + C.wave * 16384; LAS unsigned char* Kt = wl; LAS unsigned char* Vt = wl + 4608; LAS unsigned char* St = wl + 9216;
    LAS float* stf = (LAS float*)wl;
    const int lane = launder(C.lane), r32 = lane & 31, hi = lane >> 5;
    for (int u = C.gw; u < BATCH * 8 * 64 * 2; u += C.NGW) {
        const int ih = u & 1, c = (u >> 1) & 63, h = (u >> 7) & 7, b = u >> 10;
        const float l2g = log1pf(-ex2((float)(-5 - h))) * LOG2E;
        const bf16* Hb = H + ((size_t)b * SEQ + c * 64) * D_IN + h * 64;
        const int iq = 32 * ih + r32, pos = c * 64 + iq;
        bf16x8 qf[4];
        { v4u qr[4];
#pragma unroll
          for (int dk = 0; dk < 4; ++dk) qr[dk] = *(const GAS v4u*)(Hb + (size_t)iq * D_IN + OFF_QR + 16 * dk + 8 * hi);
#pragma unroll
          for (int dk = 0; dk < 2; ++dk) { const float* rp = rope + (size_t)pos * 64 + 16 * dk + 8 * hi;
              const f32x4 c0 = *(const GAS f32x4*)rp, c1 = *(const GAS f32x4*)(rp + 4), s0 = *(const GAS f32x4*)(rp + 32), s1 = *(const GAS f32x4*)(rp + 36);
              float o1[8], o2[8];
#pragma unroll
              for (int e = 0; e < 8; ++e) { const float x1 = bfel(qr[dk], e), x2 = bfel(qr[dk + 2], e), cc = e < 4 ? c0[e & 3] : c1[e & 3], ss = e < 4 ? s0[e & 3] : s1[e & 3];
                  o1[e] = (x1 * cc - x2 * ss) * 0.125f; o2[e] = (x1 * ss + x2 * cc) * 0.125f; }
              qf[dk] = pack8(o1); qf[dk + 2] = pack8(o2); } }
        f32x16 oacc[2]; oacc[0] = f32x16{}; oacc[1] = f32x16{};
        for (int jt = 0; jt <= ih; ++jt) {
            load_tile32_rot<false>(Hb + (size_t)(32 * jt) * D_IN + OFF_KR, D_IN, rope, c * 64 + 32 * jt, 32 * jt, 0.f, Kt, lane);
            load_tile32(Hb + (size_t)(32 * jt) * D_IN + OFF_VR, D_IN, Vt, lane);
            f32x16 acc = f32x16{};
#pragma unroll
            for (int dk = 0; dk < 4; ++dk) acc = mfma32(row_frag(Kt, r32, hi, dk), qf[dk], acc);
            float w[16];
#pragma unroll
            for (int r = 0; r < 16; ++r) { const int dl = iq - (32 * jt + crow(r, hi)); w[r] = dl >= 0 ? acc[r] * ex2((float)dl * l2g) : 0.f; }
            const bf16x8 pf0 = pack8(w), pf1 = pack8(w + 8);
#pragma unroll
            for (int eb = 0; eb < 2; ++eb) {
                oacc[eb] = mfma32(tr_frag(Vt, 4 * hi, 8 + 4 * hi, eb, lane), pf0, oacc[eb]);
                oacc[eb] = mfma32(tr_frag(Vt, 16 + 4 * hi, 24 + 4 * hi, eb, lane), pf1, oacc[eb]); }
        }
        f32x16 cacc[2]; cacc[0] = f32x16{}; cacc[1] = f32x16{};
        const float* Sg = KV + ((size_t)((b * 8 + h) * 64 + c)) * 4096;
        for (int half = 0; half < 2; ++half) {
#pragma unroll
            for (int i = 0; i < 4; ++i) { const int id = i * 64 + lane, row = id >> 3, ch = id & 7;
                const f32x4 a = *(const GAS f32x4*)(Sg + (size_t)(32 * half + row) * 64 + ch * 8), bb = *(const GAS f32x4*)(Sg + (size_t)(32 * half + row) * 64 + ch * 8 + 4);
                v4u t; t.x = cvtpk(a[0], a[1]); t.y = cvtpk(a[2], a[3]); t.z = cvtpk(bb[0], bb[1]); t.w = cvtpk(bb[2], bb[3]); *(LAS v4u*)(St + row * TP + ch * 16) = t; }
#pragma unroll
            for (int m2 = 0; m2 < 2; ++m2)
#pragma unroll
                for (int eb = 0; eb < 2; ++eb) cacc[eb] = mfma32(tr_frag(St, 16 * m2 + 8 * hi, 16 * m2 + 8 * hi + 4, eb, lane), qf[2 * half + m2], cacc[eb]);
        }
        const float dq = ex2((float)(iq + 1) * l2g);
        float x[2][16]; float s = 0.f;
#pragma unroll
        for (int eb = 0; eb < 2; ++eb)
#pragma unroll
            for (int r = 0; r < 16; ++r) { x[eb][r] = oacc[eb][r] + dq * cacc[eb][r]; s += x[eb][r]; }
        s += __shfl_xor(s, 32); const float mean = s * (1.0f / 64.0f); float s2 = 0.f;
#pragma unroll
        for (int eb = 0; eb < 2; ++eb)
#pragma unroll
            for (int r = 0; r < 16; ++r) { x[eb][r] -= mean; s2 += x[eb][r] * x[eb][r]; }
        s2 += __shfl_xor(s2, 32); const float rstd = 1.0f / sqrtf(s2 * (1.0f / 64.0f) + LN_EPS);
#pragma unroll
        for (int eb = 0; eb < 2; ++eb)
#pragma unroll
            for (int r = 0; r < 16; ++r) stf[r32 * 66 + 32 * eb + crow(r, hi)] = x[eb][r] * rstd;
#pragma unroll
        for (int i = 0; i < 4; ++i) { const int row = i * 8 + (lane >> 3), ch = lane & 7;
            const v4u gq = *(const GAS v4u*)(Hb + (size_t)(32 * ih + row) * D_IN + OFF_GR + ch * 8);
            const f32x4 g0 = *(const GAS f32x4*)(gn_g + h * 64 + ch * 8), g1 = *(const GAS f32x4*)(gn_g + h * 64 + ch * 8 + 4);
            float o[8];
#pragma unroll
            for (int e = 0; e < 8; ++e) { const float gate = bfel(gq, e), nv = stf[row * 66 + ch * 8 + e], gg = e < 4 ? g0[e & 3] : g1[e & 3];
                o[e] = gate * __builtin_amdgcn_rcpf(1.0f + ex2(-gate * LOG2E)) * nv * gg; }
            v4u t; t.x = cvtpk(o[0], o[1]); t.y = cvtpk(o[2], o[3]); t.z = cvtpk(o[4], o[5]); t.w = cvtpk(o[6], o[7]);
            *(GAS v4u*)(O + (size_t)(b * SEQ + c * 64 + 32 * ih + row) * DM + 512 + h * 64 + ch * 8) = t; }
    }
}

__device__ __forceinline__ void chunk_attn_phase(const Ctx& C, const bf16* QKV, const float* rel_bias, bf16* O) {
    LAS unsigned char* wl = C.lds + C.wave * 16384; LAS unsigned char* Kt = wl; LAS unsigned char* Vt = wl + 4608; LAS unsigned char* stg = wl + 9216; LAS float* tb = (LAS float*)(wl + 13824);
    const int lane = launder(C.lane), r32 = lane & 31, hi = lane >> 5;
    const float C1 = 0.125f * LOG2E;
    int cur_h = -1;
    for (int u = C.gw; u < BATCH * 16 * 128; u += C.NGW) {
        const int qt = u & 127, h = (u >> 7) & 15, b = u >> 11, c = qt >> 1, iq = 32 * (qt & 1) + r32;
        if (h != cur_h) { for (int i = lane; i < 513; i += 64) tb[i] = rel_bias[h * 513 + i] * LOG2E; cur_h = h; }
        const bf16* Qb = QKV + (size_t)b * SEQ * NQKV + h * 64;
        bf16x8 qf[4];
#pragma unroll
        for (int dk = 0; dk < 4; ++dk) qf[dk] = *(const GAS bf16x8*)(Qb + (size_t)(qt * 32 + r32) * NQKV + 16 * dk + 8 * hi);
        float m = -1.0e30f, l = 0.f; f32x16 oacc[2]; oacc[0] = f32x16{}; oacc[1] = f32x16{};
        const int kc0 = c - 8 < 0 ? 0 : c - 8;
        for (int kt = 2 * kc0; kt <= 2 * c + 1; ++kt) {
            const int kc = kt >> 1;
            load_tile32(Qb + (size_t)(kt * 32) * NQKV + 1024, NQKV, Kt, lane); load_tile32(Qb + (size_t)(kt * 32) * NQKV + 2048, NQKV, Vt, lane);
            f32x16 acc = f32x16{};
#pragma unroll
            for (int dk = 0; dk < 4; ++dk) acc = mfma32(row_frag(Kt, r32, hi, dk), qf[dk], acc);
            float sv[16];
            if (c - kc >= 5) { const float bc = tb[512];
#pragma unroll
                for (int r = 0; r < 16; ++r) sv[r] = acc[r] * C1 + bc;
            } else { const int dl = 64 * (c - kc) + iq - 32 * (kt & 1);
#pragma unroll
                for (int r = 0; r < 16; ++r) { int rel = dl - crow(r, hi); rel = rel > 256 ? 256 : rel; rel = rel < -256 ? -256 : rel; sv[r] = acc[r] * C1 + tb[rel + 256]; } }
            float tm = sv[0];
#pragma unroll
            for (int r = 1; r < 16; ++r) tm = fmaxf(tm, sv[r]);
            tm = fmaxf(tm, __shfl_xor(tm, 32));
            const float mn = fmaxf(m, tm), al = ex2(m - mn); m = mn;
            float ps = 0.f, w[16];
#pragma unroll
            for (int r = 0; r < 16; ++r) { w[r] = ex2(sv[r] - mn); ps += w[r]; }
            l = l * al + ps;
#pragma unroll
            for (int r = 0; r < 16; ++r) { oacc[0][r] *= al; oacc[1][r] *= al; }
            const bf16x8 pf0 = pack8(w), pf1 = pack8(w + 8);
#pragma unroll
            for (int db = 0; db < 2; ++db) {
                oacc[db] = mfma32(tr_frag(Vt, 4 * hi, 8 + 4 * hi, db, lane), pf0, oacc[db]);
                oacc[db] = mfma32(tr_frag(Vt, 16 + 4 * hi, 24 + 4 * hi, db, lane), pf1, oacc[db]); }
        }
        l += __shfl_xor(l, 32); const float inv = 1.0f / l;
#pragma unroll
        for (int db = 0; db < 2; ++db)
#pragma unroll
            for (int r = 0; r < 16; ++r) *(LAS unsigned short*)(stg + r32 * TP + (db * 32 + crow(r, hi)) * 2) = (unsigned short)cvtpk(oacc[db][r] * inv, 0.f);
#pragma unroll
        for (int i = 0; i < 4; ++i) { const int row = i * 8 + (lane >> 3), ch = lane & 7; const v4u v = *(const LAS v4u*)(stg + row * TP + ch * 16);
            *(GAS v4u*)(O + (size_t)(b * SEQ + qt * 32 + row) * DM + h * 64 + ch * 8) = v; }
    }
}

struct Params { const float* in[23]; float* out; unsigned char* ws; };
__global__ void __launch_bounds__(NWAVES * 64, 2) fwd_kernel(Params p) {
    extern __shared__ __attribute__((aligned(16))) unsigned char lds_raw[];
    Ctx C;
    C.lds = (LAS unsigned char*)lds_raw; C.tid = threadIdx.x; C.lane = C.tid & 63; C.wave = __builtin_amdgcn_readfirstlane(C.tid >> 6);
    C.G = gridDim.x; { const int bx = blockIdx.x; C.vcu = (C.G % 8 == 0) ? (bx % 8) * (C.G / 8) + bx / 8 : bx; }
    C.gw = C.vcu * NWAVES + C.wave; C.NGW = C.G * NWAVES;
    unsigned char* ws = p.ws; gu32* ctl = (gu32*)(ws + WS_CTL);
    volatile LAS unsigned* MISC = (volatile LAS unsigned*)(C.lds + MISC_OFF);
    for (int u = C.tid; u < (LDS_BYTES - LDSCTL_OFF) / 4; u += NWAVES * 64) ((LAS unsigned*)(C.lds + LDSCTL_OFF))[u] = 0u;
    __syncthreads();
    XcdBarrier bar = xcd_barrier_post((unsigned*)(ctl + CW_BAR), MISC + 8);
#define GRID_BAR() xcd_barrier(bar)
    const int bx = (int)blockIdx.x;
    bf16* XB = (bf16*)(ws + WS_XB); bf16* OB = (bf16*)(ws + WS_O); bf16* MIX = (bf16*)(ws + WS_MIX);
    float* KV = (float*)(ws + WS_XB); const float* rope = (const float*)(ws + WS_ROPE);

    p0_prologue(C, p.in, ws, (unsigned char*)p.out);
    GRID_BAR();
    quant_rows_fp8<2>(C, (const bf16*)((unsigned char*)p.out + OUT_WGU1), NEXP * 2 * FF1, ws + WS_WGU1Q, (float*)(ws + WS_SBGU));
    quant_rows_fp8<7>(C, (const bf16*)((unsigned char*)p.out + OUT_WDN1), NEXP * DM, ws + WS_WDN1Q, (float*)(ws + WS_SBDN));
    { pg8::Gemm g{XB, (const bf16*)(ws + WS_WIN), MTOK, D_IN, DM}; pg8::StaticOrder S; S.init(MTOK, D_IN, C.G, bx);
      pg8::EpiPlain E{(bf16*)(ws + WS_H), D_IN, 0, 0};
      pg8::gemm_phase<pg8::EpiPlain, pg8::StaticOrder, true, true>(C.lds, g, S, E); }
    GRID_BAR();
    sb_phase(C, (const bf16*)(ws + WS_H), OB);
    ret_kv_phase(C, (const bf16*)(ws + WS_H), rope, KV);
    GRID_BAR();
    ret_scan_phase(C, KV);
    GRID_BAR();
    ret_out_phase(C, (const bf16*)(ws + WS_H), rope, KV, p.in[4], OB);
    GRID_BAR();
    { pg8::Gemm g{OB, (const bf16*)(ws + WS_WO0), MTOK, DM, DM}; pg8::StaticOrder S; S.init(MTOK, DM, C.G, bx);
      pg8::EpiPlain E{MIX, DM, 0, 0};
      pg8::gemm_phase<pg8::EpiPlain, pg8::StaticOrder, true, true>(C.lds, g, S, E); }
    GRID_BAR();
    ln_phase<0, true>(C, p.in[0], MIX, p.in[1], p.in[2], nullptr, XB, nullptr, nullptr, ws);
    GRID_BAR();
    { pg8::Gemm g{XB, (const bf16*)(ws + WS_WGU0), MTOK, 2 * FF0, DM}; pg8::StaticOrder S; S.init(MTOK, 2 * FF0, C.G, bx);
      pg8::EpiSwiGLU E{(bf16*)(ws + WS_HID0), FF0, 0, 0};
      pg8::gemm_phase<pg8::EpiSwiGLU, pg8::StaticOrder, true, true>(C.lds, g, S, E); }
    GRID_BAR();
    { pg8::Gemm g{(const bf16*)(ws + WS_HID0), (const bf16*)(ws + WS_WDN0), MTOK, DM, FF0}; pg8::StaticOrder S; S.init(MTOK, DM, C.G, bx);
      pg8::EpiPlain E{MIX, DM, 0, 0};
      pg8::gemm_phase<pg8::EpiPlain, pg8::StaticOrder, true, true>(C.lds, g, S, E); }
    GRID_BAR();
    ln_phase<0, false>(C, XB, MIX, p.in[6], p.in[7], nullptr, XB, nullptr, nullptr, ws);
    GRID_BAR();
    { pg8::Gemm g{XB, (const bf16*)(ws + WS_WQKV), MTOK, NQKV, DM}; pg8::StaticOrder S; S.init(MTOK, NQKV, C.G, bx);
      pg8::EpiPlain E{(bf16*)(ws + WS_QKV), NQKV, 0, 0};
      pg8::gemm_phase<pg8::EpiPlain, pg8::StaticOrder, true, true>(C.lds, g, S, E); }
    GRID_BAR();
    chunk_attn_phase(C, (const bf16*)(ws + WS_QKV), p.in[14], OB);
    GRID_BAR();
    { pg8::Gemm g{OB, (const bf16*)(ws + WS_WO1), MTOK, DM, DM}; pg8::StaticOrder S; S.init(MTOK, DM, C.G, bx);
      pg8::EpiPlain E{MIX, DM, 0, 0};
      pg8::gemm_phase<pg8::EpiPlain, pg8::StaticOrder, true, true>(C.lds, g, S, E); }
    GRID_BAR();
    ln_phase<1, false>(C, XB, MIX, p.in[11], p.in[12], nullptr, XB, p.in[18], p.in[19], ws);
    GRID_BAR();
    moe_assign(C, ws, ctl);
    GRID_BAR();
    const int ntile = (int)__builtin_amdgcn_readfirstlane(__hip_atomic_load(ctl + CW_NTILES, RLX_AGENT));
    moe_gather(C, ws, ntile);
    GRID_BAR();
    for (int t0 = 0; t0 < ntile; t0 += MOE_SLICE) {
        const int nT = (ntile - t0) < MOE_SLICE ? (ntile - t0) : MOE_SLICE;
        { pg8::Gemm g{(const bf16*)(ws + WS_AMOE), (const bf16*)(ws + WS_WGU1Q), MOE_ROWS, 2 * FF1, DM / 2}; MoeOrder S; S.init(t0, nT, 2 * FF1 / 256, C.G, bx, (const gu32*)(ws + WS_TILE));
          pg8::EpiSwiGLU8 E{ws + WS_HSL, FF1, 2 * FF1 / 256, t0, (const float*)(ws + WS_SAS), (const float*)(ws + WS_SBGU)};
          pg8::gemm_phase<pg8::EpiSwiGLU8, MoeOrder, true, true, 1>(C.lds, g, S, E); }
        GRID_BAR();
        { pg8::Gemm g{(const bf16*)(ws + WS_HSL - (size_t)t0 * 256 * FF1), (const bf16*)(ws + WS_WDN1Q), MOE_ROWS, DM, FF1 / 2}; MoeOrder S; S.init(t0, nT, DM / 256, C.G, bx, (const gu32*)(ws + WS_TILE));
          pg8::EpiPlain8 E{(bf16*)(ws + WS_Y), DM, DM / 256, (const float*)(ws + WS_SBDN)};
          pg8::gemm_phase<pg8::EpiPlain8, MoeOrder, true, true, 1>(C.lds, g, S, E); }
        GRID_BAR();
    }
    ln_phase<2, false>(C, XB, (const bf16*)(ws + WS_Y), p.in[16], p.in[17], p.out, nullptr, nullptr, nullptr, ws);
#undef GRID_BAR
}

extern "C" void kernel_launch(void* const* d_in, const int* in_sizes, int n_in, void* d_out, int out_size, void* d_ws, size_t ws_size, hipStream_t stream) {
    static int grid = 0;
    if (grid == 0) {
        if (n_in != 23 || in_sizes[0] != MTOK * DM || out_size != MTOK * DM || ws_size < WS_END) {
            fprintf(stderr, "kernel_launch: unexpected shapes/workspace (n_in %d, in0 %d, out %d, ws %zu, need %zu); nothing launched\n", n_in, n_in > 0 ? in_sizes[0] : -1, out_size, ws_size, (size_t)WS_END); grid = -1; return; }
        int dev = 0, cus = 0, per_cu = 0;
        if (hipGetDevice(&dev) != hipSuccess || hipDeviceGetAttribute(&cus, hipDeviceAttributeMultiprocessorCount, dev) != hipSuccess) { grid = -1; return; }
        if (hipFuncSetAttribute((const void*)fwd_kernel, hipFuncAttributeMaxDynamicSharedMemorySize, LDS_BYTES) != hipSuccess) { fprintf(stderr, "kernel_launch: hipFuncSetAttribute failed\n"); grid = -1; return; }
        if (hipOccupancyMaxActiveBlocksPerMultiprocessor(&per_cu, (const void*)fwd_kernel, NWAVES * 64, LDS_BYTES) != hipSuccess || per_cu < 1)
            fprintf(stderr, "kernel_launch: note: occupancy query reports %d workgroups per CU\n", per_cu);
        (void)hipGetLastError();
        grid = cus;
    }
    if (grid < 0) return;
    if (hipMemsetAsync((char*)d_ws + WS_CTL, 0, CTL_ZERO_BYTES, stream) != hipSuccess) return;
    Params p{};
    for (int i = 0; i < 23; ++i) p.in[i] = (const float*)d_in[i];
    p.out = (float*)d_out; p.ws = (unsigned char*)d_ws;
    hipLaunchKernelGGL(fwd_kernel, dim3(grid), dim3(NWAVES * 64), LDS_BYTES, stream, p);
}
```

```cpp
#include <hip/hip_runtime.h>
#include <cstdio>
#include <cstdint>
namespace pg8 {
#define PG8_LAS __attribute__((address_space(3)))
typedef unsigned short bf16_t;
typedef short bf16x8 __attribute__((ext_vector_type(8)));
typedef float f32x4 __attribute__((ext_vector_type(4)));
typedef unsigned u32x4 __attribute__((ext_vector_type(4)));
constexpr int BM = 256, BK = 64, HALF = 128, HTB = HALF * BK * 2  , STAGE_BYTES = 8 * HTB, NXCD = 8, WGM = 8;

__host__ __device__ __forceinline__ int lds_byte(int r, int c) { const int st = (r >> 4) * 2 + (c >> 5), rr = r & 15, cc = c & 31, ob = rr * 64 + cc * 2; return st * 1024 + (ob ^ (((ob >> 9) & 1) << 5)); }
__host__ __device__ __forceinline__ void stage_rc(int b, int& R, int& C) { const int st = b / 1024, sb = b % 1024, swz = sb ^ (((sb >> 9) & 1) << 5); R = (st >> 1) * 16 + swz / 64; C = (st & 1) * 32 + (swz % 64) / 2; }
__host__ __device__ __forceinline__ int perm32(int rho) { const int n = rho >> 4, i = rho & 15; return 8 * (i >> 2) + 4 * n + (i & 3); }

struct Unit { int pm, pn; };
struct Gemm { const bf16_t* A; const bf16_t* Bt; int M, N, K; };

struct StaticOrder {
    int nM, nN, nwg, G, c;
    __host__ __device__ void init(int M, int N, int G_, int c_) { nM = M / BM; nN = N / BM; nwg = nM * nN; G = G_; c = c_; }
    __host__ __device__ bool next(int i, Unit& u) const {
        const long L = (long)i * G + c; if (L >= nwg) return false;
        int wgid = (int)L; { const int q = nwg / NXCD, r = nwg % NXCD, xcd = wgid % NXCD, off = wgid / NXCD; wgid = (xcd < r ? xcd * (q + 1) : r * (q + 1) + (xcd - r) * q) + off; }
        const int nig = WGM * nN, gid = wgid / nig, fm = gid * WGM, gsz = (nM - fm) < WGM ? (nM - fm) : WGM;
        u.pm = fm + ((wgid % nig) % gsz); u.pn = (wgid % nig) / gsz; return true;
    }
    __device__ __forceinline__ void a_ready(const Unit&) const {}
    __device__ __forceinline__ void done(const Unit&) const {}
};
__device__ __forceinline__ unsigned cvt_pk_bf16(float lo, float hi) { unsigned r; asm volatile("v_cvt_pk_bf16_f32 %0, %1, %2" : "=v"(r) : "v"(lo), "v"(hi)); return r; }
typedef float f32x2 __attribute__((ext_vector_type(2)));
__device__ __forceinline__ float silu_mul(float g, float u) { const float e = __builtin_amdgcn_exp2f(g * -1.44269504089f); return g * u * __builtin_amdgcn_rcpf(1.0f + e); }
struct EpiPlain {
    static constexpr bool PERM = true, AFTER_DRAIN = false;
    bf16_t* O; int ldc; int pn_mod; int pm_sub;
    __device__ __forceinline__ void operator()(const f32x4 (&acc)[2][2][4][2], const Unit& u, int wr, int wc, int fr, int fq) const {
        const int pn = pn_mod ? (u.pn % pn_mod) : u.pn;
        const int row0 = (u.pm - pm_sub) * BM + wr * 64 + fr, col0 = pn * BM + wc * 32 + 8 * fq;
#pragma unroll
        for (int ai = 0; ai < 2; ++ai)
#pragma unroll
            for (int m = 0; m < 4; ++m) { bf16_t* rowp = O + (size_t)(row0 + ai * HALF + m * 16) * ldc + col0;
#pragma unroll
                for (int bj = 0; bj < 2; ++bj) { const f32x4 v0 = acc[ai][bj][m][0], v1 = acc[ai][bj][m][1];
                    u32x4 w; w.x = cvt_pk_bf16(v0[0], v0[1]); w.y = cvt_pk_bf16(v0[2], v0[3]); w.z = cvt_pk_bf16(v1[0], v1[1]); w.w = cvt_pk_bf16(v1[2], v1[3]);
                    *(u32x4*)(rowp + bj * HALF) = w; } }
    }
};
struct EpiSwiGLU {
    static constexpr bool PERM = true, AFTER_DRAIN = false;
    bf16_t* O; int ldc; int pn_mod; int pm_sub;
    __device__ __forceinline__ void operator()(const f32x4 (&acc)[2][2][4][2], const Unit& u, int wr, int wc, int fr, int fq) const {
        const int pn = pn_mod ? (u.pn % pn_mod) : u.pn;
        const int row0 = (u.pm - pm_sub) * BM + wr * 64 + fr, col0 = pn * HALF + wc * 32 + 8 * fq;
#pragma unroll
        for (int ai = 0; ai < 2; ++ai)
#pragma unroll
            for (int m = 0; m < 4; ++m) { bf16_t* rowp = O + (size_t)(row0 + ai * HALF + m * 16) * ldc + col0;
                const f32x4 g0 = acc[ai][0][m][0], g1 = acc[ai][0][m][1], u0 = acc[ai][1][m][0], u1 = acc[ai][1][m][1];
                u32x4 w; w.x = cvt_pk_bf16(silu_mul(g0[0], u0[0]), silu_mul(g0[1], u0[1])); w.y = cvt_pk_bf16(silu_mul(g0[2], u0[2]), silu_mul(g0[3], u0[3]));
                w.z = cvt_pk_bf16(silu_mul(g1[0], u1[0]), silu_mul(g1[1], u1[1])); w.w = cvt_pk_bf16(silu_mul(g1[2], u1[2]), silu_mul(g1[3], u1[3]));
                *(u32x4*)rowp = w; }
    }
};
typedef int i32x4_t __attribute__((ext_vector_type(4)));
typedef int i32x8_t __attribute__((ext_vector_type(8)));
typedef unsigned u32x2_t __attribute__((ext_vector_type(2)));
__device__ __forceinline__ i32x8_t cat8(bf16x8 a, bf16x8 b) { const i32x4_t x = __builtin_bit_cast(i32x4_t, a), y = __builtin_bit_cast(i32x4_t, b); return __builtin_shufflevector(x, y, 0, 1, 2, 3, 4, 5, 6, 7); }
__device__ __forceinline__ unsigned pk4_fp8(float a, float b, float c, float d) { int w = __builtin_amdgcn_cvt_pk_fp8_f32(a, b, 0, false); w = __builtin_amdgcn_cvt_pk_fp8_f32(c, d, w, true); return (unsigned)w; }
struct EpiSwiGLU8 {
    static constexpr bool PERM = true, AFTER_DRAIN = false;
    unsigned char* O; int ldc; int pn_mod; int pm_sub; const float* sa; const float* sb;
    __device__ __forceinline__ void operator()(const f32x4 (&acc)[2][2][4][2], const Unit& u, int wr, int wc, int fr, int fq) const {
        const int pn = u.pn % pn_mod;
        const int row0 = u.pm * BM + wr * 64 + fr, col0 = pn * HALF + wc * 32 + 8 * fq, bcol = u.pn * BM + wc * 32 + 8 * fq;
        const f32x4 sg0 = *(const f32x4*)(sb + bcol), sg1 = *(const f32x4*)(sb + bcol + 4), su0 = *(const f32x4*)(sb + bcol + HALF), su1 = *(const f32x4*)(sb + bcol + HALF + 4);
#pragma unroll
        for (int ai = 0; ai < 2; ++ai)
#pragma unroll
            for (int m = 0; m < 4; ++m) { const int r = row0 + ai * HALF + m * 16; const float a = sa[r];
                const f32x4 g0 = acc[ai][0][m][0] * (sg0 * a), g1 = acc[ai][0][m][1] * (sg1 * a), u0 = acc[ai][1][m][0] * (su0 * a), u1 = acc[ai][1][m][1] * (su1 * a);
                u32x2_t w; w.x = pk4_fp8(silu_mul(g0[0], u0[0]), silu_mul(g0[1], u0[1]), silu_mul(g0[2], u0[2]), silu_mul(g0[3], u0[3]));
                w.y = pk4_fp8(silu_mul(g1[0], u1[0]), silu_mul(g1[1], u1[1]), silu_mul(g1[2], u1[2]), silu_mul(g1[3], u1[3]));
                *(u32x2_t*)(O + (size_t)(r - pm_sub * BM) * ldc + col0) = w; }
    }
};
struct EpiPlain8 {
    static constexpr bool PERM = true, AFTER_DRAIN = false;
    bf16_t* O; int ldc; int pn_mod; const float* sb;
    __device__ __forceinline__ void operator()(const f32x4 (&acc)[2][2][4][2], const Unit& u, int wr, int wc, int fr, int fq) const {
        const int pn = u.pn % pn_mod;
        const int row0 = u.pm * BM + wr * 64 + fr, col0 = pn * BM + wc * 32 + 8 * fq, bcol = u.pn * BM + wc * 32 + 8 * fq;
        f32x4 sv[2][2];
#pragma unroll
        for (int bj = 0; bj < 2; ++bj) { sv[bj][0] = *(const f32x4*)(sb + bcol + bj * HALF); sv[bj][1] = *(const f32x4*)(sb + bcol + bj * HALF + 4); }
#pragma unroll
        for (int ai = 0; ai < 2; ++ai)
#pragma unroll
            for (int m = 0; m < 4; ++m) { bf16_t* rowp = O + (size_t)(row0 + ai * HALF + m * 16) * ldc + col0;
#pragma unroll
                for (int bj = 0; bj < 2; ++bj) { const f32x4 v0 = acc[ai][bj][m][0] * sv[bj][0], v1 = acc[ai][bj][m][1] * sv[bj][1];
                    u32x4 w; w.x = cvt_pk_bf16(v0[0], v0[1]); w.y = cvt_pk_bf16(v0[2], v0[3]); w.z = cvt_pk_bf16(v1[0], v1[1]); w.w = cvt_pk_bf16(v1[2], v1[3]);
                    *(u32x4*)(rowp + bj * HALF) = w; } }
    }
};
template <class Epi, class Sched, bool ALIGN_EPI = false, bool SP2 = false, int DT = 0  >
__device__ __forceinline__ void gemm_phase(PG8_LAS unsigned char* lds, const Gemm g, const Sched& S, const Epi& E) {
    int tid_ = threadIdx.x; asm volatile("" : "+v"(tid_));
    const int tid = tid_, wid = __builtin_amdgcn_readfirstlane(tid >> 6), lane = tid & 63, wr = wid >> 2, wc = wid & 3, fr = lane & 15, fq = lane >> 4;
    const int K = g.K, nt = K / BK;
    unsigned voffA[2], voffB[2];
#pragma unroll
    for (int i = 0; i < 2; ++i) { int R, C; stage_rc(tid * 16 + i * 8192, R, C); const int Rb = Epi::PERM ? ((R & ~31) + perm32(R & 31)) : R;
        voffA[i] = (unsigned)(R * K + C) * 2u; voffB[i] = (unsigned)(Rb * K + C) * 2u; }
    const size_t kstep = (size_t)(BK * 2);
    const size_t hstep = (size_t)HALF * K * 2;
    const size_t tstep = 2 * hstep;
    const unsigned ldsw = (unsigned)wid * 1024u;
    const int aoff = lds_byte(wr * 64 + fr, fq * 8), boff = lds_byte(wc * 32 + fr, fq * 8);
#define PG8_SA(b, h) (((b) * 2 + (h)) * HTB)
#define PG8_SB(b, h) ((4 + (b) * 2 + (h)) * HTB)
#define PG8_STAGE(bufoff, gbase, voff) do { _Pragma("unroll") for (int _i = 0; _i < 2; ++_i) \
        __builtin_amdgcn_global_load_lds((const unsigned*)((const char*)(gbase) + (voff)[_i]), (PG8_LAS unsigned*)(lds + (bufoff) + ldsw + _i * 8192), 16, 0, 0); } while (0)
#define PG8_LDA(dst, b, h) do { _Pragma("unroll") for (int m = 0; m < 4; ++m) _Pragma("unroll") for (int k = 0; k < 2; ++k) dst[m][k] = *(const PG8_LAS bf16x8*)(lds + PG8_SA(b, h) + aoff + m * 2048 + k * 1024); } while (0)
#define PG8_LDB(dst, b, h) do { _Pragma("unroll") for (int n = 0; n < 2; ++n) _Pragma("unroll") for (int k = 0; k < 2; ++k) dst[n][k] = *(const PG8_LAS bf16x8*)(lds + PG8_SB(b, h) + boff + n * 2048 + k * 1024); } while (0)
#define PG8_MMA(ai, bj, At, Bt) do { __builtin_amdgcn_s_setprio(1); if constexpr (DT == 0) { _Pragma("unroll") for (int m = 0; m < 4; ++m) _Pragma("unroll") for (int n = 0; n < 2; ++n) _Pragma("unroll") for (int k = 0; k < 2; ++k) \
        acc[ai][bj][m][n] = __builtin_amdgcn_mfma_f32_16x16x32_bf16(Bt[n][k], At[m][k], acc[ai][bj][m][n], 0, 0, 0); } else { _Pragma("unroll") for (int m = 0; m < 4; ++m) _Pragma("unroll") for (int n = 0; n < 2; ++n) \
        asm volatile("v_mfma_f32_16x16x128_f8f6f4 %0, %1, %2, %0" : "+v"(acc[ai][bj][m][n]) : "v"(cat8(Bt[n][0], Bt[n][1])), "v"(cat8(At[m][0], At[m][1]))); } __builtin_amdgcn_s_setprio(0); } while (0)
#define PG8_WAIT_V(n) asm volatile("s_waitcnt vmcnt(" #n ")" ::: "memory")
#define PG8_WAIT_L(n) asm volatile("s_waitcnt lgkmcnt(" #n ")" ::: "memory")
#define PG8_BAR __builtin_amdgcn_s_barrier()
#define PG8_SCHED __builtin_amdgcn_sched_barrier(0)
    Unit cur, nxt; int ui = 0;
    if (!S.next(0, cur)) return;
    f32x4 acc[2][2][4][2];
#pragma unroll
    for (int a = 0; a < 2; ++a)
#pragma unroll
        for (int b = 0; b < 2; ++b)
#pragma unroll
            for (int m = 0; m < 4; ++m)
#pragma unroll
                for (int n = 0; n < 2; ++n) acc[a][b][m][n] = (f32x4){0.f, 0.f, 0.f, 0.f};
    bf16x8 At[4][2], B0[2][2], B1[2][2];
    const char* cA = (const char*)g.A + (size_t)cur.pm * tstep; const char* cB = (const char*)g.Bt + (size_t)cur.pn * tstep;
    S.a_ready(cur);
    if constexpr (SP2) {
        PG8_STAGE(PG8_SB(0, 0), cB, voffB); PG8_STAGE(PG8_SB(0, 1), cB + hstep, voffB); PG8_STAGE(PG8_SA(0, 0), cA, voffA); PG8_STAGE(PG8_SA(0, 1), cA + hstep, voffA);
        if (wr == 1) PG8_BAR;
        PG8_WAIT_V(2); PG8_BAR;
        PG8_STAGE(PG8_SB(1, 0), cB + kstep, voffB); PG8_STAGE(PG8_SA(1, 0), cA + kstep, voffA); PG8_STAGE(PG8_SB(1, 1), cB + hstep + kstep, voffB);
        PG8_WAIT_V(6); PG8_BAR;
    } else {
        PG8_STAGE(PG8_SB(0, 0), cB, voffB); PG8_STAGE(PG8_SA(0, 0), cA, voffA); PG8_STAGE(PG8_SB(0, 1), cB + hstep, voffB); PG8_STAGE(PG8_SA(0, 1), cA + hstep, voffA);
        if (wr == 1) PG8_BAR;
        PG8_WAIT_V(4); PG8_BAR;
        PG8_STAGE(PG8_SB(1, 0), cB + kstep, voffB); PG8_STAGE(PG8_SA(1, 0), cA + kstep, voffA); PG8_STAGE(PG8_SB(1, 1), cB + hstep + kstep, voffB);
        PG8_WAIT_V(6); PG8_BAR;
    }
    for (;;) {
        const bool has_next = S.next(ui + 1, nxt);
        const char* nA = has_next ? (const char*)g.A + (size_t)nxt.pm * tstep : cA; const char* nB = has_next ? (const char*)g.Bt + (size_t)nxt.pn * tstep : cB;
        for (int t = 0; t < nt; t += 2) {
            const bool last = (t == nt - 2);
            const char* a1 = cA + (size_t)(t + 1) * kstep;
            const char* a2 = last ? nA : cA + (size_t)(t + 2) * kstep; const char* b2 = last ? nB : cB + (size_t)(t + 2) * kstep;
            const char* a3 = a2 + kstep; const char* b3 = b2 + kstep;
            if (last && has_next) S.a_ready(nxt);
            if constexpr (SP2) {
            PG8_LDB(B0, 0, 0); PG8_LDB(B1, 0, 1); PG8_SCHED; PG8_LDA(At, 0, 0); PG8_STAGE(PG8_SA(1, 1), a1 + hstep, voffA);
            PG8_WAIT_V(8); PG8_WAIT_L(0); PG8_BAR; PG8_MMA(0, 0, At, B0); PG8_MMA(0, 1, At, B1); PG8_BAR; PG8_SCHED;
            PG8_LDA(At, 0, 1); PG8_STAGE(PG8_SB(0, 0), b2, voffB); PG8_STAGE(PG8_SB(0, 1), b2 + hstep, voffB); PG8_STAGE(PG8_SA(0, 0), a2, voffA);
            PG8_WAIT_V(8); PG8_WAIT_L(0); PG8_BAR; PG8_MMA(1, 0, At, B0); PG8_MMA(1, 1, At, B1); PG8_BAR; PG8_SCHED;
            PG8_LDB(B0, 1, 0); PG8_LDB(B1, 1, 1); PG8_SCHED; PG8_LDA(At, 1, 0); PG8_STAGE(PG8_SA(0, 1), a2 + hstep, voffA);
            PG8_WAIT_V(8); PG8_WAIT_L(0); PG8_BAR; PG8_MMA(0, 0, At, B0); PG8_MMA(0, 1, At, B1); PG8_BAR; PG8_SCHED;
            PG8_LDA(At, 1, 1); PG8_STAGE(PG8_SB(1, 0), b3, voffB); PG8_STAGE(PG8_SB(1, 1), b3 + hstep, voffB); PG8_STAGE(PG8_SA(1, 0), a3, voffA);
            PG8_WAIT_V(8); PG8_WAIT_L(0); PG8_BAR; PG8_MMA(1, 0, At, B0); PG8_MMA(1, 1, At, B1); PG8_BAR; PG8_SCHED;
            } else {
            PG8_LDB(B0, 0, 0); PG8_SCHED; PG8_LDA(At, 0, 0); PG8_STAGE(PG8_SA(1, 1), a1 + hstep, voffA);
            PG8_WAIT_L(8); PG8_BAR; PG8_WAIT_L(0); PG8_MMA(0, 0, At, B0); PG8_BAR; PG8_SCHED;
            PG8_LDB(B1, 0, 1); PG8_STAGE(PG8_SB(0, 0), b2, voffB);
            PG8_BAR; PG8_WAIT_L(0); PG8_MMA(0, 1, At, B1); PG8_BAR;
            PG8_LDA(At, 0, 1); PG8_STAGE(PG8_SA(0, 0), a2, voffA);
            PG8_BAR; PG8_WAIT_L(0); PG8_MMA(1, 0, At, B0); PG8_BAR; PG8_SCHED;
            PG8_STAGE(PG8_SB(0, 1), b2 + hstep, voffB);
            PG8_WAIT_V(6); PG8_BAR; PG8_MMA(1, 1, At, B1); PG8_BAR;
            PG8_LDB(B0, 1, 0); PG8_SCHED; PG8_LDA(At, 1, 0); PG8_STAGE(PG8_SA(0, 1), a2 + hstep, voffA);
            PG8_WAIT_L(8); PG8_BAR; PG8_WAIT_L(0); PG8_MMA(0, 0, At, B0); PG8_BAR; PG8_SCHED;
            PG8_LDB(B1, 1, 1); PG8_STAGE(PG8_SB(1, 0), b3, voffB);
            PG8_BAR; PG8_WAIT_L(0); PG8_MMA(0, 1, At, B1); PG8_BAR;
            PG8_LDA(At, 1, 1); PG8_STAGE(PG8_SA(1, 0), a3, voffA);
            PG8_BAR; PG8_WAIT_L(0); PG8_MMA(1, 0, At, B0); PG8_BAR; PG8_SCHED;
            PG8_STAGE(PG8_SB(1, 1), b3 + hstep, voffB);
            PG8_WAIT_V(6); PG8_BAR; PG8_MMA(1, 1, At, B1); PG8_BAR;
            }
        }
        if constexpr (DT == 1) {
            asm volatile("s_nop 15\n\ts_nop 15\n\ts_nop 15\n\ts_nop 15\n\ts_nop 15\n\ts_nop 15" : "+v"(acc[0][0][0][0]), "+v"(acc[0][0][0][1]), "+v"(acc[0][0][1][0]), "+v"(acc[0][0][1][1]), "+v"(acc[0][0][2][0]), "+v"(acc[0][0][2][1]), "+v"(acc[0][0][3][0]), "+v"(acc[0][0][3][1]));
            asm volatile("" : "+v"(acc[0][1][0][0]), "+v"(acc[0][1][0][1]), "+v"(acc[0][1][1][0]), "+v"(acc[0][1][1][1]), "+v"(acc[0][1][2][0]), "+v"(acc[0][1][2][1]), "+v"(acc[0][1][3][0]), "+v"(acc[0][1][3][1]));
            asm volatile("" : "+v"(acc[1][0][0][0]), "+v"(acc[1][0][0][1]), "+v"(acc[1][0][1][0]), "+v"(acc[1][0][1][1]), "+v"(acc[1][0][2][0]), "+v"(acc[1][0][2][1]), "+v"(acc[1][0][3][0]), "+v"(acc[1][0][3][1]));
            asm volatile("" : "+v"(acc[1][1][0][0]), "+v"(acc[1][1][0][1]), "+v"(acc[1][1][1][0]), "+v"(acc[1][1][1][1]), "+v"(acc[1][1][2][0]), "+v"(acc[1][1][2][1]), "+v"(acc[1][1][3][0]), "+v"(acc[1][1][3][1]));
        }
        if constexpr (ALIGN_EPI) { if (wr == 0) PG8_BAR; }
        if constexpr (!Epi::AFTER_DRAIN) { E(acc, cur, wr, wc, fr, fq); S.done(cur); }
        if (!has_next) break;
#pragma unroll
        for (int a = 0; a < 2; ++a)
#pragma unroll
            for (int b = 0; b < 2; ++b)
#pragma unroll
                for (int m = 0; m < 4; ++m)
#pragma unroll
                    for (int n = 0; n < 2; ++n) acc[a][b][m][n] = (f32x4){0.f, 0.f, 0.f, 0.f};
        cur = nxt; cA = nA; cB = nB; ++ui;
        if constexpr (ALIGN_EPI) { if (wr == 1) PG8_BAR; }
    }
    PG8_WAIT_V(0);
    if constexpr (!ALIGN_EPI) { if (wr == 0) PG8_BAR; }
    PG8_BAR;
    if constexpr (Epi::AFTER_DRAIN) { E.fused(acc, cur, wr, wc, fr, fq, lds, wid, lane); S.done(cur); }
#undef PG8_SA
#undef PG8_SB
#undef PG8_STAGE
#undef PG8_LDA
#undef PG8_LDB
#undef PG8_MMA
#undef PG8_WAIT_V
#undef PG8_WAIT_L
#undef PG8_BAR
#undef PG8_SCHED
}
}
#define GAS __attribute__((address_space(1)))
#define LAS __attribute__((address_space(3)))
typedef unsigned short bf16;
typedef unsigned v4u __attribute__((ext_vector_type(4)));
typedef float f32x4 __attribute__((ext_vector_type(4)));
typedef short bf16x8 __attribute__((ext_vector_type(8)));
typedef GAS unsigned gu32;
typedef GAS unsigned long long gu64;
#define RLX_AGENT __ATOMIC_RELAXED, __HIP_MEMORY_SCOPE_AGENT
#define LDS_WAIT() asm volatile("s_waitcnt lgkmcnt(0)" ::: "memory")
#define VM_WAIT() asm volatile("s_waitcnt vmcnt(0)" ::: "memory")
__device__ __forceinline__ unsigned long long rt() { return __builtin_amdgcn_s_memrealtime(); }
__device__ __forceinline__ unsigned f2bf(float f) { unsigned u = __builtin_bit_cast(unsigned, f); return (u + 0x7fffu + ((u >> 16) & 1u)) >> 16; }
__device__ __forceinline__ unsigned pk2(float lo, float hi) { return f2bf(lo) | (f2bf(hi) << 16); }

#define XB_TMO      128
#define XB_XCNT(j)  (256  + 64 * (j))
#define XB_XSUB(j)  (1280 + 64 * (j))
#define XB_XGEN(j)  (2304 + 64 * (j))
#define XB_TOP      3328
#define XB_TOPGEN   3392
#define XCD_BAR_WORDS 3456
#define XB_SPIN_CAP (1u << 18)

__device__ __forceinline__ unsigned xb_ld(unsigned* p)              { return __hip_atomic_load(p, __ATOMIC_RELAXED, __HIP_MEMORY_SCOPE_AGENT); }
__device__ __forceinline__ unsigned xb_add(unsigned* p, unsigned v) { return __hip_atomic_fetch_add(p, v, __ATOMIC_RELAXED, __HIP_MEMORY_SCOPE_AGENT); }
__device__ __forceinline__ unsigned xb_xcc_id() { return (unsigned)__builtin_amdgcn_s_getreg((3 << 11) | 20) & 0xFu; }
#define XB_SPIN(cond, bar) do { unsigned _sp = 0; while (cond) { __builtin_amdgcn_s_sleep(1); \
    if ((++_sp & 255u) == 0u) { if (xb_ld(&(bar)[XB_TMO])) break; if (_sp > XB_SPIN_CAP) { atomicAdd(&(bar)[XB_TMO], 1u); break; } } } } while (0)

struct XcdBarrier {
    unsigned* bar; unsigned x;
    volatile LAS unsigned* st;
};

__device__ __forceinline__ XcdBarrier xcd_barrier_post(unsigned* bar, volatile LAS unsigned* st) {
    XcdBarrier b; b.bar = bar; b.x = xb_xcc_id(); b.st = st;
    if (threadIdx.x == 0) (void)xb_add(&bar[XB_XCNT(b.x)], 1u);
    return b;
}
__device__ __forceinline__ void xcd_barrier_complete(unsigned* bar, unsigned x, unsigned& nloc, unsigned& nx) {
    const unsigned G = gridDim.x * gridDim.y * gridDim.z;
    unsigned sum, cnt, mine, sp = 0u;
    for (;;) {
        sum = 0u; cnt = 0u; mine = 0u;
#pragma unroll
        for (unsigned j = 0; j < 16; ++j) { const unsigned c = xb_ld(&bar[XB_XCNT(j)]); sum += c; cnt += (c > 0u) ? 1u : 0u; mine = (j == x) ? c : mine; }
        if (sum == G) break;
        __builtin_amdgcn_s_sleep(1);
        if ((++sp & 255u) == 0u) { if (xb_ld(&bar[XB_TMO])) break; if (sp > XB_SPIN_CAP) { atomicAdd(&bar[XB_TMO], 1u); break; } }
    }
    nloc = mine > 0u ? mine : 1u; nx = cnt > 0u ? cnt : 1u;
}

__device__ __forceinline__ void xcd_barrier(const XcdBarrier& b) {
    asm volatile("s_waitcnt vmcnt(0)" ::: "memory");
    __syncthreads();
    if (threadIdx.x == 0) {
        unsigned* bar = b.bar;
        __builtin_amdgcn_s_waitcnt(0);
        unsigned nloc = b.st[0], nx = b.st[1];
        if (nloc == 0u) { xcd_barrier_complete(bar, b.x, nloc, nx); b.st[0] = nloc; b.st[1] = nx; }
        const unsigned old = xb_add(&bar[XB_XSUB(b.x)], 1u);
        const unsigned gen = old / nloc;
        if (old + 1u == (gen + 1u) * nloc) {
            __builtin_amdgcn_fence(__ATOMIC_RELEASE, "agent");
            asm volatile("s_waitcnt vmcnt(0)" ::: "memory");
            const unsigned og = xb_add(&bar[XB_TOP], 1u);
            const unsigned tg = og / nx;
            if (og + 1u == (tg + 1u) * nx) xb_add(&bar[XB_TOPGEN], 1u);
            else XB_SPIN(xb_ld(&bar[XB_TOPGEN]) == tg, bar);
            __builtin_amdgcn_fence(__ATOMIC_ACQUIRE, "agent");
            xb_add(&bar[XB_XGEN(b.x)], 1u);
            asm volatile("s_waitcnt vmcnt(0)" ::: "memory");
        } else {
            XB_SPIN(xb_ld(&bar[XB_XGEN(b.x)]) == gen, bar);
            __builtin_amdgcn_fence(__ATOMIC_ACQUIRE, "agent");
            asm volatile("s_waitcnt vmcnt(0)" ::: "memory");
        }
    }
    __syncthreads();
}

constexpr int NWAVES = 8;
constexpr int BATCH = 16, SEQ = 4096, DM = 1024, MTOK = BATCH * SEQ;
constexpr int D_IN = 3584, FF0 = 2816, FF1 = 3584, NEXP = 8, NQKV = 3072;
constexpr int OFF_QSB = 0, OFF_KSB = 512, OFF_VSB = 1024, OFF_QR = 1536, OFF_KR = 2048, OFF_VR = 2560, OFF_GR = 3072;
constexpr float LN_EPS = 1e-5f, ALPHA = 1.41421356237309515f;
constexpr float LOG2E = 1.44269504088896341f, LN2 = 0.69314718055994531f;
constexpr int MOE_MAXTILES = 520, MOE_SLICE = 256, MOE_ROWS = MOE_MAXTILES * 256;

constexpr size_t MiB = 1u << 20;
constexpr size_t WS_CTL = 0, CTL_ZERO_BYTES = 1 * MiB;
constexpr size_t WS_TOKE = 1 * MiB;
constexpr size_t WS_TOKG = WS_TOKE + (size_t)MTOK * 4;
constexpr size_t WS_TOKS = WS_TOKG + (size_t)MTOK * 8;
constexpr size_t WS_PERM = WS_TOKS + (size_t)MTOK * 8;
constexpr size_t WS_WCNT = WS_PERM + (size_t)MOE_ROWS * 4;
constexpr size_t WS_TILE = WS_WCNT + 4096 * 8 * 4;
constexpr size_t WS_SBGU = WS_TILE + 4096;
constexpr size_t WS_SBDN = WS_SBGU + (size_t)NEXP * 2 * FF1 * 4;
constexpr size_t WS_XS = WS_SBDN + (size_t)NEXP * DM * 4;
constexpr size_t WS_SAS = WS_XS + (size_t)MTOK * 4;
static_assert(WS_SAS + (size_t)MOE_ROWS * 4 <= 5 * MiB, "misc map");
constexpr size_t WS_ROPE = 5 * MiB;
constexpr size_t WS_WIN = 6 * MiB, WS_WO0 = 13 * MiB, WS_WGU0 = 15 * MiB, WS_WDN0 = 26 * MiB, WS_WQKV = 32 * MiB, WS_WO1 = 38 * MiB;
constexpr size_t WS_WGU1Q = 40 * MiB, WS_WDN1Q = 96 * MiB;
constexpr size_t WS_XQ = 124 * MiB;
constexpr size_t WS_XB = 188 * MiB;
constexpr size_t WS_O = 316 * MiB;
constexpr size_t WS_BIG = 444 * MiB;
constexpr size_t WS_H = WS_BIG, WS_HID0 = WS_BIG, WS_QKV = WS_BIG;
constexpr size_t WS_MIX = WS_BIG + 352 * MiB;
constexpr size_t WS_AMOE = 316 * MiB;
constexpr size_t WS_Y = 446 * MiB;
constexpr size_t WS_HSL = 706 * MiB;
constexpr size_t WS_END = 930 * MiB;
static_assert(WS_WDN1Q + (size_t)NEXP * DM * FF1 <= WS_XQ && WS_HSL + (size_t)MOE_SLICE * 256 * FF1 <= WS_END && WS_MIX + (size_t)MTOK * DM * 2 <= WS_END, "ws map");
static_assert(WS_AMOE + (size_t)MOE_ROWS * DM <= WS_Y && WS_Y + (size_t)MOE_ROWS * DM * 2 <= WS_HSL && (size_t)MTOK * FF0 * 2 <= 352 * MiB && WS_BIG + (size_t)MTOK * D_IN * 2 <= WS_END, "ws map 2");
constexpr size_t OUT_WGU1 = 0, OUT_WDN1 = 112 * MiB;
constexpr int CW_BAR = 4096;
constexpr int CW_NTILES = 16384;

constexpr int RING_BYTES = 131072, LDSCTL_OFF = 139264, MISC_OFF = LDSCTL_OFF + 320, LDS_BYTES = 147456;
constexpr int TP = 144;

typedef short s16x4 __attribute__((ext_vector_type(4)));
typedef float f32x16 __attribute__((ext_vector_type(16)));
typedef unsigned u32x2 __attribute__((ext_vector_type(2)));
typedef float f32x2 __attribute__((ext_vector_type(2)));
typedef __bf16 bf16x2_t __attribute__((ext_vector_type(2)));
typedef int i32x2 __attribute__((ext_vector_type(2)));
typedef int i32x4 __attribute__((ext_vector_type(4)));

__device__ __forceinline__ unsigned cvtpk(float lo, float hi) { f32x2 v = {lo, hi}; bf16x2_t b = __builtin_convertvector(v, bf16x2_t); return __builtin_bit_cast(unsigned, b); }
__device__ __forceinline__ float bflo(unsigned w) { return __uint_as_float(w << 16); }
__device__ __forceinline__ float bfhi(unsigned w) { return __uint_as_float(w & 0xffff0000u); }
__device__ __forceinline__ float bfel(const v4u& a, int e) { const unsigned w = a[e >> 1]; return (e & 1) ? bfhi(w) : bflo(w); }
__device__ __forceinline__ int crow(int r, int hi) { return (r & 3) + 8 * (r >> 2) + 4 * hi; }
__device__ __forceinline__ float ex2(float x) { return __builtin_amdgcn_exp2f(x); }
__device__ __forceinline__ float lg2(float x) { return __builtin_amdgcn_logf(x); }
__device__ __forceinline__ f32x16 mfma32(bf16x8 x, bf16x8 y, f32x16 c) { return __builtin_amdgcn_mfma_f32_32x32x16_bf16(x, y, c, 0, 0, 0); }
__device__ __forceinline__ float wave_sum(float v) {
#pragma unroll
    for (int o = 1; o < 64; o <<= 1) v += __shfl_xor(v, o);
    return v;
}
__device__ __forceinline__ float xmax32(float v) { const auto rr = __builtin_amdgcn_permlane32_swap(__float_as_uint(v), __float_as_uint(v), false, false); return fmaxf(__uint_as_float(rr[0]), __uint_as_float(rr[1])); }
__device__ __forceinline__ float xsum32(float v) { const auto rr = __builtin_amdgcn_permlane32_swap(__float_as_uint(v), __float_as_uint(v), false, false); return __uint_as_float(rr[0]) + __uint_as_float(rr[1]); }
typedef short v4i16_t __attribute__((ext_vector_type(4)));
__device__ __forceinline__ s16x4 trrd(const LAS unsigned char* p) { return __builtin_bit_cast(s16x4, __builtin_amdgcn_ds_read_tr16_b64_v4i16((LAS v4i16_t*)p)); }
__device__ __forceinline__ bf16x8 row_frag(const LAS unsigned char* tile, int r32, int hi, int dk) { return *(const LAS bf16x8*)(tile + r32 * TP + (16 * dk + 8 * hi) * 2); }
__device__ __forceinline__ bf16x8 tr_frag(const LAS unsigned char* tile, int rowA, int rowB, int cb, int lane) {
    const int q = (lane & 15) >> 2, p = lane & 3, blk = (lane >> 4) & 1;
    const int co = cb * 64 + blk * 32 + p * 8;
    const s16x4 lo = trrd(tile + (rowA + q) * TP + co), hi4 = trrd(tile + (rowB + q) * TP + co);
    return (bf16x8){lo[0], lo[1], lo[2], lo[3], hi4[0], hi4[1], hi4[2], hi4[3]};
}
__device__ __forceinline__ void load_tile32(const bf16* g, size_t ldg, LAS unsigned char* tile, int lane) {
#pragma unroll
    for (int i = 0; i < 4; ++i) { const int id = i * 64 + lane, row = id >> 3, ch = id & 7;
        const v4u v = *(const GAS v4u*)(g + (size_t)row * ldg + ch * 8); *(LAS v4u*)(tile + row * TP + ch * 16) = v; }
}
__device__ __forceinline__ void tile32_fetch(const bf16* g, size_t ldg, int lane, v4u (&r)[4]) {
#pragma unroll
    for (int i = 0; i < 4; ++i) { const int id = i * 64 + lane, row = id >> 3, ch = id & 7; r[i] = *(const GAS v4u*)(g + (size_t)row * ldg + ch * 8); }
}
__device__ __forceinline__ void tile32_store(LAS unsigned char* tile, int lane, const v4u (&r)[4]) {
#pragma unroll
    for (int i = 0; i < 4; ++i) { const int id = i * 64 + lane, row = id >> 3, ch = id & 7; *(LAS v4u*)(tile + row * TP + ch * 16) = r[i]; }
}
template <bool DECAY>
__device__ __forceinline__ void load_tile32_rot(const bf16* g, size_t ldg, const float* rope, int pos0, int j0, float l2g, LAS unsigned char* tile, int lane) {
#pragma unroll
    for (int i = 0; i < 2; ++i) { const int id = i * 64 + lane, row = id >> 2, ch = id & 3;
        const v4u a = *(const GAS v4u*)(g + (size_t)row * ldg + ch * 8), bq = *(const GAS v4u*)(g + (size_t)row * ldg + 32 + ch * 8);
        const float* rp = rope + (size_t)(pos0 + row) * 64 + ch * 8;
        const f32x4 c0 = *(const GAS f32x4*)rp, c1 = *(const GAS f32x4*)(rp + 4), s0 = *(const GAS f32x4*)(rp + 32), s1 = *(const GAS f32x4*)(rp + 36);
        const float sc = DECAY ? ex2((float)(63 - (j0 + row)) * l2g) : 1.0f;
        float o1[8], o2[8];
#pragma unroll
        for (int e = 0; e < 8; ++e) { const float x1 = bfel(a, e), x2 = bfel(bq, e), c = e < 4 ? c0[e & 3] : c1[e & 3], s = e < 4 ? s0[e & 3] : s1[e & 3];
            o1[e] = (x1 * c - x2 * s) * sc; o2[e] = (x1 * s + x2 * c) * sc; }
        v4u w1, w2;
#pragma unroll
        for (int e = 0; e < 4; ++e) { w1[e] = cvtpk(o1[2 * e], o1[2 * e + 1]); w2[e] = cvtpk(o2[2 * e], o2[2 * e + 1]); }
        *(LAS v4u*)(tile + row * TP + ch * 16) = w1; *(LAS v4u*)(tile + row * TP + 64 + ch * 16) = w2; }
}
__device__ __forceinline__ bf16x8 pack8(const float* w) { v4u t; t.x = cvtpk(w[0], w[1]); t.y = cvtpk(w[2], w[3]); t.z = cvtpk(w[4], w[5]); t.w = cvtpk(w[6], w[7]); return __builtin_bit_cast(bf16x8, t); }

struct Ctx { LAS unsigned char* lds; int wave, vcu, G, gw, NGW; };
__device__ __forceinline__ int ph_tid() { int t = threadIdx.x; asm volatile("" : "+v"(t)); return t; }
__device__ __forceinline__ int launder(int x) { asm volatile("" : "+v"(x)); return x; }

__device__ __forceinline__ void p0_transpose_item(const float* W, int K, int N, bf16* WT, int rs128, int radd, LAS float* scr, int item, int lane) {
    const int nblk = N / 32, kb = item / nblk, nb = item % nblk, k0 = 64 * kb, n0 = 32 * nb;
    const int drow0 = (n0 >> 7) * rs128 + (n0 & 127) + radd;
#pragma unroll 8
    for (int i = 0; i < 32; ++i) { const int kk = 2 * i + (lane >> 5); scr[kk * 33 + (lane & 31)] = W[(size_t)(k0 + kk) * N + n0 + (lane & 31)]; }
    LDS_WAIT(); asm volatile("" ::: "memory");
    const int c = lane & 7;
#pragma unroll
    for (int j = 0; j < 4; ++j) { const int n = (lane >> 3) + 8 * j; const LAS float* s = scr + (8 * c) * 33 + n;
        v4u o; o.x = cvtpk(s[0 * 33], s[1 * 33]); o.y = cvtpk(s[2 * 33], s[3 * 33]); o.z = cvtpk(s[4 * 33], s[5 * 33]); o.w = cvtpk(s[6 * 33], s[7 * 33]);
        *(GAS v4u*)(WT + (size_t)(drow0 + n) * K + k0 + 8 * c) = o; }
    LDS_WAIT(); asm volatile("" ::: "memory");
}
__device__ __forceinline__ void p0_prologue(const Ctx& C, const float* const* in, unsigned char* ws, unsigned char* outb) {
    const int lane_ = ph_tid() & 63;
    LAS float* scr = (LAS float*)(C.lds + C.wave * 16384);
    constexpr int I_WIN = 16 * (D_IN / 32), I_WO = 16 * 32, I_G0 = 16 * (FF0 / 32), I_D0 = (FF0 / 64) * 32, I_QKV = 16 * (NQKV / 32), I_ME = 16 * (FF1 / 32), I_MD = (FF1 / 64) * 32;
    static_assert(I_ME == 1792 && I_MD == 1792, "moe items");
    constexpr int NITEMS = I_WIN + I_WO + 2 * I_G0 + I_D0 + I_QKV + I_WO + NEXP * (2 * I_ME + I_MD);
    for (int it = C.gw; it < NITEMS; it += C.NGW) {
        int r = it;
        if (r < I_WIN) { p0_transpose_item(in[3], DM, D_IN, (bf16*)(ws + WS_WIN), 128, 0, scr, r, lane_); continue; } r -= I_WIN;
        if (r < I_WO) { p0_transpose_item(in[5], DM, DM, (bf16*)(ws + WS_WO0), 128, 0, scr, r, lane_); continue; } r -= I_WO;
        if (r < I_G0) { p0_transpose_item(in[8], DM, FF0, (bf16*)(ws + WS_WGU0), 256, 0, scr, r, lane_); continue; } r -= I_G0;
        if (r < I_G0) { p0_transpose_item(in[9], DM, FF0, (bf16*)(ws + WS_WGU0), 256, 128, scr, r, lane_); continue; } r -= I_G0;
        if (r < I_D0) { p0_transpose_item(in[10], FF0, DM, (bf16*)(ws + WS_WDN0), 128, 0, scr, r, lane_); continue; } r -= I_D0;
        if (r < I_QKV) { p0_transpose_item(in[13], DM, NQKV, (bf16*)(ws + WS_WQKV), 128, 0, scr, r, lane_); continue; } r -= I_QKV;
        if (r < I_WO) { p0_transpose_item(in[15], DM, DM, (bf16*)(ws + WS_WO1), 128, 0, scr, r, lane_); continue; } r -= I_WO;
        if (r < NEXP * I_ME) { const int e = r / I_ME; p0_transpose_item(in[20] + (size_t)e * DM * FF1, DM, FF1, (bf16*)(outb + OUT_WGU1) + (size_t)e * 2 * FF1 * DM, 256, 0, scr, r % I_ME, lane_); continue; } r -= NEXP * I_ME;
        if (r < NEXP * I_ME) { const int e = r / I_ME; p0_transpose_item(in[21] + (size_t)e * DM * FF1, DM, FF1, (bf16*)(outb + OUT_WGU1) + (size_t)e * 2 * FF1 * DM, 256, 128, scr, r % I_ME, lane_); continue; } r -= NEXP * I_ME;
        { const int e = r / I_MD; p0_transpose_item(in[22] + (size_t)e * FF1 * DM, FF1, DM, (bf16*)(outb + OUT_WDN1) + (size_t)e * DM * FF1, 128, 0, scr, r % I_MD, lane_); }
    }
    { const float* x = in[0]; bf16* xb = (bf16*)(ws + WS_XB); const size_t n8 = (size_t)MTOK * DM / 8;
      for (size_t i = (size_t)C.gw * 64 + lane_; i < n8; i += (size_t)C.NGW * 64) {
          const f32x4 a = *(const GAS f32x4*)(x + 8 * i), b = *(const GAS f32x4*)(x + 8 * i + 4);
          v4u o; o.x = cvtpk(a[0], a[1]); o.y = cvtpk(a[2], a[3]); o.z = cvtpk(b[0], b[1]); o.w = cvtpk(b[2], b[3]); *(GAS v4u*)(xb + 8 * i) = o; } }
    { float* rope = (float*)(ws + WS_ROPE);
      for (int idx = C.gw * 64 + lane_; idx < SEQ * 32; idx += C.NGW * 64) { const int pos = idx >> 5, i = idx & 31;
          double f = 1.0; for (int k = 0; k < i; ++k) f *= 0.74989420933245582;
          const float invf = (float)f, ang = (float)pos * invf;
          double rev = (double)ang * 0.15915494309189535; rev -= __builtin_rint(rev);
          rope[pos * 64 + i] = __builtin_amdgcn_cosf((float)rev); rope[pos * 64 + 32 + i] = __builtin_amdgcn_sinf((float)rev); } }
}


template <int NCH>
__device__ __forceinline__ void quant_rows_fp8(const Ctx& C, const bf16* src, int nrows, unsigned char* dst, float* scale) {
    constexpr int K = NCH * 512; const int lane_ = ph_tid() & 63;
    for (int row = C.gw; row < nrows; row += C.NGW) {
        const GAS v4u* sp = (const GAS v4u*)(src + (size_t)row * K) + lane_;
        v4u buf[NCH]; float am = 0.f;
#pragma unroll
        for (int i = 0; i < NCH; ++i) { buf[i] = sp[64 * i];
#pragma unroll
            for (int e = 0; e < 8; ++e) am = fmaxf(am, fabsf(bfel(buf[i], e))); }
#pragma unroll
        for (int o = 1; o < 64; o <<= 1) am = fmaxf(am, __shfl_xor(am, o));
        am = fmaxf(am, 1.0e-30f); const float inv = 384.0f / am;
        GAS u32x2* dp = (GAS u32x2*)(dst + (size_t)row * K) + lane_;
#pragma unroll
        for (int i = 0; i < NCH; ++i) { u32x2 w;
            w.x = pg8::pk4_fp8(bfel(buf[i], 0) * inv, bfel(buf[i], 1) * inv, bfel(buf[i], 2) * inv, bfel(buf[i], 3) * inv);
            w.y = pg8::pk4_fp8(bfel(buf[i], 4) * inv, bfel(buf[i], 5) * inv, bfel(buf[i], 6) * inv, bfel(buf[i], 7) * inv); dp[64 * i] = w; }
        if (lane_ == 0) scale[row] = am * (1.0f / 384.0f);
    }
}

template <int MODE, bool XF32>
__device__ __forceinline__ void ln_phase(const Ctx& C, const void* xprev, const bf16* fsrc, const float* gam, const float* bet, float* xout, bf16* xb,
                                         const float* w_router, const float* b_router, unsigned char* ws) {
    const int lane = (ph_tid() & 63);
    LAS float* wrT = (LAS float*)C.lds;
    if (MODE == 1) {
        for (int idx = ph_tid(); idx < DM * NEXP; idx += NWAVES * 64) { const int d = idx >> 3, e = idx & 7; wrT[e * DM + d] = w_router[idx]; }
        int* perm = (int*)(ws + WS_PERM);
        for (int idx = C.gw * 64 + lane; idx < MOE_ROWS; idx += C.NGW * 64) perm[idx] = -1;
        __syncthreads();
    }
    f32x4 gv[4], bv[4];
#pragma unroll
    for (int j = 0; j < 4; ++j) { gv[j] = ((const GAS f32x4*)gam)[lane + 64 * j]; bv[j] = ((const GAS f32x4*)bet)[lane + 64 * j]; }
    int cnt0 = 0, cnt1 = 0, cnt2 = 0, cnt3 = 0, cnt4 = 0, cnt5 = 0, cnt6 = 0, cnt7 = 0;
    for (int row = C.gw; row < MTOK; row += C.NGW) {
        f32x4 xin[4];
        if (XF32) { const GAS f32x4* xr = (const GAS f32x4*)((const float*)xprev + (size_t)row * DM) + lane;
#pragma unroll
            for (int j = 0; j < 4; ++j) xin[j] = xr[64 * j];
        } else { const GAS u32x2* xr = (const GAS u32x2*)((const bf16*)xprev + (size_t)row * DM) + lane;
#pragma unroll
            for (int j = 0; j < 4; ++j) { const u32x2 a = xr[64 * j]; xin[j] = (f32x4){bflo(a.x), bfhi(a.x), bflo(a.y), bfhi(a.y)}; } }
        f32x4 v[4];
        if (MODE == 2) {
            const i32x2 sl = *(const GAS i32x2*)(ws + WS_TOKS + (size_t)row * 8); const f32x2 gt = *(const GAS f32x2*)(ws + WS_TOKG + (size_t)row * 8);
            const GAS u32x2* y1 = (const GAS u32x2*)(fsrc + (size_t)sl.x * DM) + lane; const GAS u32x2* y2 = (const GAS u32x2*)(fsrc + (size_t)sl.y * DM) + lane;
#pragma unroll
            for (int j = 0; j < 4; ++j) { const u32x2 a = y1[64 * j], b = y2[64 * j]; const f32x4 xv = xin[j];
                v[j][0] = xv[0] * ALPHA + (gt.x * bflo(a.x) + gt.y * bflo(b.x)); v[j][1] = xv[1] * ALPHA + (gt.x * bfhi(a.x) + gt.y * bfhi(b.x));
                v[j][2] = xv[2] * ALPHA + (gt.x * bflo(a.y) + gt.y * bflo(b.y)); v[j][3] = xv[3] * ALPHA + (gt.x * bfhi(a.y) + gt.y * bfhi(b.y)); }
        } else {
            const GAS u32x2* mr = (const GAS u32x2*)(fsrc + (size_t)row * DM) + lane;
#pragma unroll
            for (int j = 0; j < 4; ++j) { const u32x2 a = mr[64 * j]; const f32x4 xv = xin[j];
                v[j][0] = xv[0] * ALPHA + bflo(a.x); v[j][1] = xv[1] * ALPHA + bfhi(a.x); v[j][2] = xv[2] * ALPHA + bflo(a.y); v[j][3] = xv[3] * ALPHA + bfhi(a.y); }
        }
        float s = 0.f;
#pragma unroll
        for (int j = 0; j < 4; ++j) s += (v[j][0] + v[j][1]) + (v[j][2] + v[j][3]);
        const float mean = wave_sum(s) * (1.0f / DM); float s2 = 0.f;
#pragma unroll
        for (int j = 0; j < 4; ++j) { v[j] = v[j] - mean; s2 += (v[j][0] * v[j][0] + v[j][1] * v[j][1]) + (v[j][2] * v[j][2] + v[j][3] * v[j][3]); }
        const float rstd = 1.0f / sqrtf(wave_sum(s2) * (1.0f / DM) + LN_EPS);
#pragma unroll
        for (int j = 0; j < 4; ++j) v[j] = v[j] * rstd * gv[j] + bv[j];
        if (MODE == 2) { GAS f32x4* xo = (GAS f32x4*)(xout + (size_t)row * DM) + lane;
#pragma unroll
            for (int j = 0; j < 4; ++j) xo[64 * j] = v[j]; }
        if (MODE != 2) { GAS u32x2* bo = (GAS u32x2*)(xb + (size_t)row * DM) + lane;
#pragma unroll
            for (int j = 0; j < 4; ++j) { u32x2 w; w.x = cvtpk(v[j][0], v[j][1]); w.y = cvtpk(v[j][2], v[j][3]); bo[64 * j] = w; } }
        if (MODE == 1) {
            float am = 0.f;
#pragma unroll
            for (int j = 0; j < 4; ++j) am = fmaxf(am, fmaxf(fmaxf(fabsf(v[j][0]), fabsf(v[j][1])), fmaxf(fabsf(v[j][2]), fabsf(v[j][3]))));
#pragma unroll
            for (int o = 1; o < 64; o <<= 1) am = fmaxf(am, __shfl_xor(am, o));
            am = fmaxf(am, 1.0e-30f); const float qi = 384.0f / am;
            GAS unsigned* xq = (GAS unsigned*)(ws + WS_XQ + (size_t)row * DM) + lane;
#pragma unroll
            for (int j = 0; j < 4; ++j) xq[64 * j] = pg8::pk4_fp8(v[j][0] * qi, v[j][1] * qi, v[j][2] * qi, v[j][3] * qi);
            if (lane == 0) *(GAS float*)(ws + WS_XS + (size_t)row * 4) = am * (1.0f / 384.0f);
            float lg[8];
#pragma unroll
            for (int e = 0; e < 8; ++e) { float a = 0.f;
#pragma unroll
                for (int j = 0; j < 4; ++j) { const f32x4 w = *(const LAS f32x4*)(wrT + e * DM + 4 * lane + 256 * j); a += (v[j][0] * w[0] + v[j][1] * w[1]) + (v[j][2] * w[2] + v[j][3] * w[3]); }
                lg[e] = wave_sum(a) + b_router[e]; }
            int e1 = 0; float v1 = lg[0];
#pragma unroll
            for (int e = 1; e < 8; ++e) if (lg[e] > v1) { v1 = lg[e]; e1 = e; }
            int e2 = -1; float v2 = -3.0e38f;
#pragma unroll
            for (int e = 0; e < 8; ++e) if (e != e1 && lg[e] > v2) { v2 = lg[e]; e2 = e; }
            const float g1 = 1.0f / (1.0f + __expf(v2 - v1)), g2 = 1.0f - g1;
            if (lane == 0) { *(GAS int*)(ws + WS_TOKE + (size_t)row * 4) = e1 | (e2 << 8); *(GAS f32x2*)(ws + WS_TOKG + (size_t)row * 8) = (f32x2){g1, g2}; }
            cnt0 += (e1 == 0) + (e2 == 0); cnt1 += (e1 == 1) + (e2 == 1); cnt2 += (e1 == 2) + (e2 == 2); cnt3 += (e1 == 3) + (e2 == 3);
            cnt4 += (e1 == 4) + (e2 == 4); cnt5 += (e1 == 5) + (e2 == 5); cnt6 += (e1 == 6) + (e2 == 6); cnt7 += (e1 == 7) + (e2 == 7);
        }
    }
    if (MODE == 1) {
        int myc = cnt0; myc = lane == 1 ? cnt1 : myc; myc = lane == 2 ? cnt2 : myc; myc = lane == 3 ? cnt3 : myc; myc = lane == 4 ? cnt4 : myc; myc = lane == 5 ? cnt5 : myc; myc = lane == 6 ? cnt6 : myc; myc = lane == 7 ? cnt7 : myc;
        if (lane < 8) *(GAS int*)(ws + WS_WCNT + ((size_t)C.gw * 8 + lane) * 4) = myc;
    }
}

__device__ __forceinline__ void moe_assign(const Ctx& C, unsigned char* ws, gu32* ctl) {
    const int lane = (ph_tid() & 63);
    const GAS int* wcnt = (const GAS int*)(ws + WS_WCNT);
    int tot[8], pre[8];
#pragma unroll
    for (int e = 0; e < 8; ++e) { tot[e] = 0; pre[e] = 0; }
    for (int w = lane; w < C.NGW; w += 64) { const i32x4 a = *(const GAS i32x4*)(wcnt + w * 8), b = *(const GAS i32x4*)(wcnt + w * 8 + 4); const bool lo = w < C.gw;
        tot[0] += a.x; tot[1] += a.y; tot[2] += a.z; tot[3] += a.w; tot[4] += b.x; tot[5] += b.y; tot[6] += b.z; tot[7] += b.w;
        if (lo) { pre[0] += a.x; pre[1] += a.y; pre[2] += a.z; pre[3] += a.w; pre[4] += b.x; pre[5] += b.y; pre[6] += b.z; pre[7] += b.w; } }
    int off[9]; off[0] = 0;
#pragma unroll
    for (int e = 0; e < 8; ++e) {
#pragma unroll
        for (int o = 1; o < 64; o <<= 1) { tot[e] += __shfl_xor(tot[e], o); pre[e] += __shfl_xor(pre[e], o); }
        off[e + 1] = off[e] + ((tot[e] + 255) & ~255); }
    const GAS int* toke = (const GAS int*)(ws + WS_TOKE); GAS int* perm = (GAS int*)(ws + WS_PERM);
    int base[8];
#pragma unroll
    for (int e = 0; e < 8; ++e) base[e] = off[e] + pre[e];
    for (int i0 = 0; C.gw + i0 * C.NGW < MTOK; i0 += 64) {
        const int row = C.gw + (i0 + lane) * C.NGW; const bool live = row < MTOK;
        const int ee = live ? toke[row] : 0xffff; const int e1 = ee & 0xff, e2 = (ee >> 8) & 0xff;
        int s1 = 0, s2 = 0; const unsigned long long lower = (1ull << lane) - 1ull;
#pragma unroll
        for (int e = 0; e < 8; ++e) { const unsigned long long m1 = __ballot(live && e1 == e), m2 = __ballot(live && e2 == e);
            const int rank = __popcll(m1 & lower) + __popcll(m2 & lower);
            if (e1 == e) s1 = base[e] + rank; if (e2 == e) s2 = base[e] + rank;
            base[e] += __popcll(m1) + __popcll(m2); }
        if (live) { perm[s1] = row; perm[s2] = row; *(GAS i32x2*)(ws + WS_TOKS + (size_t)row * 8) = (i32x2){s1, s2}; }
    }
    if (C.gw == 0) {
        const int ntile = off[8] >> 8;
        for (int t = lane; t < 1024; t += 64) { int e = 0;
#pragma unroll
            for (int k = 1; k < 8; ++k) e += (t * 256 >= off[k]) ? 1 : 0;
            __hip_atomic_store((gu32*)(ws + WS_TILE) + t, (unsigned)(t < ntile ? e : 0), RLX_AGENT); }
        if (lane == 0) __hip_atomic_store(ctl + CW_NTILES, (unsigned)ntile, RLX_AGENT);
    }
}
__device__ __forceinline__ void moe_gather(const Ctx& C, unsigned char* ws, int ntile) {
    const int lane_ = ph_tid() & 63;
    const GAS int* perm = (const GAS int*)(ws + WS_PERM); const unsigned char* xq = ws + WS_XQ; unsigned char* A = ws + WS_AMOE;
    const GAS float* xs = (const GAS float*)(ws + WS_XS); GAS float* sas = (GAS float*)(ws + WS_SAS);
    for (int s = C.gw; s < ntile * 256; s += C.NGW) { const int row = perm[s];
        v4u a = {0u, 0u, 0u, 0u}; float sc = 0.f;
        if (row >= 0) { a = ((const GAS v4u*)(xq + (size_t)row * DM))[lane_]; sc = xs[row]; }
        ((GAS v4u*)(A + (size_t)s * DM))[lane_] = a; if (lane_ == 0) sas[s] = sc; }
}
struct MoeOrder {
    int nM, nN, nwg, G, c, t0; const gu32* tile_expert;
    __device__ __forceinline__ void init(int t0_, int nT, int nN_, int G_, int c_, const gu32* te) { t0 = t0_; nM = nT; nN = nN_; nwg = nM * nN; G = G_; c = c_; tile_expert = te; }
    __device__ __forceinline__ bool next(int i, pg8::Unit& u) const {
        const long L = (long)i * G + c; if (L >= nwg) return false;
        int wgid = (int)L; { const int q = nwg / pg8::NXCD, r = nwg % pg8::NXCD, xcd = wgid % pg8::NXCD, off = wgid / pg8::NXCD; wgid = (xcd < r ? xcd * (q + 1) : r * (q + 1) + (xcd - r) * q) + off; }
        const int nig = pg8::WGM * nN, gid = wgid / nig, fm = gid * pg8::WGM, gsz = (nM - fm) < pg8::WGM ? (nM - fm) : pg8::WGM;
        const int pm = t0 + fm + ((wgid % nig) % gsz), pn = (wgid % nig) / gsz;
        const int e = (int)__builtin_amdgcn_readfirstlane(__hip_atomic_load(tile_expert + pm, RLX_AGENT));
        u.pm = pm; u.pn = e * nN + pn; return true;
    }
    __device__ __forceinline__ void a_ready(const pg8::Unit&) const {}
    __device__ __forceinline__ void done(const pg8::Unit&) const {}
};

__device__ __forceinline__ void sb_phase(const Ctx& C, const bf16* H, bf16* O) {
    LAS unsigned char* wl = C.lds + C.wave * 16384; LAS unsigned char* Kt = wl; LAS unsigned char* Vt = wl + 4608; LAS unsigned char* stg = wl + 9216;
    const int lane = (ph_tid() & 63), r32 = lane & 31, hi = lane >> 5;
    for (int u = C.gw; u < BATCH * 8 * 128; u += C.NGW) {
        const int qt = u & 127, h = (u >> 7) & 7, b = u >> 10;
        const bf16* Hb = H + (size_t)b * SEQ * D_IN + h * 64;
        bf16x8 qf[4];
#pragma unroll
        for (int dk = 0; dk < 4; ++dk) qf[dk] = *(const GAS bf16x8*)(Hb + (size_t)(qt * 32 + r32) * D_IN + OFF_QSB + 16 * dk + 8 * hi);
        float R = 0.f; f32x16 oacc[2]; oacc[0] = f32x16{}; oacc[1] = f32x16{};
        v4u kpre[4], vpre[4];
        tile32_fetch(Hb + (size_t)(qt * 32) * D_IN + OFF_KSB, D_IN, lane, kpre); tile32_fetch(Hb + (size_t)(qt * 32) * D_IN + OFF_VSB, D_IN, lane, vpre);
        for (int kt = qt; kt >= 0; --kt) {
            tile32_store(Kt, lane, kpre); tile32_store(Vt, lane, vpre);
            if (kt > 0) { tile32_fetch(Hb + (size_t)((kt - 1) * 32) * D_IN + OFF_KSB, D_IN, lane, kpre); tile32_fetch(Hb + (size_t)((kt - 1) * 32) * D_IN + OFF_VSB, D_IN, lane, vpre); }
            f32x16 acc = f32x16{};
#pragma unroll
            for (int dk = 0; dk < 4; ++dk) acc = mfma32(row_frag(Kt, r32, hi, dk), qf[dk], acc);
            const bool diag = (kt == qt);
            float z[16], lgv[16]; bool valid[16];
#pragma unroll
            for (int r = 0; r < 16; ++r) { z[r] = acc[r] * 0.125f; valid[r] = !diag || (crow(r, hi) < r32);
                const float e = ex2(-fabsf(z[r]) * LOG2E); const float sp = fmaxf(z[r], 0.f) + LN2 * lg2(1.0f + e); lgv[r] = valid[r] ? -sp : 0.f; }
            float G[4], PG[4], T[4];
#pragma unroll
            for (int g = 0; g < 4; ++g) { G[g] = (lgv[4 * g] + lgv[4 * g + 1]) + (lgv[4 * g + 2] + lgv[4 * g + 3]); PG[g] = __shfl_xor(G[g], 32); T[g] = G[g] + PG[g]; }
            float above[4]; above[3] = 0.f; above[2] = T[3]; above[1] = T[3] + T[2]; above[0] = T[3] + T[2] + T[1];
            float w[16];
#pragma unroll
            for (int g = 0; g < 4; ++g) { const float base = R + above[g] + (hi == 0 ? PG[g] : 0.f);
                float inc = 0.f;
#pragma unroll
                for (int i = 3; i >= 0; --i) { const int r = 4 * g + i; inc += lgv[r]; w[r] = valid[r] ? ex2((z[r] + base + inc) * LOG2E) : 0.f; } }
            R += (T[0] + T[1]) + (T[2] + T[3]);
            const bf16x8 pf0 = pack8(w), pf1 = pack8(w + 8);
#pragma unroll
            for (int db = 0; db < 2; ++db) {
                oacc[db] = mfma32(tr_frag(Vt, 4 * hi, 8 + 4 * hi, db, lane), pf0, oacc[db]);
                oacc[db] = mfma32(tr_frag(Vt, 16 + 4 * hi, 24 + 4 * hi, db, lane), pf1, oacc[db]); }
            if (__all(R < -88.0f)) break;
        }
#pragma unroll
        for (int db = 0; db < 2; ++db)
#pragma unroll
            for (int r = 0; r < 16; ++r) *(LAS unsigned short*)(stg + r32 * TP + (db * 32 + crow(r, hi)) * 2) = (unsigned short)cvtpk(oacc[db][r], 0.f);
#pragma unroll
        for (int i = 0; i < 4; ++i) { const int row = i * 8 + (lane >> 3), ch = lane & 7; const v4u v = *(const LAS v4u*)(stg + row * TP + ch * 16);
            *(GAS v4u*)(O + (size_t)(b * SEQ + qt * 32 + row) * DM + h * 64 + ch * 8) = v; }
    }
}

__device__ __forceinline__ void ret_kv_phase(const Ctx& C, const bf16* H, const float* rope, float* KV) {
    LAS unsigned char* wl = C.lds + C.wave * 16384; LAS unsigned char* Kt = wl; LAS unsigned char* Vt = wl + 4608;
    const int lane = (ph_tid() & 63), r32 = lane & 31, hi = lane >> 5;
    for (int u = C.gw; u < BATCH * 8 * 64; u += C.NGW) {
        const int c = u & 63, h = (u >> 6) & 7, b = u >> 9;
        const float l2g = log1pf(-ex2((float)(-5 - h))) * LOG2E;
        const bf16* Hb = H + ((size_t)b * SEQ + c * 64) * D_IN + h * 64;
        f32x16 acc[2][2]; acc[0][0] = f32x16{}; acc[0][1] = f32x16{}; acc[1][0] = f32x16{}; acc[1][1] = f32x16{};
        for (int jh = 0; jh < 2; ++jh) {
            load_tile32_rot<true>(Hb + (size_t)(32 * jh) * D_IN + OFF_KR, D_IN, rope, c * 64 + 32 * jh, 32 * jh, l2g, Kt, lane);
            load_tile32(Hb + (size_t)(32 * jh) * D_IN + OFF_VR, D_IN, Vt, lane);
#pragma unroll
            for (int m = 0; m < 2; ++m) {
                bf16x8 kf[2], vf[2];
#pragma unroll
                for (int a = 0; a < 2; ++a) { kf[a] = tr_frag(Kt, 16 * m + 8 * hi, 16 * m + 8 * hi + 4, a, lane); vf[a] = tr_frag(Vt, 16 * m + 8 * hi, 16 * m + 8 * hi + 4, a, lane); }
#pragma unroll
                for (int a = 0; a < 2; ++a)
#pragma unroll
                    for (int b2 = 0; b2 < 2; ++b2) acc[a][b2] = mfma32(kf[a], vf[b2], acc[a][b2]);
            }
        }
        float* dst = KV + ((size_t)((b * 8 + h) * 64 + c)) * 4096;
#pragma unroll
        for (int a = 0; a < 2; ++a)
#pragma unroll
            for (int b2 = 0; b2 < 2; ++b2)
#pragma unroll
                for (int r = 0; r < 16; ++r) dst[(crow(r, hi) + 32 * a) * 64 + r32 + 32 * b2] = acc[a][b2][r];
    }
}
__device__ __forceinline__ void ret_scan_phase(const Ctx& C, float* KV) {
    for (int idx = C.gw * 64 + (ph_tid() & 63); idx < BATCH * 8 * 4096; idx += C.NGW * 64) {
        const int bh = idx >> 12, el = idx & 4095, h = bh & 7;
        const float dc = ex2(64.0f * log1pf(-ex2((float)(-5 - h))) * LOG2E);
        float* p = KV + (size_t)bh * 64 * 4096 + el; float st = 0.f;
        for (int c0 = 0; c0 < 64; c0 += 8) { float t[8];
#pragma unroll
            for (int k = 0; k < 8; ++k) t[k] = p[(size_t)(c0 + k) * 4096];
#pragma unroll
            for (int k = 0; k < 8; ++k) { p[(size_t)(c0 + k) * 4096] = st; st = st * dc + t[k]; } }
    }
}
__device__ __forceinline__ void ret_out_phase(const Ctx& C, const bf16* H, const float* rope, const float* KV, const float* gn_g, bf16* O) {
    LAS unsigned char* wl = C.lds + C.wave * 16384; LAS unsigned char* Kt = wl; LAS unsigned char* Vt = wl + 4608; LAS unsigned char* St = wl + 9216;
    LAS float* stf = (LAS float*)wl;
    const int lane = (ph_tid() & 63), r32 = lane & 31, hi = lane >> 5;
    for (int u = C.gw; u < BATCH * 8 * 64 * 2; u += C.NGW) {
        const int ih = u & 1, c = (u >> 1) & 63, h = (u >> 7) & 7, b = u >> 10;
        const float l2g = log1pf(-ex2((float)(-5 - h))) * LOG2E;
        const bf16* Hb = H + ((size_t)b * SEQ + c * 64) * D_IN + h * 64;
        const int iq = 32 * ih + r32, pos = c * 64 + iq;
        bf16x8 qf[4];
        { v4u qr[4];
#pragma unroll
          for (int dk = 0; dk < 4; ++dk) qr[dk] = *(const GAS v4u*)(Hb + (size_t)iq * D_IN + OFF_QR + 16 * dk + 8 * hi);
#pragma unroll
          for (int dk = 0; dk < 2; ++dk) { const float* rp = rope + (size_t)pos * 64 + 16 * dk + 8 * hi;
              const f32x4 c0 = *(const GAS f32x4*)rp, c1 = *(const GAS f32x4*)(rp + 4), s0 = *(const GAS f32x4*)(rp + 32), s1 = *(const GAS f32x4*)(rp + 36);
              float o1[8], o2[8];
#pragma unroll
              for (int e = 0; e < 8; ++e) { const float x1 = bfel(qr[dk], e), x2 = bfel(qr[dk + 2], e), cc = e < 4 ? c0[e & 3] : c1[e & 3], ss = e < 4 ? s0[e & 3] : s1[e & 3];
                  o1[e] = (x1 * cc - x2 * ss) * 0.125f; o2[e] = (x1 * ss + x2 * cc) * 0.125f; }
              qf[dk] = pack8(o1); qf[dk + 2] = pack8(o2); } }
        f32x16 oacc[2]; oacc[0] = f32x16{}; oacc[1] = f32x16{};
        for (int jt = 0; jt <= ih; ++jt) {
            load_tile32_rot<false>(Hb + (size_t)(32 * jt) * D_IN + OFF_KR, D_IN, rope, c * 64 + 32 * jt, 32 * jt, 0.f, Kt, lane);
            load_tile32(Hb + (size_t)(32 * jt) * D_IN + OFF_VR, D_IN, Vt, lane);
            f32x16 acc = f32x16{};
#pragma unroll
            for (int dk = 0; dk < 4; ++dk) acc = mfma32(row_frag(Kt, r32, hi, dk), qf[dk], acc);
            float w[16];
#pragma unroll
            for (int r = 0; r < 16; ++r) { const int dl = iq - (32 * jt + crow(r, hi)); w[r] = dl >= 0 ? acc[r] * ex2((float)dl * l2g) : 0.f; }
            const bf16x8 pf0 = pack8(w), pf1 = pack8(w + 8);
#pragma unroll
            for (int eb = 0; eb < 2; ++eb) {
                oacc[eb] = mfma32(tr_frag(Vt, 4 * hi, 8 + 4 * hi, eb, lane), pf0, oacc[eb]);
                oacc[eb] = mfma32(tr_frag(Vt, 16 + 4 * hi, 24 + 4 * hi, eb, lane), pf1, oacc[eb]); }
        }
        f32x16 cacc[2]; cacc[0] = f32x16{}; cacc[1] = f32x16{};
        const float* Sg = KV + ((size_t)((b * 8 + h) * 64 + c)) * 4096;
        for (int half = 0; half < 2; ++half) {
#pragma unroll
            for (int i = 0; i < 4; ++i) { const int id = i * 64 + lane, row = id >> 3, ch = id & 7;
                const f32x4 a = *(const GAS f32x4*)(Sg + (size_t)(32 * half + row) * 64 + ch * 8), bb = *(const GAS f32x4*)(Sg + (size_t)(32 * half + row) * 64 + ch * 8 + 4);
                v4u t; t.x = cvtpk(a[0], a[1]); t.y = cvtpk(a[2], a[3]); t.z = cvtpk(bb[0], bb[1]); t.w = cvtpk(bb[2], bb[3]); *(LAS v4u*)(St + row * TP + ch * 16) = t; }
#pragma unroll
            for (int m2 = 0; m2 < 2; ++m2)
#pragma unroll
                for (int eb = 0; eb < 2; ++eb) cacc[eb] = mfma32(tr_frag(St, 16 * m2 + 8 * hi, 16 * m2 + 8 * hi + 4, eb, lane), qf[2 * half + m2], cacc[eb]);
        }
        const float dq = ex2((float)(iq + 1) * l2g);
        float x[2][16]; float s = 0.f;
#pragma unroll
        for (int eb = 0; eb < 2; ++eb)
#pragma unroll
            for (int r = 0; r < 16; ++r) { x[eb][r] = oacc[eb][r] + dq * cacc[eb][r]; s += x[eb][r]; }
        s += __shfl_xor(s, 32); const float mean = s * (1.0f / 64.0f); float s2 = 0.f;
#pragma unroll
        for (int eb = 0; eb < 2; ++eb)
#pragma unroll
            for (int r = 0; r < 16; ++r) { x[eb][r] -= mean; s2 += x[eb][r] * x[eb][r]; }
        s2 += __shfl_xor(s2, 32); const float rstd = 1.0f / sqrtf(s2 * (1.0f / 64.0f) + LN_EPS);
#pragma unroll
        for (int eb = 0; eb < 2; ++eb)
#pragma unroll
            for (int r = 0; r < 16; ++r) stf[r32 * 66 + 32 * eb + crow(r, hi)] = x[eb][r] * rstd;
#pragma unroll
        for (int i = 0; i < 4; ++i) { const int row = i * 8 + (lane >> 3), ch = lane & 7;
            const v4u gq = *(const GAS v4u*)(Hb + (size_t)(32 * ih + row) * D_IN + OFF_GR + ch * 8);
            const f32x4 g0 = *(const GAS f32x4*)(gn_g + h * 64 + ch * 8), g1 = *(const GAS f32x4*)(gn_g + h * 64 + ch * 8 + 4);
            float o[8];
#pragma unroll
            for (int e = 0; e < 8; ++e) { const float gate = bfel(gq, e), nv = stf[row * 66 + ch * 8 + e], gg = e < 4 ? g0[e & 3] : g1[e & 3];
                o[e] = gate * __builtin_amdgcn_rcpf(1.0f + ex2(-gate * LOG2E)) * nv * gg; }
            v4u t; t.x = cvtpk(o[0], o[1]); t.y = cvtpk(o[2], o[3]); t.z = cvtpk(o[4], o[5]); t.w = cvtpk(o[6], o[7]);
            *(GAS v4u*)(O + (size_t)(b * SEQ + c * 64 + 32 * ih + row) * DM + 512 + h * 64 + ch * 8) = t; }
    }
}

constexpr int CA_SLOT = 2 * 64 * TP, CA_TB = 5 * CA_SLOT, CA_STG = CA_TB + 2304;
static_assert(CA_STG + 8 * 32 * TP <= LDSCTL_OFF, "chunk attention LDS map");
__device__ __forceinline__ void ca_softmax_pv(const f32x16& a0, const f32x16& a1, int st, const LAS float* tb, const LAS unsigned char* Vs, int iq, int hi, int lane, float& m, float& l, f32x16 (&oacc)[2]) {
    const float C1 = 0.125f * LOG2E;
    f32x16 p0, p1; float mn;
    if (st <= 3) {
        const float bc = tb[575 - 512];
        float t = fmaxf(a0[0], a1[0]);
#pragma unroll
        for (int r = 1; r < 16; ++r) t = fmaxf(fmaxf(t, a0[r]), a1[r]);
        float tm = t * C1 + bc; tm = xmax32(tm); mn = fmaxf(m, tm);
        const float cc = bc - mn; p0 = a0 * C1 + cc; p1 = a1 * C1 + cc;
    } else {
        int lo_ = iq - 4 * hi; asm volatile("" : "+v"(lo_));
        const LAS float* tp = tb + (575 - 256 - 64 * (8 - st)) - lo_;
#pragma unroll
        for (int r = 0; r < 16; ++r) { const int k = (r & 3) + 8 * (r >> 2); p0[r] = a0[r] * C1 + tp[k]; p1[r] = a1[r] * C1 + tp[k + 32]; }
        float t = fmaxf(p0[0], p1[0]);
#pragma unroll
        for (int r = 1; r < 16; ++r) t = fmaxf(fmaxf(t, p0[r]), p1[r]);
        t = xmax32(t); mn = fmaxf(m, t);
        p0 = p0 - mn; p1 = p1 - mn;
    }
    if (__any(mn > m)) { const float al = ex2(m - mn); l *= al; oacc[0] = oacc[0] * al; oacc[1] = oacc[1] * al; }
    m = mn;
#pragma unroll
    for (int r = 0; r < 16; ++r) { p0[r] = ex2(p0[r]); p1[r] = ex2(p1[r]); }
    { const f32x16 sm = p0 + p1; float ps = 0.f;
#pragma unroll
      for (int r = 0; r < 16; r += 4) ps += (sm[r] + sm[r + 1]) + (sm[r + 2] + sm[r + 3]);
      l += ps; }
    float s0[16], s1[16];
#pragma unroll
    for (int r = 0; r < 16; ++r) { s0[r] = p0[r]; s1[r] = p1[r]; }
    const bf16x8 p00 = pack8(s0), p01 = pack8(s0 + 8), p10 = pack8(s1), p11 = pack8(s1 + 8);
#pragma unroll
    for (int db = 0; db < 2; ++db) {
        bf16x8 vf[4];
#pragma unroll
        for (int k = 0; k < 4; ++k) vf[k] = tr_frag(Vs, 16 * k + 4 * hi, 16 * k + 8 + 4 * hi, db, lane);
        __builtin_amdgcn_sched_barrier(0);
        oacc[db] = mfma32(vf[0], p00, oacc[db]); oacc[db] = mfma32(vf[1], p01, oacc[db]);
        oacc[db] = mfma32(vf[2], p10, oacc[db]); oacc[db] = mfma32(vf[3], p11, oacc[db]); }
}
#define CA_BAR() asm volatile("s_waitcnt lgkmcnt(0)\n\ts_barrier" ::: "memory")
__device__ __forceinline__ void chunk_attn_phase(const Ctx& C, const bf16* QKV, const float* rel_bias, bf16* O) {
    const int lane = (ph_tid() & 63), r32 = lane & 31, hi = lane >> 5, w = C.wave, tid = ph_tid();
    LAS unsigned char* lds = C.lds; LAS float* tb = (LAS float*)(lds + CA_TB); LAS unsigned char* stg = lds + CA_STG + w * (32 * TP);
    const int prow = tid >> 3, pch = tid & 7;
    const int NU = BATCH * 16 * 16, per = (NU + C.G - 1) / C.G;
    const bool late = w >= 4;
    int cur_h = -1;
    for (int i = 0; i < per; ++i) {
        const int u = C.vcu * per + i; if (u >= NU) break;
        const int g = u & 15, h = (u >> 4) & 15, b = u >> 8, c0 = 4 * g, qc = c0 + (w >> 1), iq = 32 * (w & 1) + r32;
        CA_BAR();
        if (h != cur_h) { for (int k = tid; k < 576; k += NWAVES * 64) { const int e = 575 - k; tb[k] = rel_bias[h * 513 + (e > 512 ? 512 : e)] * LOG2E; } cur_h = h; }
        const bf16* Qb = QKV + (size_t)b * SEQ * NQKV + h * 64;
        const bf16* Kp = Qb + (size_t)prow * NQKV + 1024 + pch * 8;
        bf16x8 qf[4];
#pragma unroll
        for (int dk = 0; dk < 4; ++dk) qf[dk] = *(const GAS bf16x8*)(Qb + (size_t)(qc * 64 + iq) * NQKV + 16 * dk + 8 * hi);
#pragma unroll
        for (int j = 0; j < 4; ++j) { const int kcj = c0 - 8 + j;
            if (kcj >= 0) { const v4u kr = *(const GAS v4u*)(Kp + (size_t)kcj * 64 * NQKV), vr = *(const GAS v4u*)(Kp + (size_t)kcj * 64 * NQKV + 1024);
                LAS unsigned char* sl = lds + (kcj % 5) * CA_SLOT + prow * TP + pch * 16; *(LAS v4u*)sl = kr; *(LAS v4u*)(sl + 64 * TP) = vr; } }
        asm volatile("" : "+v"(qf[0]), "+v"(qf[1]), "+v"(qf[2]), "+v"(qf[3]));
        v4u kA = {0u, 0u, 0u, 0u}, vA = {0u, 0u, 0u, 0u}, kB = {0u, 0u, 0u, 0u}, vB = {0u, 0u, 0u, 0u};
        { const int nx = c0 - 4 < 0 ? 0 : c0 - 4; kA = *(const GAS v4u*)(Kp + (size_t)nx * 64 * NQKV); vA = *(const GAS v4u*)(Kp + (size_t)nx * 64 * NQKV + 1024); }
        CA_BAR();
        float m = -1.0e30f, l = 0.f; f32x16 oacc[2]; oacc[0] = f32x16{}; oacc[1] = f32x16{};
        f32x16 a0 = f32x16{}, a1 = f32x16{};
#define CA_STEP(ST, KR, VR, KN, VN) do { const int st = (ST); \
            const int pre = c0 - 4 + st; const bool has_pre = (st < 8) && (pre >= 0); \
            { const int nx = pre + 1 < 0 ? 0 : (pre + 1 > 63 ? 63 : pre + 1);     \
              KN = *(const GAS v4u*)(Kp + (size_t)nx * 64 * NQKV); VN = *(const GAS v4u*)(Kp + (size_t)nx * 64 * NQKV + 1024); } \
            const int kc = qc - 8 + st; \
            if (late && st > 0 && kc - 1 >= 0) ca_softmax_pv(a0, a1, st - 1, tb, lds + ((kc - 1) % 5) * CA_SLOT + 64 * TP, iq, hi, lane, m, l, oacc);     \
            if (kc >= 0) { \
                const LAS unsigned char* Ks = lds + (kc % 5) * CA_SLOT; \
                a0 = f32x16{}; a1 = f32x16{}; \
                _Pragma("unroll") for (int dk = 0; dk < 4; ++dk) { a0 = mfma32(row_frag(Ks, r32, hi, dk), qf[dk], a0); a1 = mfma32(row_frag(Ks + 32 * TP, r32, hi, dk), qf[dk], a1); } \
                if (!late) ca_softmax_pv(a0, a1, st, tb, Ks + 64 * TP, iq, hi, lane, m, l, oacc); \
            } \
            if (has_pre) { LAS unsigned char* sl = lds + (pre % 5) * CA_SLOT + prow * TP + pch * 16; *(LAS v4u*)sl = KR; *(LAS v4u*)(sl + 64 * TP) = VR; } \
            CA_BAR(); } while (0)
        for (int s2 = 0; s2 < 8; s2 += 2) { CA_STEP(s2, kA, vA, kB, vB); CA_STEP(s2 + 1, kB, vB, kA, vA); }
        CA_STEP(8, kA, vA, kB, vB);
#undef CA_STEP
        if (late) ca_softmax_pv(a0, a1, 8, tb, lds + (qc % 5) * CA_SLOT + 64 * TP, iq, hi, lane, m, l, oacc);
        l += __shfl_xor(l, 32); const float inv = 1.0f / l;
#pragma unroll
        for (int db = 0; db < 2; ++db)
#pragma unroll
            for (int r = 0; r < 16; ++r) *(LAS unsigned short*)(stg + r32 * TP + (db * 32 + crow(r, hi)) * 2) = (unsigned short)cvtpk(oacc[db][r] * inv, 0.f);
#pragma unroll
        for (int k = 0; k < 4; ++k) { const int row = k * 8 + (lane >> 3), ch = lane & 7; const v4u v = *(const LAS v4u*)(stg + row * TP + ch * 16);
            *(GAS v4u*)(O + (size_t)(b * SEQ + qc * 64 + 32 * (w & 1) + row) * DM + h * 64 + ch * 8) = v; }
    }
}

struct Params { const float* in[23]; float* out; unsigned char* ws; };
__global__ void __launch_bounds__(NWAVES * 64, 2) fwd_kernel(Params p) {
    extern __shared__ __attribute__((aligned(16))) unsigned char lds_raw[];
    Ctx C;
    C.lds = (LAS unsigned char*)lds_raw; C.wave = __builtin_amdgcn_readfirstlane((int)threadIdx.x >> 6);
    C.G = gridDim.x; { const int bx = blockIdx.x; C.vcu = (C.G % 8 == 0) ? (bx % 8) * (C.G / 8) + bx / 8 : bx; }
    C.gw = C.vcu * NWAVES + C.wave; C.NGW = C.G * NWAVES;
    unsigned char* ws = p.ws; gu32* ctl = (gu32*)(ws + WS_CTL);
    volatile LAS unsigned* MISC = (volatile LAS unsigned*)(C.lds + MISC_OFF);
    for (int u = threadIdx.x; u < (LDS_BYTES - LDSCTL_OFF) / 4; u += NWAVES * 64) ((LAS unsigned*)(C.lds + LDSCTL_OFF))[u] = 0u;
    __syncthreads();
    XcdBarrier bar = xcd_barrier_post((unsigned*)(ctl + CW_BAR), MISC + 8);
#define GRID_BAR() xcd_barrier(bar)
    const int bx = (int)blockIdx.x;
    bf16* XB = (bf16*)(ws + WS_XB); bf16* OB = (bf16*)(ws + WS_O); bf16* MIX = (bf16*)(ws + WS_MIX);
    float* KV = p.out;     const float* rope = (const float*)(ws + WS_ROPE);

    p0_prologue(C, p.in, ws, (unsigned char*)p.out);
    GRID_BAR();
    quant_rows_fp8<2>(C, (const bf16*)((unsigned char*)p.out + OUT_WGU1), NEXP * 2 * FF1, ws + WS_WGU1Q, (float*)(ws + WS_SBGU));
    quant_rows_fp8<7>(C, (const bf16*)((unsigned char*)p.out + OUT_WDN1), NEXP * DM, ws + WS_WDN1Q, (float*)(ws + WS_SBDN));
    { pg8::Gemm g{XB, (const bf16*)(ws + WS_WIN), MTOK, D_IN, DM}; pg8::StaticOrder S; S.init(MTOK, D_IN, C.G, bx);
      pg8::EpiPlain E{(bf16*)(ws + WS_H), D_IN, 0, 0};
      pg8::gemm_phase<pg8::EpiPlain, pg8::StaticOrder, true, true>(C.lds, g, S, E); }
    GRID_BAR();
    sb_phase(C, (const bf16*)(ws + WS_H), OB);
    ret_kv_phase(C, (const bf16*)(ws + WS_H), rope, KV);
    GRID_BAR();
    ret_scan_phase(C, KV);
    GRID_BAR();
    ret_out_phase(C, (const bf16*)(ws + WS_H), rope, KV, p.in[4], OB);
    GRID_BAR();
    { pg8::Gemm g{OB, (const bf16*)(ws + WS_WO0), MTOK, DM, DM}; pg8::StaticOrder S; S.init(MTOK, DM, C.G, bx);
      pg8::EpiPlain E{MIX, DM, 0, 0};
      pg8::gemm_phase<pg8::EpiPlain, pg8::StaticOrder, true, true>(C.lds, g, S, E); }
    GRID_BAR();
    ln_phase<0, false>(C, XB, MIX, p.in[1], p.in[2], nullptr, XB, nullptr, nullptr, ws);
    GRID_BAR();
    { pg8::Gemm g{XB, (const bf16*)(ws + WS_WGU0), MTOK, 2 * FF0, DM}; pg8::StaticOrder S; S.init(MTOK, 2 * FF0, C.G, bx);
      pg8::EpiSwiGLU E{(bf16*)(ws + WS_HID0), FF0, 0, 0};
      pg8::gemm_phase<pg8::EpiSwiGLU, pg8::StaticOrder, true, true>(C.lds, g, S, E); }
    GRID_BAR();
    { pg8::Gemm g{(const bf16*)(ws + WS_HID0), (const bf16*)(ws + WS_WDN0), MTOK, DM, FF0}; pg8::StaticOrder S; S.init(MTOK, DM, C.G, bx);
      pg8::EpiPlain E{MIX, DM, 0, 0};
      pg8::gemm_phase<pg8::EpiPlain, pg8::StaticOrder, true, true>(C.lds, g, S, E); }
    GRID_BAR();
    ln_phase<0, false>(C, XB, MIX, p.in[6], p.in[7], nullptr, XB, nullptr, nullptr, ws);
    GRID_BAR();
    { pg8::Gemm g{XB, (const bf16*)(ws + WS_WQKV), MTOK, NQKV, DM}; pg8::StaticOrder S; S.init(MTOK, NQKV, C.G, bx);
      pg8::EpiPlain E{(bf16*)(ws + WS_QKV), NQKV, 0, 0};
      pg8::gemm_phase<pg8::EpiPlain, pg8::StaticOrder, true, true>(C.lds, g, S, E); }
    GRID_BAR();
    chunk_attn_phase(C, (const bf16*)(ws + WS_QKV), p.in[14], OB);
    GRID_BAR();
    { pg8::Gemm g{OB, (const bf16*)(ws + WS_WO1), MTOK, DM, DM}; pg8::StaticOrder S; S.init(MTOK, DM, C.G, bx);
      pg8::EpiPlain E{MIX, DM, 0, 0};
      pg8::gemm_phase<pg8::EpiPlain, pg8::StaticOrder, true, true>(C.lds, g, S, E); }
    GRID_BAR();
    ln_phase<1, false>(C, XB, MIX, p.in[11], p.in[12], nullptr, XB, p.in[18], p.in[19], ws);
    GRID_BAR();
    moe_assign(C, ws, ctl);
    GRID_BAR();
    const int ntile = (int)__builtin_amdgcn_readfirstlane(__hip_atomic_load(ctl + CW_NTILES, RLX_AGENT));
    moe_gather(C, ws, ntile);
    GRID_BAR();
    for (int t0 = 0; t0 < ntile; t0 += MOE_SLICE) {
        const int nT = (ntile - t0) < MOE_SLICE ? (ntile - t0) : MOE_SLICE;
        { pg8::Gemm g{(const bf16*)(ws + WS_AMOE), (const bf16*)(ws + WS_WGU1Q), MOE_ROWS, 2 * FF1, DM / 2}; MoeOrder S; S.init(t0, nT, 2 * FF1 / 256, C.G, bx, (const gu32*)(ws + WS_TILE));
          pg8::EpiSwiGLU8 E{ws + WS_HSL, FF1, 2 * FF1 / 256, t0, (const float*)(ws + WS_SAS), (const float*)(ws + WS_SBGU)};
          pg8::gemm_phase<pg8::EpiSwiGLU8, MoeOrder, true, true, 1>(C.lds, g, S, E); }
        GRID_BAR();
        { pg8::Gemm g{(const bf16*)(ws + WS_HSL - (size_t)t0 * 256 * FF1), (const bf16*)(ws + WS_WDN1Q), MOE_ROWS, DM, FF1 / 2}; MoeOrder S; S.init(t0, nT, DM / 256, C.G, bx, (const gu32*)(ws + WS_TILE));
          pg8::EpiPlain8 E{(bf16*)(ws + WS_Y), DM, DM / 256, (const float*)(ws + WS_SBDN)};
          pg8::gemm_phase<pg8::EpiPlain8, MoeOrder, true, true, 1>(C.lds, g, S, E); }
        GRID_BAR();
    }
    ln_phase<2, false>(C, XB, (const bf16*)(ws + WS_Y), p.in[16], p.in[17], p.out, nullptr, nullptr, nullptr, ws);
#undef GRID_BAR
}

extern "C" void kernel_launch(void* const* d_in, const int* in_sizes, int n_in, void* d_out, int out_size, void* d_ws, size_t ws_size, hipStream_t stream) {
    static int grid = 0;
    if (grid == 0) {
        if (n_in != 23 || in_sizes[0] != MTOK * DM || out_size != MTOK * DM || ws_size < WS_END) {
            fprintf(stderr, "kernel_launch: unexpected shapes/workspace (n_in %d, in0 %d, out %d, ws %zu, need %zu); nothing launched\n", n_in, n_in > 0 ? in_sizes[0] : -1, out_size, ws_size, (size_t)WS_END); grid = -1; return; }
        int dev = 0, cus = 0, per_cu = 0;
        if (hipGetDevice(&dev) != hipSuccess || hipDeviceGetAttribute(&cus, hipDeviceAttributeMultiprocessorCount, dev) != hipSuccess) { grid = -1; return; }
        if (hipFuncSetAttribute((const void*)fwd_kernel, hipFuncAttributeMaxDynamicSharedMemorySize, LDS_BYTES) != hipSuccess) { fprintf(stderr, "kernel_launch: hipFuncSetAttribute failed\n"); grid = -1; return; }
        if (hipOccupancyMaxActiveBlocksPerMultiprocessor(&per_cu, (const void*)fwd_kernel, NWAVES * 64, LDS_BYTES) != hipSuccess || per_cu < 1)
            fprintf(stderr, "kernel_launch: note: occupancy query reports %d workgroups per CU\n", per_cu);
        (void)hipGetLastError();
        grid = cus;
    }
    if (grid < 0) return;
    if (hipMemsetAsync((char*)d_ws + WS_CTL, 0, CTL_ZERO_BYTES, stream) != hipSuccess) return;
    Params p{};
    for (int i = 0; i < 23; ++i) p.in[i] = (const float*)d_in[i];
    p.out = (float*)d_out; p.ws = (unsigned char*)d_ws;
    hipLaunchKernelGGL(fwd_kernel, dim3(grid), dim3(NWAVES * 64), LDS_BYTES, stream, p);
}
```

```cpp
#include <hip/hip_runtime.h>
#include <cstdio>
#include <cstdint>
namespace pg8 {
#define PG8_LAS __attribute__((address_space(3)))
typedef unsigned short bf16_t;
typedef short bf16x8 __attribute__((ext_vector_type(8)));
typedef float f32x4 __attribute__((ext_vector_type(4)));
typedef unsigned u32x4 __attribute__((ext_vector_type(4)));
constexpr int BM = 256, BK = 64, HALF = 128, HTB = HALF * BK * 2  , STAGE_BYTES = 8 * HTB, NXCD = 8, WGM = 8;

__host__ __device__ __forceinline__ int lds_byte(int r, int c) { const int st = (r >> 4) * 2 + (c >> 5), rr = r & 15, cc = c & 31, ob = rr * 64 + cc * 2; return st * 1024 + (ob ^ (((ob >> 9) & 1) << 5)); }
__host__ __device__ __forceinline__ void stage_rc(int b, int& R, int& C) { const int st = b / 1024, sb = b % 1024, swz = sb ^ (((sb >> 9) & 1) << 5); R = (st >> 1) * 16 + swz / 64; C = (st & 1) * 32 + (swz % 64) / 2; }
__host__ __device__ __forceinline__ int perm32(int rho) { const int n = rho >> 4, i = rho & 15; return 8 * (i >> 2) + 4 * n + (i & 3); }

struct Unit { int pm, pn; };
struct Gemm { const bf16_t* A; const bf16_t* Bt; int M, N, K; };

struct StaticOrder {
    int nM, nN, nwg, G, c;
    __host__ __device__ void init(int M, int N, int G_, int c_) { nM = M / BM; nN = N / BM; nwg = nM * nN; G = G_; c = c_; }
    __host__ __device__ bool next(int i, Unit& u) const {
        const long L = (long)i * G + c; if (L >= nwg) return false;
        int wgid = (int)L; { const int q = nwg / NXCD, r = nwg % NXCD, xcd = wgid % NXCD, off = wgid / NXCD; wgid = (xcd < r ? xcd * (q + 1) : r * (q + 1) + (xcd - r) * q) + off; }
        const int nig = WGM * nN, gid = wgid / nig, fm = gid * WGM, gsz = (nM - fm) < WGM ? (nM - fm) : WGM;
        u.pm = fm + ((wgid % nig) % gsz); u.pn = (wgid % nig) / gsz; return true;
    }
    __device__ __forceinline__ void a_ready(const Unit&) const {}
    __device__ __forceinline__ void done(const Unit&) const {}
};
__device__ __forceinline__ unsigned cvt_pk_bf16(float lo, float hi) { unsigned r; asm volatile("v_cvt_pk_bf16_f32 %0, %1, %2" : "=v"(r) : "v"(lo), "v"(hi)); return r; }
typedef float f32x2 __attribute__((ext_vector_type(2)));
__device__ __forceinline__ float silu_mul(float g, float u) { const float e = __builtin_amdgcn_exp2f(g * -1.44269504089f); return g * u * __builtin_amdgcn_rcpf(1.0f + e); }
struct EpiPlain {
    static constexpr bool PERM = true, AFTER_DRAIN = false;
    bf16_t* O; int ldc; int pn_mod; int pm_sub;
    __device__ __forceinline__ void operator()(const f32x4 (&acc)[2][2][4][2], const Unit& u, int wr, int wc, int fr, int fq) const {
        const int pn = pn_mod ? (u.pn % pn_mod) : u.pn;
        const int row0 = (u.pm - pm_sub) * BM + wr * 64 + fr, col0 = pn * BM + wc * 32 + 8 * fq;
#pragma unroll
        for (int ai = 0; ai < 2; ++ai)
#pragma unroll
            for (int m = 0; m < 4; ++m) { bf16_t* rowp = O + (size_t)(row0 + ai * HALF + m * 16) * ldc + col0;
#pragma unroll
                for (int bj = 0; bj < 2; ++bj) { const f32x4 v0 = acc[ai][bj][m][0], v1 = acc[ai][bj][m][1];
                    u32x4 w; w.x = cvt_pk_bf16(v0[0], v0[1]); w.y = cvt_pk_bf16(v0[2], v0[3]); w.z = cvt_pk_bf16(v1[0], v1[1]); w.w = cvt_pk_bf16(v1[2], v1[3]);
                    *(u32x4*)(rowp + bj * HALF) = w; } }
    }
};
struct EpiSwiGLU {
    static constexpr bool PERM = true, AFTER_DRAIN = false;
    bf16_t* O; int ldc; int pn_mod; int pm_sub;
    __device__ __forceinline__ void operator()(const f32x4 (&acc)[2][2][4][2], const Unit& u, int wr, int wc, int fr, int fq) const {
        const int pn = pn_mod ? (u.pn % pn_mod) : u.pn;
        const int row0 = (u.pm - pm_sub) * BM + wr * 64 + fr, col0 = pn * HALF + wc * 32 + 8 * fq;
#pragma unroll
        for (int ai = 0; ai < 2; ++ai)
#pragma unroll
            for (int m = 0; m < 4; ++m) { bf16_t* rowp = O + (size_t)(row0 + ai * HALF + m * 16) * ldc + col0;
                const f32x4 g0 = acc[ai][0][m][0], g1 = acc[ai][0][m][1], u0 = acc[ai][1][m][0], u1 = acc[ai][1][m][1];
                u32x4 w; w.x = cvt_pk_bf16(silu_mul(g0[0], u0[0]), silu_mul(g0[1], u0[1])); w.y = cvt_pk_bf16(silu_mul(g0[2], u0[2]), silu_mul(g0[3], u0[3]));
                w.z = cvt_pk_bf16(silu_mul(g1[0], u1[0]), silu_mul(g1[1], u1[1])); w.w = cvt_pk_bf16(silu_mul(g1[2], u1[2]), silu_mul(g1[3], u1[3]));
                *(u32x4*)rowp = w; }
    }
};
typedef int i32x4_t __attribute__((ext_vector_type(4)));
typedef int i32x8_t __attribute__((ext_vector_type(8)));
typedef unsigned u32x2_t __attribute__((ext_vector_type(2)));
__device__ __forceinline__ i32x8_t cat8(bf16x8 a, bf16x8 b) { const i32x4_t x = __builtin_bit_cast(i32x4_t, a), y = __builtin_bit_cast(i32x4_t, b); return __builtin_shufflevector(x, y, 0, 1, 2, 3, 4, 5, 6, 7); }
__device__ __forceinline__ unsigned pk4_fp8(float a, float b, float c, float d) { int w = __builtin_amdgcn_cvt_pk_fp8_f32(a, b, 0, false); w = __builtin_amdgcn_cvt_pk_fp8_f32(c, d, w, true); return (unsigned)w; }
struct EpiSwiGLU8 {
    static constexpr bool PERM = true, AFTER_DRAIN = false;
    unsigned char* O; int ldc; int pn_mod; int pm_sub; const float* sa; const float* sb;
    __device__ __forceinline__ void operator()(const f32x4 (&acc)[2][2][4][2], const Unit& u, int wr, int wc, int fr, int fq) const {
        const int pn = u.pn % pn_mod;
        const int row0 = u.pm * BM + wr * 64 + fr, col0 = pn * HALF + wc * 32 + 8 * fq, bcol = u.pn * BM + wc * 32 + 8 * fq;
        const f32x4 sg0 = *(const f32x4*)(sb + bcol), sg1 = *(const f32x4*)(sb + bcol + 4), su0 = *(const f32x4*)(sb + bcol + HALF), su1 = *(const f32x4*)(sb + bcol + HALF + 4);
        float av[2][4];
#pragma unroll
        for (int ai = 0; ai < 2; ++ai)
#pragma unroll
            for (int m = 0; m < 4; ++m) av[ai][m] = sa[row0 + ai * HALF + m * 16];
#pragma unroll
        for (int ai = 0; ai < 2; ++ai)
#pragma unroll
            for (int m = 0; m < 4; ++m) { const int r = row0 + ai * HALF + m * 16; const float a = av[ai][m];
                const f32x4 g0 = acc[ai][0][m][0] * (sg0 * a), g1 = acc[ai][0][m][1] * (sg1 * a), u0 = acc[ai][1][m][0] * (su0 * a), u1 = acc[ai][1][m][1] * (su1 * a);
                u32x2_t w; w.x = pk4_fp8(silu_mul(g0[0], u0[0]), silu_mul(g0[1], u0[1]), silu_mul(g0[2], u0[2]), silu_mul(g0[3], u0[3]));
                w.y = pk4_fp8(silu_mul(g1[0], u1[0]), silu_mul(g1[1], u1[1]), silu_mul(g1[2], u1[2]), silu_mul(g1[3], u1[3]));
                *(u32x2_t*)(O + (size_t)(r - pm_sub * BM) * ldc + col0) = w; }
    }
};
struct EpiPlain8 {
    static constexpr bool PERM = true, AFTER_DRAIN = false;
    bf16_t* O; int ldc; int pn_mod; const float* sb;
    __device__ __forceinline__ void operator()(const f32x4 (&acc)[2][2][4][2], const Unit& u, int wr, int wc, int fr, int fq) const {
        const int pn = u.pn % pn_mod;
        const int row0 = u.pm * BM + wr * 64 + fr, col0 = pn * BM + wc * 32 + 8 * fq, bcol = u.pn * BM + wc * 32 + 8 * fq;
        f32x4 sv[2][2];
#pragma unroll
        for (int bj = 0; bj < 2; ++bj) { sv[bj][0] = *(const f32x4*)(sb + bcol + bj * HALF); sv[bj][1] = *(const f32x4*)(sb + bcol + bj * HALF + 4); }
#pragma unroll
        for (int ai = 0; ai < 2; ++ai)
#pragma unroll
            for (int m = 0; m < 4; ++m) { bf16_t* rowp = O + (size_t)(row0 + ai * HALF + m * 16) * ldc + col0;
#pragma unroll
                for (int bj = 0; bj < 2; ++bj) { const f32x4 v0 = acc[ai][bj][m][0] * sv[bj][0], v1 = acc[ai][bj][m][1] * sv[bj][1];
                    u32x4 w; w.x = cvt_pk_bf16(v0[0], v0[1]); w.y = cvt_pk_bf16(v0[2], v0[3]); w.z = cvt_pk_bf16(v1[0], v1[1]); w.w = cvt_pk_bf16(v1[2], v1[3]);
                    *(u32x4*)(rowp + bj * HALF) = w; } }
    }
};
template <class Epi, class Sched, bool ALIGN_EPI = false, bool SP2 = false, int DT = 0  >
__device__ __forceinline__ void gemm_phase(PG8_LAS unsigned char* lds, const Gemm g, const Sched& S, const Epi& E, const int wave_id  ) {
    unsigned m_ = ~0u; asm volatile("" : "+s"(m_)); int lane_ = (int)__builtin_amdgcn_mbcnt_hi(m_, __builtin_amdgcn_mbcnt_lo(m_, 0u)); asm volatile("" : "+v"(lane_));
    const int lane = lane_, wid = wave_id, tid = wid * 64 + lane,
              wr = wid >> 2, wc = wid & 3, fr = lane & 15, fq = lane >> 4;
    const int K = g.K, nt = K / BK;
    unsigned voffA[2], voffB[2];
#pragma unroll
    for (int i = 0; i < 2; ++i) { int R, C; stage_rc(tid * 16 + i * 8192, R, C); const int Rb = Epi::PERM ? ((R & ~31) + perm32(R & 31)) : R;
        voffA[i] = (unsigned)(R * K + C) * 2u; voffB[i] = (unsigned)(Rb * K + C) * 2u; }
    const size_t kstep = (size_t)(BK * 2);
    const size_t hstep = (size_t)HALF * K * 2;
    const size_t tstep = 2 * hstep;
    const unsigned ldsw = (unsigned)wid * 1024u;
    const int aoff = lds_byte(wr * 64 + fr, fq * 8), boff = lds_byte(wc * 32 + fr, fq * 8);
#define PG8_SA(b, h) (((b) * 2 + (h)) * HTB)
#define PG8_SB(b, h) ((4 + (b) * 2 + (h)) * HTB)
#define PG8_STAGE(bufoff, gbase, voff) do { _Pragma("unroll") for (int _i = 0; _i < 2; ++_i) \
        __builtin_amdgcn_global_load_lds((const unsigned*)((const char*)(gbase) + (voff)[_i]), (PG8_LAS unsigned*)(lds + (bufoff) + ldsw + _i * 8192), 16, 0, 0); } while (0)
#define PG8_LDA(dst, b, h) do { _Pragma("unroll") for (int m = 0; m < 4; ++m) _Pragma("unroll") for (int k = 0; k < 2; ++k) dst[m][k] = *(const PG8_LAS bf16x8*)(lds + PG8_SA(b, h) + aoff + m * 2048 + k * 1024); } while (0)
#define PG8_LDB(dst, b, h) do { _Pragma("unroll") for (int n = 0; n < 2; ++n) _Pragma("unroll") for (int k = 0; k < 2; ++k) dst[n][k] = *(const PG8_LAS bf16x8*)(lds + PG8_SB(b, h) + boff + n * 2048 + k * 1024); } while (0)
#define PG8_MMA(ai, bj, At, Bt) do { __builtin_amdgcn_s_setprio(1); if constexpr (DT == 0) { _Pragma("unroll") for (int m = 0; m < 4; ++m) _Pragma("unroll") for (int n = 0; n < 2; ++n) _Pragma("unroll") for (int k = 0; k < 2; ++k) \
        acc[ai][bj][m][n] = __builtin_amdgcn_mfma_f32_16x16x32_bf16(Bt[n][k], At[m][k], acc[ai][bj][m][n], 0, 0, 0); } else { _Pragma("unroll") for (int m = 0; m < 4; ++m) _Pragma("unroll") for (int n = 0; n < 2; ++n) \
        asm volatile("v_mfma_f32_16x16x128_f8f6f4 %0, %1, %2, %0" : "+v"(acc[ai][bj][m][n]) : "v"(cat8(Bt[n][0], Bt[n][1])), "v"(cat8(At[m][0], At[m][1]))); } __builtin_amdgcn_s_setprio(0); } while (0)
#define PG8_WAIT_V(n) asm volatile("s_waitcnt vmcnt(" #n ")" ::: "memory")
#define PG8_WAIT_L(n) asm volatile("s_waitcnt lgkmcnt(" #n ")" ::: "memory")
#define PG8_BAR __builtin_amdgcn_s_barrier()
#define PG8_SCHED __builtin_amdgcn_sched_barrier(0)
    Unit cur, nxt; int ui = 0;
    if (!S.next(0, cur)) return;
    f32x4 acc[2][2][4][2];
#pragma unroll
    for (int a = 0; a < 2; ++a)
#pragma unroll
        for (int b = 0; b < 2; ++b)
#pragma unroll
            for (int m = 0; m < 4; ++m)
#pragma unroll
                for (int n = 0; n < 2; ++n) acc[a][b][m][n] = (f32x4){0.f, 0.f, 0.f, 0.f};
    bf16x8 At[4][2], B0[2][2], B1[2][2];
    const char* cA = (const char*)g.A + (size_t)cur.pm * tstep; const char* cB = (const char*)g.Bt + (size_t)cur.pn * tstep;
    S.a_ready(cur);
    if constexpr (SP2) {
        PG8_STAGE(PG8_SB(0, 0), cB, voffB); PG8_STAGE(PG8_SB(0, 1), cB + hstep, voffB); PG8_STAGE(PG8_SA(0, 0), cA, voffA); PG8_STAGE(PG8_SA(0, 1), cA + hstep, voffA);
        if (wr == 1) PG8_BAR;
        PG8_WAIT_V(2); PG8_BAR;
        PG8_STAGE(PG8_SB(1, 0), cB + kstep, voffB); PG8_STAGE(PG8_SA(1, 0), cA + kstep, voffA); PG8_STAGE(PG8_SB(1, 1), cB + hstep + kstep, voffB);
        PG8_WAIT_V(6); PG8_BAR;
    } else {
        PG8_STAGE(PG8_SB(0, 0), cB, voffB); PG8_STAGE(PG8_SA(0, 0), cA, voffA); PG8_STAGE(PG8_SB(0, 1), cB + hstep, voffB); PG8_STAGE(PG8_SA(0, 1), cA + hstep, voffA);
        if (wr == 1) PG8_BAR;
        PG8_WAIT_V(4); PG8_BAR;
        PG8_STAGE(PG8_SB(1, 0), cB + kstep, voffB); PG8_STAGE(PG8_SA(1, 0), cA + kstep, voffA); PG8_STAGE(PG8_SB(1, 1), cB + hstep + kstep, voffB);
        PG8_WAIT_V(6); PG8_BAR;
    }
    for (;;) {
        const bool has_next = S.next(ui + 1, nxt);
        const char* nA = has_next ? (const char*)g.A + (size_t)nxt.pm * tstep : cA; const char* nB = has_next ? (const char*)g.Bt + (size_t)nxt.pn * tstep : cB;
        for (int t = 0; t < nt; t += 2) {
            const bool last = (t == nt - 2);
            const char* a1 = cA + (size_t)(t + 1) * kstep;
            const char* a2 = last ? nA : cA + (size_t)(t + 2) * kstep; const char* b2 = last ? nB : cB + (size_t)(t + 2) * kstep;
            const char* a3 = a2 + kstep; const char* b3 = b2 + kstep;
            if (last && has_next) S.a_ready(nxt);
            if constexpr (SP2) {
            PG8_LDB(B0, 0, 0); PG8_LDB(B1, 0, 1); PG8_SCHED; PG8_LDA(At, 0, 0); PG8_STAGE(PG8_SA(1, 1), a1 + hstep, voffA);
            PG8_WAIT_V(8); PG8_WAIT_L(0); PG8_BAR; PG8_MMA(0, 0, At, B0); PG8_MMA(0, 1, At, B1); PG8_BAR; PG8_SCHED;
            PG8_LDA(At, 0, 1); PG8_STAGE(PG8_SB(0, 0), b2, voffB); PG8_STAGE(PG8_SB(0, 1), b2 + hstep, voffB); PG8_STAGE(PG8_SA(0, 0), a2, voffA);
            PG8_WAIT_V(8); PG8_WAIT_L(0); PG8_BAR; PG8_MMA(1, 0, At, B0); PG8_MMA(1, 1, At, B1); PG8_BAR; PG8_SCHED;
            PG8_LDB(B0, 1, 0); PG8_LDB(B1, 1, 1); PG8_SCHED; PG8_LDA(At, 1, 0); PG8_STAGE(PG8_SA(0, 1), a2 + hstep, voffA);
            PG8_WAIT_V(8); PG8_WAIT_L(0); PG8_BAR; PG8_MMA(0, 0, At, B0); PG8_MMA(0, 1, At, B1); PG8_BAR; PG8_SCHED;
            PG8_LDA(At, 1, 1); PG8_STAGE(PG8_SB(1, 0), b3, voffB); PG8_STAGE(PG8_SB(1, 1), b3 + hstep, voffB); PG8_STAGE(PG8_SA(1, 0), a3, voffA);
            PG8_WAIT_V(8); PG8_WAIT_L(0); PG8_BAR; PG8_MMA(1, 0, At, B0); PG8_MMA(1, 1, At, B1); PG8_BAR; PG8_SCHED;
            } else {
            PG8_LDB(B0, 0, 0); PG8_SCHED; PG8_LDA(At, 0, 0); PG8_STAGE(PG8_SA(1, 1), a1 + hstep, voffA);
            PG8_WAIT_L(8); PG8_BAR; PG8_WAIT_L(0); PG8_MMA(0, 0, At, B0); PG8_BAR; PG8_SCHED;
            PG8_LDB(B1, 0, 1); PG8_STAGE(PG8_SB(0, 0), b2, voffB);
            PG8_BAR; PG8_WAIT_L(0); PG8_MMA(0, 1, At, B1); PG8_BAR;
            PG8_LDA(At, 0, 1); PG8_STAGE(PG8_SA(0, 0), a2, voffA);
            PG8_BAR; PG8_WAIT_L(0); PG8_MMA(1, 0, At, B0); PG8_BAR; PG8_SCHED;
            PG8_STAGE(PG8_SB(0, 1), b2 + hstep, voffB);
            PG8_WAIT_V(6); PG8_BAR; PG8_MMA(1, 1, At, B1); PG8_BAR;
            PG8_LDB(B0, 1, 0); PG8_SCHED; PG8_LDA(At, 1, 0); PG8_STAGE(PG8_SA(0, 1), a2 + hstep, voffA);
            PG8_WAIT_L(8); PG8_BAR; PG8_WAIT_L(0); PG8_MMA(0, 0, At, B0); PG8_BAR; PG8_SCHED;
            PG8_LDB(B1, 1, 1); PG8_STAGE(PG8_SB(1, 0), b3, voffB);
            PG8_BAR; PG8_WAIT_L(0); PG8_MMA(0, 1, At, B1); PG8_BAR;
            PG8_LDA(At, 1, 1); PG8_STAGE(PG8_SA(1, 0), a3, voffA);
            PG8_BAR; PG8_WAIT_L(0); PG8_MMA(1, 0, At, B0); PG8_BAR; PG8_SCHED;
            PG8_STAGE(PG8_SB(1, 1), b3 + hstep, voffB);
            PG8_WAIT_V(6); PG8_BAR; PG8_MMA(1, 1, At, B1); PG8_BAR;
            }
        }
        if constexpr (DT == 1) {
            asm volatile("s_nop 15\n\ts_nop 15\n\ts_nop 15\n\ts_nop 15\n\ts_nop 15\n\ts_nop 15" : "+v"(acc[0][0][0][0]), "+v"(acc[0][0][0][1]), "+v"(acc[0][0][1][0]), "+v"(acc[0][0][1][1]), "+v"(acc[0][0][2][0]), "+v"(acc[0][0][2][1]), "+v"(acc[0][0][3][0]), "+v"(acc[0][0][3][1]));
            asm volatile("" : "+v"(acc[0][1][0][0]), "+v"(acc[0][1][0][1]), "+v"(acc[0][1][1][0]), "+v"(acc[0][1][1][1]), "+v"(acc[0][1][2][0]), "+v"(acc[0][1][2][1]), "+v"(acc[0][1][3][0]), "+v"(acc[0][1][3][1]));
            asm volatile("" : "+v"(acc[1][0][0][0]), "+v"(acc[1][0][0][1]), "+v"(acc[1][0][1][0]), "+v"(acc[1][0][1][1]), "+v"(acc[1][0][2][0]), "+v"(acc[1][0][2][1]), "+v"(acc[1][0][3][0]), "+v"(acc[1][0][3][1]));
            asm volatile("" : "+v"(acc[1][1][0][0]), "+v"(acc[1][1][0][1]), "+v"(acc[1][1][1][0]), "+v"(acc[1][1][1][1]), "+v"(acc[1][1][2][0]), "+v"(acc[1][1][2][1]), "+v"(acc[1][1][3][0]), "+v"(acc[1][1][3][1]));
        }
        if constexpr (ALIGN_EPI) { if (wr == 0) PG8_BAR; }
        if constexpr (!Epi::AFTER_DRAIN) { E(acc, cur, wr, wc, fr, fq); S.done(cur); }
        if (!has_next) break;
#pragma unroll
        for (int a = 0; a < 2; ++a)
#pragma unroll
            for (int b = 0; b < 2; ++b)
#pragma unroll
                for (int m = 0; m < 4; ++m)
#pragma unroll
                    for (int n = 0; n < 2; ++n) acc[a][b][m][n] = (f32x4){0.f, 0.f, 0.f, 0.f};
        cur = nxt; cA = nA; cB = nB; ++ui;
        if constexpr (ALIGN_EPI) { if (wr == 1) PG8_BAR; }
    }
    PG8_WAIT_V(0);
    if constexpr (!ALIGN_EPI) { if (wr == 0) PG8_BAR; }
    PG8_BAR;
    if constexpr (Epi::AFTER_DRAIN) { E.fused(acc, cur, wr, wc, fr, fq, lds, wid, lane); S.done(cur); }
#undef PG8_SA
#undef PG8_SB
#undef PG8_STAGE
#undef PG8_LDA
#undef PG8_LDB
#undef PG8_MMA
#undef PG8_WAIT_V
#undef PG8_WAIT_L
#undef PG8_BAR
#undef PG8_SCHED
}
}
#define GAS __attribute__((address_space(1)))
#define LAS __attribute__((address_space(3)))
typedef unsigned short bf16;
typedef unsigned v4u __attribute__((ext_vector_type(4)));
typedef float f32x4 __attribute__((ext_vector_type(4)));
typedef short bf16x8 __attribute__((ext_vector_type(8)));
typedef GAS unsigned gu32;
typedef GAS unsigned long long gu64;
#define RLX_AGENT __ATOMIC_RELAXED, __HIP_MEMORY_SCOPE_AGENT
#define LDS_WAIT() asm volatile("s_waitcnt lgkmcnt(0)" ::: "memory")
#define VM_WAIT() asm volatile("s_waitcnt vmcnt(0)" ::: "memory")
__device__ __forceinline__ unsigned long long rt() { return __builtin_amdgcn_s_memrealtime(); }
__device__ __forceinline__ unsigned f2bf(float f) { unsigned u = __builtin_bit_cast(unsigned, f); return (u + 0x7fffu + ((u >> 16) & 1u)) >> 16; }
__device__ __forceinline__ unsigned pk2(float lo, float hi) { return f2bf(lo) | (f2bf(hi) << 16); }

#define XB_TMO      128
#define XB_XCNT(j)  (256  + 64 * (j))
#define XB_XSUB(j)  (1280 + 64 * (j))
#define XB_XGEN(j)  (2304 + 64 * (j))
#define XB_TOP      3328
#define XB_TOPGEN   3392
#define XCD_BAR_WORDS 3456
#define XB_SPIN_CAP (1u << 18)

__device__ __forceinline__ unsigned xb_ld(unsigned* p)              { return __hip_atomic_load(p, __ATOMIC_RELAXED, __HIP_MEMORY_SCOPE_AGENT); }
__device__ __forceinline__ unsigned xb_add(unsigned* p, unsigned v) { return __hip_atomic_fetch_add(p, v, __ATOMIC_RELAXED, __HIP_MEMORY_SCOPE_AGENT); }
__device__ __forceinline__ unsigned xb_xcc_id() { return (unsigned)__builtin_amdgcn_s_getreg((3 << 11) | 20) & 0xFu; }
#define XB_SPIN(cond, bar) do { unsigned _sp = 0; while (cond) { __builtin_amdgcn_s_sleep(1); \
    if ((++_sp & 255u) == 0u) { if (xb_ld(&(bar)[XB_TMO])) break; if (_sp > XB_SPIN_CAP) { atomicAdd(&(bar)[XB_TMO], 1u); break; } } } } while (0)

struct XcdBarrier {
    unsigned* bar; unsigned x;
    volatile LAS unsigned* st;
};

__device__ __forceinline__ XcdBarrier xcd_barrier_post(unsigned* bar, volatile LAS unsigned* st) {
    XcdBarrier b; b.bar = bar; b.x = xb_xcc_id(); b.st = st;
    if (threadIdx.x == 0) (void)xb_add(&bar[XB_XCNT(b.x)], 1u);
    return b;
}
__device__ __forceinline__ void xcd_barrier_complete(unsigned* bar, unsigned x, unsigned& nloc, unsigned& nx) {
    const unsigned G = gridDim.x * gridDim.y * gridDim.z;
    unsigned sum, cnt, mine, sp = 0u;
    for (;;) {
        sum = 0u; cnt = 0u; mine = 0u;
#pragma unroll
        for (unsigned j = 0; j < 16; ++j) { const unsigned c = xb_ld(&bar[XB_XCNT(j)]); sum += c; cnt += (c > 0u) ? 1u : 0u; mine = (j == x) ? c : mine; }
        if (sum == G) break;
        __builtin_amdgcn_s_sleep(1);
        if ((++sp & 255u) == 0u) { if (xb_ld(&bar[XB_TMO])) break; if (sp > XB_SPIN_CAP) { atomicAdd(&bar[XB_TMO], 1u); break; } }
    }
    nloc = mine > 0u ? mine : 1u; nx = cnt > 0u ? cnt : 1u;
}

__device__ __forceinline__ void xcd_barrier(const XcdBarrier& b) {
    asm volatile("s_waitcnt vmcnt(0)" ::: "memory");
    __syncthreads();
    if (threadIdx.x == 0) {
        unsigned* bar = b.bar;
        __builtin_amdgcn_s_waitcnt(0);
        unsigned nloc = b.st[0], nx = b.st[1];
        if (nloc == 0u) { xcd_barrier_complete(bar, b.x, nloc, nx); b.st[0] = nloc; b.st[1] = nx; }
        const unsigned old = xb_add(&bar[XB_XSUB(b.x)], 1u);
        const unsigned gen = old / nloc;
        if (old + 1u == (gen + 1u) * nloc) {
            __builtin_amdgcn_fence(__ATOMIC_RELEASE, "agent");
            asm volatile("s_waitcnt vmcnt(0)" ::: "memory");
            const unsigned og = xb_add(&bar[XB_TOP], 1u);
            const unsigned tg = og / nx;
            if (og + 1u == (tg + 1u) * nx) xb_add(&bar[XB_TOPGEN], 1u);
            else XB_SPIN(xb_ld(&bar[XB_TOPGEN]) == tg, bar);
            __builtin_amdgcn_fence(__ATOMIC_ACQUIRE, "agent");
            xb_add(&bar[XB_XGEN(b.x)], 1u);
            asm volatile("s_waitcnt vmcnt(0)" ::: "memory");
        } else {
            XB_SPIN(xb_ld(&bar[XB_XGEN(b.x)]) == gen, bar);
            __builtin_amdgcn_fence(__ATOMIC_ACQUIRE, "agent");
            asm volatile("s_waitcnt vmcnt(0)" ::: "memory");
        }
    }
    __syncthreads();
}

constexpr int NWAVES = 8;
constexpr int BATCH = 16, SEQ = 4096, DM = 1024, MTOK = BATCH * SEQ;
constexpr int D_IN = 3584, FF0 = 2816, FF1 = 3584, NEXP = 8, NQKV = 3072;
constexpr int OFF_QSB = 0, OFF_KSB = 512, OFF_VSB = 1024, OFF_QR = 1536, OFF_KR = 2048, OFF_VR = 2560, OFF_GR = 3072;
constexpr float LN_EPS = 1e-5f, ALPHA = 1.41421356237309515f;
constexpr float LOG2E = 1.44269504088896341f, LN2 = 0.69314718055994531f;
constexpr int MOE_MAXTILES = 520, MOE_SLICE = 256, MOE_ROWS = MOE_MAXTILES * 256;

constexpr size_t MiB = 1u << 20;
constexpr size_t WS_CTL = 0, CTL_ZERO_BYTES = 1 * MiB;
constexpr size_t WS_TOKE = 1 * MiB;
constexpr size_t WS_TOKG = WS_TOKE + (size_t)MTOK * 4;
constexpr size_t WS_TOKS = WS_TOKG + (size_t)MTOK * 8;
constexpr size_t WS_PERM = WS_TOKS + (size_t)MTOK * 8;
constexpr size_t WS_WCNT = WS_PERM + (size_t)MOE_ROWS * 4;
constexpr size_t WS_TILE = WS_WCNT + 4096 * 8 * 4;
constexpr size_t WS_SBGU = WS_TILE + 4096;
constexpr size_t WS_SBDN = WS_SBGU + (size_t)NEXP * 2 * FF1 * 4;
constexpr size_t WS_XS = WS_SBDN + (size_t)NEXP * DM * 4;
constexpr size_t WS_SAS = WS_XS + (size_t)MTOK * 4;
static_assert(WS_SAS + (size_t)MOE_ROWS * 4 <= 5 * MiB, "misc map");
constexpr size_t WS_ROPE = 5 * MiB;
constexpr size_t WS_WIN = 6 * MiB, WS_WO0 = 13 * MiB, WS_WGU0 = 15 * MiB, WS_WDN0 = 26 * MiB, WS_WQKV = 32 * MiB, WS_WO1 = 38 * MiB;
constexpr size_t WS_WGU1Q = 40 * MiB, WS_WDN1Q = 96 * MiB;
constexpr size_t WS_XQ = 124 * MiB;
constexpr size_t WS_XB = 188 * MiB;
constexpr size_t WS_O = 316 * MiB;
constexpr size_t WS_BIG = 444 * MiB;
constexpr size_t WS_H = WS_BIG, WS_HID0 = WS_BIG, WS_QKV = WS_BIG;
constexpr size_t WS_MIX = WS_BIG + 352 * MiB;
constexpr size_t WS_AMOE = 316 * MiB;
constexpr size_t WS_Y = 446 * MiB;
constexpr size_t WS_HSL = 706 * MiB;
constexpr size_t WS_END = 930 * MiB;
static_assert(WS_WDN1Q + (size_t)NEXP * DM * FF1 <= WS_XQ && WS_HSL + (size_t)MOE_SLICE * 256 * FF1 <= WS_END && WS_MIX + (size_t)MTOK * DM * 2 <= WS_END, "ws map");
static_assert(WS_AMOE + (size_t)MOE_ROWS * DM <= WS_Y && WS_Y + (size_t)MOE_ROWS * DM * 2 <= WS_HSL && (size_t)MTOK * FF0 * 2 <= 352 * MiB && WS_BIG + (size_t)MTOK * D_IN * 2 <= WS_END, "ws map 2");
constexpr size_t OUT_WGU1 = 0, OUT_WDN1 = 112 * MiB;
constexpr int CW_BAR = 4096;
constexpr int CW_NTILES = 16384;

constexpr int RING_BYTES = 131072, LDSCTL_OFF = 139264, MISC_OFF = LDSCTL_OFF + 320, LDS_BYTES = 147456;
constexpr int TP = 144;

typedef short s16x4 __attribute__((ext_vector_type(4)));
typedef float f32x16 __attribute__((ext_vector_type(16)));
typedef unsigned u32x2 __attribute__((ext_vector_type(2)));
typedef float f32x2 __attribute__((ext_vector_type(2)));
typedef __bf16 bf16x2_t __attribute__((ext_vector_type(2)));
typedef int i32x2 __attribute__((ext_vector_type(2)));
typedef int i32x4 __attribute__((ext_vector_type(4)));

__device__ __forceinline__ unsigned cvtpk(float lo, float hi) { f32x2 v = {lo, hi}; bf16x2_t b = __builtin_convertvector(v, bf16x2_t); return __builtin_bit_cast(unsigned, b); }
__device__ __forceinline__ float bflo(unsigned w) { return __uint_as_float(w << 16); }
__device__ __forceinline__ float bfhi(unsigned w) { return __uint_as_float(w & 0xffff0000u); }
__device__ __forceinline__ float bfel(const v4u& a, int e) { const unsigned w = a[e >> 1]; return (e & 1) ? bfhi(w) : bflo(w); }
__device__ __forceinline__ int crow(int r, int hi) { return (r & 3) + 8 * (r >> 2) + 4 * hi; }
__device__ __forceinline__ float ex2(float x) { return __builtin_amdgcn_exp2f(x); }
__device__ __forceinline__ float lg2(float x) { return __builtin_amdgcn_logf(x); }
__device__ __forceinline__ f32x16 mfma32(bf16x8 x, bf16x8 y, f32x16 c) { return __builtin_amdgcn_mfma_f32_32x32x16_bf16(x, y, c, 0, 0, 0); }
__device__ __forceinline__ float wave_sum(float v) {
#pragma unroll
    for (int o = 1; o < 64; o <<= 1) v += __shfl_xor(v, o);
    return v;
}
__device__ __forceinline__ float xmax32(float v) { const auto rr = __builtin_amdgcn_permlane32_swap(__float_as_uint(v), __float_as_uint(v), false, false); return fmaxf(__uint_as_float(rr[0]), __uint_as_float(rr[1])); }
__device__ __forceinline__ float xsum32(float v) { const auto rr = __builtin_amdgcn_permlane32_swap(__float_as_uint(v), __float_as_uint(v), false, false); return __uint_as_float(rr[0]) + __uint_as_float(rr[1]); }
typedef short v4i16_t __attribute__((ext_vector_type(4)));
__device__ __forceinline__ s16x4 trrd(const LAS unsigned char* p) { return __builtin_bit_cast(s16x4, __builtin_amdgcn_ds_read_tr16_b64_v4i16((LAS v4i16_t*)p)); }
__device__ __forceinline__ bf16x8 row_frag(const LAS unsigned char* tile, int r32, int hi, int dk) { return *(const LAS bf16x8*)(tile + r32 * TP + (16 * dk + 8 * hi) * 2); }
__device__ __forceinline__ bf16x8 tr_frag(const LAS unsigned char* tile, int rowA, int rowB, int cb, int lane) {
    const int q = (lane & 15) >> 2, p = lane & 3, blk = (lane >> 4) & 1;
    const int co = cb * 64 + blk * 32 + p * 8;
    const s16x4 lo = trrd(tile + (rowA + q) * TP + co), hi4 = trrd(tile + (rowB + q) * TP + co);
    return (bf16x8){lo[0], lo[1], lo[2], lo[3], hi4[0], hi4[1], hi4[2], hi4[3]};
}
__device__ __forceinline__ void load_tile32(const bf16* g, size_t ldg, LAS unsigned char* tile, int lane) {
#pragma unroll
    for (int i = 0; i < 4; ++i) { const int id = i * 64 + lane, row = id >> 3, ch = id & 7;
        const v4u v = *(const GAS v4u*)(g + (size_t)row * ldg + ch * 8); *(LAS v4u*)(tile + row * TP + ch * 16) = v; }
}
__device__ __forceinline__ void tile32_fetch(const bf16* g, size_t ldg, int lane, v4u (&r)[4]) {
#pragma unroll
    for (int i = 0; i < 4; ++i) { const int id = i * 64 + lane, row = id >> 3, ch = id & 7; r[i] = *(const GAS v4u*)(g + (size_t)row * ldg + ch * 8); }
}
__device__ __forceinline__ void tile32_store(LAS unsigned char* tile, int lane, const v4u (&r)[4]) {
#pragma unroll
    for (int i = 0; i < 4; ++i) { const int id = i * 64 + lane, row = id >> 3, ch = id & 7; *(LAS v4u*)(tile + row * TP + ch * 16) = r[i]; }
}
template <bool DECAY>
__device__ __forceinline__ void load_tile32_rot(const bf16* g, size_t ldg, const float* rope, int pos0, int j0, float l2g, LAS unsigned char* tile, int lane) {
#pragma unroll
    for (int i = 0; i < 2; ++i) { const int id = i * 64 + lane, row = id >> 2, ch = id & 3;
        const v4u a = *(const GAS v4u*)(g + (size_t)row * ldg + ch * 8), bq = *(const GAS v4u*)(g + (size_t)row * ldg + 32 + ch * 8);
        const float* rp = rope + (size_t)(pos0 + row) * 64 + ch * 8;
        const f32x4 c0 = *(const GAS f32x4*)rp, c1 = *(const GAS f32x4*)(rp + 4), s0 = *(const GAS f32x4*)(rp + 32), s1 = *(const GAS f32x4*)(rp + 36);
        const float sc = DECAY ? ex2((float)(63 - (j0 + row)) * l2g) : 1.0f;
        float o1[8], o2[8];
#pragma unroll
        for (int e = 0; e < 8; ++e) { const float x1 = bfel(a, e), x2 = bfel(bq, e), c = e < 4 ? c0[e & 3] : c1[e & 3], s = e < 4 ? s0[e & 3] : s1[e & 3];
            o1[e] = (x1 * c - x2 * s) * sc; o2[e] = (x1 * s + x2 * c) * sc; }
        v4u w1, w2;
#pragma unroll
        for (int e = 0; e < 4; ++e) { w1[e] = cvtpk(o1[2 * e], o1[2 * e + 1]); w2[e] = cvtpk(o2[2 * e], o2[2 * e + 1]); }
        *(LAS v4u*)(tile + row * TP + ch * 16) = w1; *(LAS v4u*)(tile + row * TP + 64 + ch * 16) = w2; }
}
__device__ __forceinline__ bf16x8 pack8(const float* w) { v4u t; t.x = cvtpk(w[0], w[1]); t.y = cvtpk(w[2], w[3]); t.z = cvtpk(w[4], w[5]); t.w = cvtpk(w[6], w[7]); return __builtin_bit_cast(bf16x8, t); }

struct Ctx { LAS unsigned char* lds; int wave, vcu, G, gw, NGW; };
__device__ __forceinline__ int fresh_lane() { unsigned m = ~0u; asm volatile("" : "+s"(m)); int l = (int)__builtin_amdgcn_mbcnt_hi(m, __builtin_amdgcn_mbcnt_lo(m, 0u)); asm volatile("" : "+v"(l)); return l; }
#define ph_tid() (C.wave * 64 + fresh_lane())
__device__ __forceinline__ int launder(int x) { asm volatile("" : "+v"(x)); return x; }

struct TItem { const float* src; bf16* dst; int N, K; };
__device__ __forceinline__ TItem p0_item(const float* W, int K, int N, bf16* WT, int rs128, int radd, int item) {
    const int nblk = N / 32, kb = item / nblk, nb = item % nblk, k0 = 64 * kb, n0 = 32 * nb;
    const int drow0 = (n0 >> 7) * rs128 + (n0 & 127) + radd;
    TItem t; t.src = W + (size_t)k0 * N + n0; t.dst = WT + (size_t)drow0 * K + k0; t.N = N; t.K = K; return t;
}
__device__ __forceinline__ TItem p0_decode(int it, const float* const* in, unsigned char* ws, unsigned char* outb) {
    constexpr int I_WIN = 16 * (D_IN / 32), I_WO = 16 * 32, I_G0 = 16 * (FF0 / 32), I_D0 = (FF0 / 64) * 32, I_QKV = 16 * (NQKV / 32), I_ME = 16 * (FF1 / 32), I_MD = (FF1 / 64) * 32;
    int r = it;
    if (r < I_WIN) return p0_item(in[3], DM, D_IN, (bf16*)(ws + WS_WIN), 128, 0, r); r -= I_WIN;
    if (r < I_WO) return p0_item(in[5], DM, DM, (bf16*)(ws + WS_WO0), 128, 0, r); r -= I_WO;
    if (r < I_G0) return p0_item(in[8], DM, FF0, (bf16*)(ws + WS_WGU0), 256, 0, r); r -= I_G0;
    if (r < I_G0) return p0_item(in[9], DM, FF0, (bf16*)(ws + WS_WGU0), 256, 128, r); r -= I_G0;
    if (r < I_D0) return p0_item(in[10], FF0, DM, (bf16*)(ws + WS_WDN0), 128, 0, r); r -= I_D0;
    if (r < I_QKV) return p0_item(in[13], DM, NQKV, (bf16*)(ws + WS_WQKV), 128, 0, r); r -= I_QKV;
    if (r < I_WO) return p0_item(in[15], DM, DM, (bf16*)(ws + WS_WO1), 128, 0, r); r -= I_WO;
    if (r < NEXP * I_ME) { const int e = r / I_ME; return p0_item(in[20] + (size_t)e * DM * FF1, DM, FF1, (bf16*)(outb + OUT_WGU1) + (size_t)e * 2 * FF1 * DM, 256, 0, r % I_ME); } r -= NEXP * I_ME;
    if (r < NEXP * I_ME) { const int e = r / I_ME; return p0_item(in[21] + (size_t)e * DM * FF1, DM, FF1, (bf16*)(outb + OUT_WGU1) + (size_t)e * 2 * FF1 * DM, 256, 128, r % I_ME); } r -= NEXP * I_ME;
    { const int e = r / I_MD; return p0_item(in[22] + (size_t)e * FF1 * DM, FF1, DM, (bf16*)(outb + OUT_WDN1) + (size_t)e * DM * FF1, 128, 0, r % I_MD); }
}
__device__ __forceinline__ void p0_fetch(const TItem& t, int lane, f32x4 (&r)[8]) {
#pragma unroll
    for (int i = 0; i < 8; ++i) { const int id = i * 64 + lane, kk = id >> 3, ch = id & 7; r[i] = *(const GAS f32x4*)(t.src + (size_t)kk * t.N + 4 * ch); }
}
__device__ __forceinline__ void p0_prologue(const Ctx& C, const float* const* in, unsigned char* ws, unsigned char* outb) {
    const int lane_ = ph_tid() & 63;
    LAS float* scr = (LAS float*)(C.lds + C.wave * 16384);
    constexpr int I_WIN = 16 * (D_IN / 32), I_WO = 16 * 32, I_G0 = 16 * (FF0 / 32), I_D0 = (FF0 / 64) * 32, I_QKV = 16 * (NQKV / 32), I_ME = 16 * (FF1 / 32), I_MD = (FF1 / 64) * 32;
    static_assert(I_ME == 1792 && I_MD == 1792, "moe items");
    constexpr int NITEMS = I_WIN + I_WO + 2 * I_G0 + I_D0 + I_QKV + I_WO + NEXP * (2 * I_ME + I_MD);
    if (C.gw < NITEMS) {
        TItem cur = p0_decode(C.gw, in, ws, outb); f32x4 r[8]; p0_fetch(cur, lane_, r);
        for (int it = C.gw; it < NITEMS; it += C.NGW) {
#pragma unroll
            for (int i = 0; i < 8; ++i) { const int id = i * 64 + lane_, kk = id >> 3, ch = id & 7; LAS float* d = scr + kk * 33 + 4 * ch; d[0] = r[i][0]; d[1] = r[i][1]; d[2] = r[i][2]; d[3] = r[i][3]; }
            const bool more = it + C.NGW < NITEMS; TItem nxt = cur;
            if (more) { nxt = p0_decode(it + C.NGW, in, ws, outb); p0_fetch(nxt, lane_, r); }
            LDS_WAIT(); asm volatile("" ::: "memory");
            const int c = lane_ & 7;
#pragma unroll
            for (int j = 0; j < 4; ++j) { const int n = (lane_ >> 3) + 8 * j; const LAS float* sp = scr + (8 * c) * 33 + n;
                v4u o; o.x = cvtpk(sp[0 * 33], sp[1 * 33]); o.y = cvtpk(sp[2 * 33], sp[3 * 33]); o.z = cvtpk(sp[4 * 33], sp[5 * 33]); o.w = cvtpk(sp[6 * 33], sp[7 * 33]);
                *(GAS v4u*)(cur.dst + (size_t)n * cur.K + 8 * c) = o; }
            LDS_WAIT(); asm volatile("" ::: "memory");
            cur = nxt;
        }
    }
    { const float* x = in[0]; bf16* xb = (bf16*)(ws + WS_XB); const size_t n8 = (size_t)MTOK * DM / 8;
      for (size_t i = (size_t)C.gw * 64 + lane_; i < n8; i += (size_t)C.NGW * 64) {
          const f32x4 a = *(const GAS f32x4*)(x + 8 * i), b = *(const GAS f32x4*)(x + 8 * i + 4);
          v4u o; o.x = cvtpk(a[0], a[1]); o.y = cvtpk(a[2], a[3]); o.z = cvtpk(b[0], b[1]); o.w = cvtpk(b[2], b[3]); *(GAS v4u*)(xb + 8 * i) = o; } }
    { float* rope = (float*)(ws + WS_ROPE);
      for (int idx = C.gw * 64 + lane_; idx < SEQ * 32; idx += C.NGW * 64) { const int pos = idx >> 5, i = idx & 31;
          double f = 1.0; for (int k = 0; k < i; ++k) f *= 0.74989420933245582;
          const float invf = (float)f, ang = (float)pos * invf;
          double rev = (double)ang * 0.15915494309189535; rev -= __builtin_rint(rev);
          rope[pos * 64 + i] = __builtin_amdgcn_cosf((float)rev); rope[pos * 64 + 32 + i] = __builtin_amdgcn_sinf((float)rev); } }
}


template <int NCH>
__device__ __forceinline__ void quant_rows_fp8(const Ctx& C, const bf16* src, int nrows, unsigned char* dst, float* scale) {
    constexpr int K = NCH * 512; const int lane_ = ph_tid() & 63;
    for (int row = C.gw; row < nrows; row += C.NGW) {
        const GAS v4u* sp = (const GAS v4u*)(src + (size_t)row * K) + lane_;
        v4u buf[NCH]; float am = 0.f;
#pragma unroll
        for (int i = 0; i < NCH; ++i) { buf[i] = sp[64 * i];
#pragma unroll
            for (int e = 0; e < 8; ++e) am = fmaxf(am, fabsf(bfel(buf[i], e))); }
#pragma unroll
        for (int o = 1; o < 64; o <<= 1) am = fmaxf(am, __shfl_xor(am, o));
        am = fmaxf(am, 1.0e-30f); const float inv = 384.0f / am;
        GAS u32x2* dp = (GAS u32x2*)(dst + (size_t)row * K) + lane_;
#pragma unroll
        for (int i = 0; i < NCH; ++i) { u32x2 w;
            w.x = pg8::pk4_fp8(bfel(buf[i], 0) * inv, bfel(buf[i], 1) * inv, bfel(buf[i], 2) * inv, bfel(buf[i], 3) * inv);
            w.y = pg8::pk4_fp8(bfel(buf[i], 4) * inv, bfel(buf[i], 5) * inv, bfel(buf[i], 6) * inv, bfel(buf[i], 7) * inv); dp[64 * i] = w; }
        if (lane_ == 0) scale[row] = am * (1.0f / 384.0f);
    }
}

template <int MODE, bool XF32>
__device__ __forceinline__ void ln_phase(const Ctx& C, const void* xprev, const bf16* fsrc, const float* gam, const float* bet, float* xout, bf16* xb,
                                         const float* w_router, const float* b_router, unsigned char* ws) {
    const int lane = (ph_tid() & 63);
    LAS float* wrT = (LAS float*)C.lds;
    if (MODE == 1) {
        for (int idx = ph_tid(); idx < DM * NEXP; idx += NWAVES * 64) { const int d = idx >> 3, e = idx & 7; wrT[e * DM + d] = w_router[idx]; }
        int* perm = (int*)(ws + WS_PERM);
        for (int idx = C.gw * 64 + lane; idx < MOE_ROWS; idx += C.NGW * 64) perm[idx] = -1;
        __syncthreads();
    }
    f32x4 gv[4], bv[4];
#pragma unroll
    for (int j = 0; j < 4; ++j) { gv[j] = ((const GAS f32x4*)gam)[lane + 64 * j]; bv[j] = ((const GAS f32x4*)bet)[lane + 64 * j]; }
    int cnt0 = 0, cnt1 = 0, cnt2 = 0, cnt3 = 0, cnt4 = 0, cnt5 = 0, cnt6 = 0, cnt7 = 0;
    for (int row = C.gw; row < MTOK; row += C.NGW) {
        f32x4 xin[4];
        if (XF32) { const GAS f32x4* xr = (const GAS f32x4*)((const float*)xprev + (size_t)row * DM) + lane;
#pragma unroll
            for (int j = 0; j < 4; ++j) xin[j] = xr[64 * j];
        } else { const GAS u32x2* xr = (const GAS u32x2*)((const bf16*)xprev + (size_t)row * DM) + lane;
#pragma unroll
            for (int j = 0; j < 4; ++j) { const u32x2 a = xr[64 * j]; xin[j] = (f32x4){bflo(a.x), bfhi(a.x), bflo(a.y), bfhi(a.y)}; } }
        f32x4 v[4];
        if (MODE == 2) {
            const i32x2 sl = *(const GAS i32x2*)(ws + WS_TOKS + (size_t)row * 8); const f32x2 gt = *(const GAS f32x2*)(ws + WS_TOKG + (size_t)row * 8);
            const GAS u32x2* y1 = (const GAS u32x2*)(fsrc + (size_t)sl.x * DM) + lane; const GAS u32x2* y2 = (const GAS u32x2*)(fsrc + (size_t)sl.y * DM) + lane;
#pragma unroll
            for (int j = 0; j < 4; ++j) { const u32x2 a = y1[64 * j], b = y2[64 * j]; const f32x4 xv = xin[j];
                v[j][0] = xv[0] * ALPHA + (gt.x * bflo(a.x) + gt.y * bflo(b.x)); v[j][1] = xv[1] * ALPHA + (gt.x * bfhi(a.x) + gt.y * bfhi(b.x));
                v[j][2] = xv[2] * ALPHA + (gt.x * bflo(a.y) + gt.y * bflo(b.y)); v[j][3] = xv[3] * ALPHA + (gt.x * bfhi(a.y) + gt.y * bfhi(b.y)); }
        } else {
            const GAS u32x2* mr = (const GAS u32x2*)(fsrc + (size_t)row * DM) + lane;
#pragma unroll
            for (int j = 0; j < 4; ++j) { const u32x2 a = mr[64 * j]; const f32x4 xv = xin[j];
                v[j][0] = xv[0] * ALPHA + bflo(a.x); v[j][1] = xv[1] * ALPHA + bfhi(a.x); v[j][2] = xv[2] * ALPHA + bflo(a.y); v[j][3] = xv[3] * ALPHA + bfhi(a.y); }
        }
        float s = 0.f;
#pragma unroll
        for (int j = 0; j < 4; ++j) s += (v[j][0] + v[j][1]) + (v[j][2] + v[j][3]);
        const float mean = wave_sum(s) * (1.0f / DM); float s2 = 0.f;
#pragma unroll
        for (int j = 0; j < 4; ++j) { v[j] = v[j] - mean; s2 += (v[j][0] * v[j][0] + v[j][1] * v[j][1]) + (v[j][2] * v[j][2] + v[j][3] * v[j][3]); }
        const float rstd = 1.0f / sqrtf(wave_sum(s2) * (1.0f / DM) + LN_EPS);
#pragma unroll
        for (int j = 0; j < 4; ++j) v[j] = v[j] * rstd * gv[j] + bv[j];
        if (MODE == 2) { GAS f32x4* xo = (GAS f32x4*)(xout + (size_t)row * DM) + lane;
#pragma unroll
            for (int j = 0; j < 4; ++j) xo[64 * j] = v[j]; }
        if (MODE != 2) { GAS u32x2* bo = (GAS u32x2*)(xb + (size_t)row * DM) + lane;
#pragma unroll
            for (int j = 0; j < 4; ++j) { u32x2 w; w.x = cvtpk(v[j][0], v[j][1]); w.y = cvtpk(v[j][2], v[j][3]); bo[64 * j] = w; } }
        if (MODE == 1) {
            float am = 0.f;
#pragma unroll
            for (int j = 0; j < 4; ++j) am = fmaxf(am, fmaxf(fmaxf(fabsf(v[j][0]), fabsf(v[j][1])), fmaxf(fabsf(v[j][2]), fabsf(v[j][3]))));
#pragma unroll
            for (int o = 1; o < 64; o <<= 1) am = fmaxf(am, __shfl_xor(am, o));
            am = fmaxf(am, 1.0e-30f); const float qi = 384.0f / am;
            GAS unsigned* xq = (GAS unsigned*)(ws + WS_XQ + (size_t)row * DM) + lane;
#pragma unroll
            for (int j = 0; j < 4; ++j) xq[64 * j] = pg8::pk4_fp8(v[j][0] * qi, v[j][1] * qi, v[j][2] * qi, v[j][3] * qi);
            if (lane == 0) *(GAS float*)(ws + WS_XS + (size_t)row * 4) = am * (1.0f / 384.0f);
            float lg[8];
#pragma unroll
            for (int e = 0; e < 8; ++e) { float a = 0.f;
#pragma unroll
                for (int j = 0; j < 4; ++j) { const f32x4 w = *(const LAS f32x4*)(wrT + e * DM + 4 * lane + 256 * j); a += (v[j][0] * w[0] + v[j][1] * w[1]) + (v[j][2] * w[2] + v[j][3] * w[3]); }
                lg[e] = wave_sum(a) + b_router[e]; }
            int e1 = 0; float v1 = lg[0];
#pragma unroll
            for (int e = 1; e < 8; ++e) if (lg[e] > v1) { v1 = lg[e]; e1 = e; }
            int e2 = -1; float v2 = -3.0e38f;
#pragma unroll
            for (int e = 0; e < 8; ++e) if (e != e1 && lg[e] > v2) { v2 = lg[e]; e2 = e; }
            const float g1 = 1.0f / (1.0f + __expf(v2 - v1)), g2 = 1.0f - g1;
            if (lane == 0) { *(GAS int*)(ws + WS_TOKE + (size_t)row * 4) = e1 | (e2 << 8); *(GAS f32x2*)(ws + WS_TOKG + (size_t)row * 8) = (f32x2){g1, g2}; }
            cnt0 += (e1 == 0) + (e2 == 0); cnt1 += (e1 == 1) + (e2 == 1); cnt2 += (e1 == 2) + (e2 == 2); cnt3 += (e1 == 3) + (e2 == 3);
            cnt4 += (e1 == 4) + (e2 == 4); cnt5 += (e1 == 5) + (e2 == 5); cnt6 += (e1 == 6) + (e2 == 6); cnt7 += (e1 == 7) + (e2 == 7);
        }
    }
    if (MODE == 1) {
        int myc = cnt0; myc = lane == 1 ? cnt1 : myc; myc = lane == 2 ? cnt2 : myc; myc = lane == 3 ? cnt3 : myc; myc = lane == 4 ? cnt4 : myc; myc = lane == 5 ? cnt5 : myc; myc = lane == 6 ? cnt6 : myc; myc = lane == 7 ? cnt7 : myc;
        if (lane < 8) *(GAS int*)(ws + WS_WCNT + ((size_t)C.gw * 8 + lane) * 4) = myc;
    }
}

__device__ __forceinline__ void moe_assign(const Ctx& C, unsigned char* ws, gu32* ctl) {
    const int lane = (ph_tid() & 63);
    const GAS int* wcnt = (const GAS int*)(ws + WS_WCNT);
    int tot[8], pre[8];
#pragma unroll
    for (int e = 0; e < 8; ++e) { tot[e] = 0; pre[e] = 0; }
    for (int w = lane; w < C.NGW; w += 64) { const i32x4 a = *(const GAS i32x4*)(wcnt + w * 8), b = *(const GAS i32x4*)(wcnt + w * 8 + 4); const bool lo = w < C.gw;
        tot[0] += a.x; tot[1] += a.y; tot[2] += a.z; tot[3] += a.w; tot[4] += b.x; tot[5] += b.y; tot[6] += b.z; tot[7] += b.w;
        if (lo) { pre[0] += a.x; pre[1] += a.y; pre[2] += a.z; pre[3] += a.w; pre[4] += b.x; pre[5] += b.y; pre[6] += b.z; pre[7] += b.w; } }
    int off[9]; off[0] = 0;
#pragma unroll
    for (int e = 0; e < 8; ++e) {
#pragma unroll
        for (int o = 1; o < 64; o <<= 1) { tot[e] += __shfl_xor(tot[e], o); pre[e] += __shfl_xor(pre[e], o); }
        off[e + 1] = off[e] + ((tot[e] + 255) & ~255); }
    const GAS int* toke = (const GAS int*)(ws + WS_TOKE); GAS int* perm = (GAS int*)(ws + WS_PERM);
    int base[8];
#pragma unroll
    for (int e = 0; e < 8; ++e) base[e] = off[e] + pre[e];
    for (int i0 = 0; C.gw + i0 * C.NGW < MTOK; i0 += 64) {
        const int row = C.gw + (i0 + lane) * C.NGW; const bool live = row < MTOK;
        const int ee = live ? toke[row] : 0xffff; const int e1 = ee & 0xff, e2 = (ee >> 8) & 0xff;
        int s1 = 0, s2 = 0; const unsigned long long lower = (1ull << lane) - 1ull;
#pragma unroll
        for (int e = 0; e < 8; ++e) { const unsigned long long m1 = __ballot(live && e1 == e), m2 = __ballot(live && e2 == e);
            const int rank = __popcll(m1 & lower) + __popcll(m2 & lower);
            if (e1 == e) s1 = base[e] + rank; if (e2 == e) s2 = base[e] + rank;
            base[e] += __popcll(m1) + __popcll(m2); }
        if (live) { perm[s1] = row; perm[s2] = row; *(GAS i32x2*)(ws + WS_TOKS + (size_t)row * 8) = (i32x2){s1, s2}; }
    }
    if (C.gw == 0) {
        const int ntile = off[8] >> 8;
        for (int t = lane; t < 1024; t += 64) { int e = 0;
#pragma unroll
            for (int k = 1; k < 8; ++k) e += (t * 256 >= off[k]) ? 1 : 0;
            __hip_atomic_store((gu32*)(ws + WS_TILE) + t, (unsigned)(t < ntile ? e : 0), RLX_AGENT); }
        if (lane == 0) __hip_atomic_store(ctl + CW_NTILES, (unsigned)ntile, RLX_AGENT);
    }
}
__device__ __forceinline__ void moe_gather(const Ctx& C, unsigned char* ws, int ntile) {
    const int lane_ = ph_tid() & 63;
    const GAS int* perm = (const GAS int*)(ws + WS_PERM); const unsigned char* xq = ws + WS_XQ; unsigned char* A = ws + WS_AMOE;
    const GAS float* xs = (const GAS float*)(ws + WS_XS); GAS float* sas = (GAS float*)(ws + WS_SAS);
    for (int s = C.gw; s < ntile * 256; s += C.NGW) { const int row = perm[s];
        v4u a = {0u, 0u, 0u, 0u}; float sc = 0.f;
        if (row >= 0) { a = ((const GAS v4u*)(xq + (size_t)row * DM))[lane_]; sc = xs[row]; }
        ((GAS v4u*)(A + (size_t)s * DM))[lane_] = a; if (lane_ == 0) sas[s] = sc; }
}
struct MoeOrder {
    LAS unsigned* tab; int n;
    __device__ __forceinline__ void init(int t0, int nT, int nN, int G, int c, const gu32* tile_expert, LAS unsigned* tab_, int tid) {
        tab = tab_; const int nwg = nT * nN; n = c < nwg ? (nwg - c + G - 1) / G : 0;
        __syncthreads();
        for (int i = tid; i < n; i += NWAVES * 64) {
            int wgid = i * G + c; { const int q = nwg / pg8::NXCD, r = nwg % pg8::NXCD, xcd = wgid % pg8::NXCD, off = wgid / pg8::NXCD; wgid = (xcd < r ? xcd * (q + 1) : r * (q + 1) + (xcd - r) * q) + off; }
            const int nig = pg8::WGM * nN, gid = wgid / nig, fm = gid * pg8::WGM, gsz = (nT - fm) < pg8::WGM ? (nT - fm) : pg8::WGM;
            const int pm = t0 + fm + ((wgid % nig) % gsz), pn = (wgid % nig) / gsz;
            const int e = (int)__hip_atomic_load(tile_expert + pm, RLX_AGENT);
            tab[i] = (unsigned)pm | ((unsigned)(e * nN + pn) << 16); }
        __syncthreads();
    }
    __device__ __forceinline__ bool next(int i, pg8::Unit& u) const {
        if (i >= n) return false;
        const unsigned v = (unsigned)__builtin_amdgcn_readfirstlane((int)tab[i]);
        u.pm = (int)(v & 0xffffu); u.pn = (int)(v >> 16); return true;
    }
    __device__ __forceinline__ void a_ready(const pg8::Unit&) const {}
    __device__ __forceinline__ void done(const pg8::Unit&) const {}
};
constexpr int MOE_TAB_OFF = LDSCTL_OFF + 1024, MOE_TAB_MAX = 256;
static_assert(MOE_TAB_OFF + MOE_TAB_MAX * 4 <= LDS_BYTES, "MoE unit table");

__device__ __forceinline__ void sb_phase(const Ctx& C, const bf16* H, bf16* O) {
    LAS unsigned char* wl = C.lds + C.wave * 16384; LAS unsigned char* Kt = wl; LAS unsigned char* Vt = wl + 4608; LAS unsigned char* stg = wl + 9216;
    const int lane = (ph_tid() & 63), r32 = lane & 31, hi = lane >> 5;
    for (int u = C.gw; u < BATCH * 8 * 128; u += C.NGW) {
        const int qt = u & 127, h = (u >> 7) & 7, b = u >> 10;
        const bf16* Hb = H + (size_t)b * SEQ * D_IN + h * 64;
        bf16x8 qf[4];
#pragma unroll
        for (int dk = 0; dk < 4; ++dk) qf[dk] = *(const GAS bf16x8*)(Hb + (size_t)(qt * 32 + r32) * D_IN + OFF_QSB + 16 * dk + 8 * hi);
        float R = 0.f; f32x16 oacc[2]; oacc[0] = f32x16{}; oacc[1] = f32x16{};
        v4u kpre[4], vpre[4];
        tile32_fetch(Hb + (size_t)(qt * 32) * D_IN + OFF_KSB, D_IN, lane, kpre); tile32_fetch(Hb + (size_t)(qt * 32) * D_IN + OFF_VSB, D_IN, lane, vpre);
        for (int kt = qt; kt >= 0; --kt) {
            tile32_store(Kt, lane, kpre); tile32_store(Vt, lane, vpre);
            if (kt > 0) { tile32_fetch(Hb + (size_t)((kt - 1) * 32) * D_IN + OFF_KSB, D_IN, lane, kpre); tile32_fetch(Hb + (size_t)((kt - 1) * 32) * D_IN + OFF_VSB, D_IN, lane, vpre); }
            f32x16 acc = f32x16{};
#pragma unroll
            for (int dk = 0; dk < 4; ++dk) acc = mfma32(row_frag(Kt, r32, hi, dk), qf[dk], acc);
            const bool diag = (kt == qt);
            float z[16], lgv[16]; bool valid[16];
#pragma unroll
            for (int r = 0; r < 16; ++r) { z[r] = acc[r] * 0.125f; valid[r] = !diag || (crow(r, hi) < r32);
                const float e = ex2(-fabsf(z[r]) * LOG2E); const float sp = fmaxf(z[r], 0.f) + LN2 * lg2(1.0f + e); lgv[r] = valid[r] ? -sp : 0.f; }
            float G[4], PG[4], T[4];
#pragma unroll
            for (int g = 0; g < 4; ++g) { G[g] = (lgv[4 * g] + lgv[4 * g + 1]) + (lgv[4 * g + 2] + lgv[4 * g + 3]); PG[g] = __shfl_xor(G[g], 32); T[g] = G[g] + PG[g]; }
            float above[4]; above[3] = 0.f; above[2] = T[3]; above[1] = T[3] + T[2]; above[0] = T[3] + T[2] + T[1];
            float w[16];
#pragma unroll
            for (int g = 0; g < 4; ++g) { const float base = R + above[g] + (hi == 0 ? PG[g] : 0.f);
                float inc = 0.f;
#pragma unroll
                for (int i = 3; i >= 0; --i) { const int r = 4 * g + i; inc += lgv[r]; w[r] = valid[r] ? ex2((z[r] + base + inc) * LOG2E) : 0.f; } }
            R += (T[0] + T[1]) + (T[2] + T[3]);
            const bf16x8 pf0 = pack8(w), pf1 = pack8(w + 8);
#pragma unroll
            for (int db = 0; db < 2; ++db) {
                oacc[db] = mfma32(tr_frag(Vt, 4 * hi, 8 + 4 * hi, db, lane), pf0, oacc[db]);
                oacc[db] = mfma32(tr_frag(Vt, 16 + 4 * hi, 24 + 4 * hi, db, lane), pf1, oacc[db]); }
            if (__all(R < -88.0f)) break;
        }
#pragma unroll
        for (int db = 0; db < 2; ++db)
#pragma unroll
            for (int r = 0; r < 16; ++r) *(LAS unsigned short*)(stg + r32 * TP + (db * 32 + crow(r, hi)) * 2) = (unsigned short)cvtpk(oacc[db][r], 0.f);
#pragma unroll
        for (int i = 0; i < 4; ++i) { const int row = i * 8 + (lane >> 3), ch = lane & 7; const v4u v = *(const LAS v4u*)(stg + row * TP + ch * 16);
            *(GAS v4u*)(O + (size_t)(b * SEQ + qt * 32 + row) * DM + h * 64 + ch * 8) = v; }
    }
}

__device__ __forceinline__ void ret_kv_phase(const Ctx& C, const bf16* H, const float* rope, float* KV) {
    LAS unsigned char* wl = C.lds + C.wave * 16384; LAS unsigned char* Kt = wl; LAS unsigned char* Vt = wl + 4608;
    const int lane = (ph_tid() & 63), r32 = lane & 31, hi = lane >> 5;
    for (int u = C.gw; u < BATCH * 8 * 64; u += C.NGW) {
        const int c = u & 63, h = (u >> 6) & 7, b = u >> 9;
        const float l2g = log1pf(-ex2((float)(-5 - h))) * LOG2E;
        const bf16* Hb = H + ((size_t)b * SEQ + c * 64) * D_IN + h * 64;
        f32x16 acc[2][2]; acc[0][0] = f32x16{}; acc[0][1] = f32x16{}; acc[1][0] = f32x16{}; acc[1][1] = f32x16{};
        for (int jh = 0; jh < 2; ++jh) {
            load_tile32_rot<true>(Hb + (size_t)(32 * jh) * D_IN + OFF_KR, D_IN, rope, c * 64 + 32 * jh, 32 * jh, l2g, Kt, lane);
            load_tile32(Hb + (size_t)(32 * jh) * D_IN + OFF_VR, D_IN, Vt, lane);
#pragma unroll
            for (int m = 0; m < 2; ++m) {
                bf16x8 kf[2], vf[2];
#pragma unroll
                for (int a = 0; a < 2; ++a) { kf[a] = tr_frag(Kt, 16 * m + 8 * hi, 16 * m + 8 * hi + 4, a, lane); vf[a] = tr_frag(Vt, 16 * m + 8 * hi, 16 * m + 8 * hi + 4, a, lane); }
#pragma unroll
                for (int a = 0; a < 2; ++a)
#pragma unroll
                    for (int b2 = 0; b2 < 2; ++b2) acc[a][b2] = mfma32(kf[a], vf[b2], acc[a][b2]);
            }
        }
        float* dst = KV + ((size_t)((b * 8 + h) * 64 + c)) * 4096;
#pragma unroll
        for (int a = 0; a < 2; ++a)
#pragma unroll
            for (int b2 = 0; b2 < 2; ++b2)
#pragma unroll
                for (int r = 0; r < 16; ++r) dst[(crow(r, hi) + 32 * a) * 64 + r32 + 32 * b2] = acc[a][b2][r];
    }
}
__device__ __forceinline__ void ret_scan_phase(const Ctx& C, const float* KV, bf16* S16) {
    for (int idx = C.gw * 64 + (ph_tid() & 63); idx < BATCH * 8 * 2048; idx += C.NGW * 64) {
        const int bh = idx >> 11, el = (idx & 2047) * 2, h = bh & 7;
        const float dc = ex2(64.0f * log1pf(-ex2((float)(-5 - h))) * LOG2E);
        const float* p = KV + (size_t)bh * 64 * 4096 + el; bf16* q = S16 + (size_t)bh * 64 * 4096 + el; f32x2 st = {0.f, 0.f};
        for (int c0 = 0; c0 < 64; c0 += 8) { f32x2 t[8];
#pragma unroll
            for (int k = 0; k < 8; ++k) t[k] = *(const GAS f32x2*)(p + (size_t)(c0 + k) * 4096);
#pragma unroll
            for (int k = 0; k < 8; ++k) { *(GAS unsigned*)(q + (size_t)(c0 + k) * 4096) = cvtpk(st[0], st[1]); st = st * dc + t[k]; } }
    }
}
__device__ __forceinline__ void ret_out_phase(const Ctx& C, const bf16* H, const float* rope, const bf16* S16, const float* gn_g, bf16* O) {
    LAS unsigned char* wl = C.lds + C.wave * 16384; LAS unsigned char* Kt = wl; LAS unsigned char* Vt = wl + 4608; LAS unsigned char* St = wl + 9216;
    LAS float* stf = (LAS float*)wl;
    const int lane = (ph_tid() & 63), r32 = lane & 31, hi = lane >> 5;
    for (int u = C.gw; u < BATCH * 8 * 64 * 2; u += C.NGW) {
        const int ih = u & 1, c = (u >> 1) & 63, h = (u >> 7) & 7, b = u >> 10;
        const float l2g = log1pf(-ex2((float)(-5 - h))) * LOG2E;
        const bf16* Hb = H + ((size_t)b * SEQ + c * 64) * D_IN + h * 64;
        const bf16* Sg = S16 + ((size_t)((b * 8 + h) * 64 + c)) * 4096;
        const int iq = 32 * ih + r32, pos = c * 64 + iq;
        v4u qr[4], s0r[4], s1r[4], ka[2], kb[2], vv[4], gq[4];
#pragma unroll
        for (int dk = 0; dk < 4; ++dk) qr[dk] = *(const GAS v4u*)(Hb + (size_t)iq * D_IN + OFF_QR + 16 * dk + 8 * hi);
        tile32_fetch(Sg, 64, lane, s0r); tile32_fetch(Sg + 32 * 64, 64, lane, s1r);
#pragma unroll
        for (int i = 0; i < 2; ++i) { const int id = i * 64 + lane, row = id >> 2, ch = id & 3;
            ka[i] = *(const GAS v4u*)(Hb + (size_t)row * D_IN + OFF_KR + ch * 8); kb[i] = *(const GAS v4u*)(Hb + (size_t)row * D_IN + OFF_KR + 32 + ch * 8); }
        tile32_fetch(Hb + OFF_VR, D_IN, lane, vv);
#pragma unroll
        for (int i = 0; i < 4; ++i) { const int row = i * 8 + (lane >> 3), ch = lane & 7; gq[i] = *(const GAS v4u*)(Hb + (size_t)(32 * ih + row) * D_IN + OFF_GR + ch * 8); }
        bf16x8 qf[4];
#pragma unroll
        for (int dk = 0; dk < 2; ++dk) { const float* rp = rope + (size_t)pos * 64 + 16 * dk + 8 * hi;
            const f32x4 c0 = *(const GAS f32x4*)rp, c1 = *(const GAS f32x4*)(rp + 4), s0 = *(const GAS f32x4*)(rp + 32), s1 = *(const GAS f32x4*)(rp + 36);
            float o1[8], o2[8];
#pragma unroll
            for (int e = 0; e < 8; ++e) { const float x1 = bfel(qr[dk], e), x2 = bfel(qr[dk + 2], e), cc = e < 4 ? c0[e & 3] : c1[e & 3], ss = e < 4 ? s0[e & 3] : s1[e & 3];
                o1[e] = (x1 * cc - x2 * ss) * 0.125f; o2[e] = (x1 * ss + x2 * cc) * 0.125f; }
            qf[dk] = pack8(o1); qf[dk + 2] = pack8(o2); }
        f32x16 cacc[2]; cacc[0] = f32x16{}; cacc[1] = f32x16{};
        tile32_store(St, lane, s0r);
#pragma unroll
        for (int m2 = 0; m2 < 2; ++m2)
#pragma unroll
            for (int eb = 0; eb < 2; ++eb) cacc[eb] = mfma32(tr_frag(St, 16 * m2 + 8 * hi, 16 * m2 + 8 * hi + 4, eb, lane), qf[m2], cacc[eb]);
        tile32_store(St, lane, s1r);
#pragma unroll
        for (int m2 = 0; m2 < 2; ++m2)
#pragma unroll
            for (int eb = 0; eb < 2; ++eb) cacc[eb] = mfma32(tr_frag(St, 16 * m2 + 8 * hi, 16 * m2 + 8 * hi + 4, eb, lane), qf[2 + m2], cacc[eb]);
        f32x16 oacc[2]; oacc[0] = f32x16{}; oacc[1] = f32x16{};
        for (int jt = 0; jt <= ih; ++jt) {
            if (jt == 1) {
#pragma unroll
                for (int i = 0; i < 2; ++i) { const int id = i * 64 + lane, row = 32 + (id >> 2), ch = id & 3;
                    ka[i] = *(const GAS v4u*)(Hb + (size_t)row * D_IN + OFF_KR + ch * 8); kb[i] = *(const GAS v4u*)(Hb + (size_t)row * D_IN + OFF_KR + 32 + ch * 8); }
                tile32_fetch(Hb + (size_t)32 * D_IN + OFF_VR, D_IN, lane, vv); }
#pragma unroll
            for (int i = 0; i < 2; ++i) { const int id = i * 64 + lane, row = id >> 2, ch = id & 3;
                const float* rp = rope + (size_t)(c * 64 + 32 * jt + row) * 64 + ch * 8;
                const f32x4 c0 = *(const GAS f32x4*)rp, c1 = *(const GAS f32x4*)(rp + 4), s0 = *(const GAS f32x4*)(rp + 32), s1 = *(const GAS f32x4*)(rp + 36);
                float o1[8], o2[8];
#pragma unroll
                for (int e = 0; e < 8; ++e) { const float x1 = bfel(ka[i], e), x2 = bfel(kb[i], e), cc = e < 4 ? c0[e & 3] : c1[e & 3], ss = e < 4 ? s0[e & 3] : s1[e & 3];
                    o1[e] = x1 * cc - x2 * ss; o2[e] = x1 * ss + x2 * cc; }
                v4u w1, w2;
#pragma unroll
                for (int e = 0; e < 4; ++e) { w1[e] = cvtpk(o1[2 * e], o1[2 * e + 1]); w2[e] = cvtpk(o2[2 * e], o2[2 * e + 1]); }
                *(LAS v4u*)(Kt + row * TP + ch * 16) = w1; *(LAS v4u*)(Kt + row * TP + 64 + ch * 16) = w2; }
            tile32_store(Vt, lane, vv);
            f32x16 acc = f32x16{};
#pragma unroll
            for (int dk = 0; dk < 4; ++dk) acc = mfma32(row_frag(Kt, r32, hi, dk), qf[dk], acc);
            float w[16];
#pragma unroll
            for (int r = 0; r < 16; ++r) { const int dl = iq - (32 * jt + crow(r, hi)); w[r] = dl >= 0 ? acc[r] * ex2((float)dl * l2g) : 0.f; }
            const bf16x8 pf0 = pack8(w), pf1 = pack8(w + 8);
#pragma unroll
            for (int eb = 0; eb < 2; ++eb) {
                oacc[eb] = mfma32(tr_frag(Vt, 4 * hi, 8 + 4 * hi, eb, lane), pf0, oacc[eb]);
                oacc[eb] = mfma32(tr_frag(Vt, 16 + 4 * hi, 24 + 4 * hi, eb, lane), pf1, oacc[eb]); }
        }
        const float dq = ex2((float)(iq + 1) * l2g);
        float x[2][16]; float sm = 0.f;
#pragma unroll
        for (int eb = 0; eb < 2; ++eb)
#pragma unroll
            for (int r = 0; r < 16; ++r) { x[eb][r] = oacc[eb][r] + dq * cacc[eb][r]; sm += x[eb][r]; }
        sm = xsum32(sm); const float mean = sm * (1.0f / 64.0f); float s2 = 0.f;
#pragma unroll
        for (int eb = 0; eb < 2; ++eb)
#pragma unroll
            for (int r = 0; r < 16; ++r) { x[eb][r] -= mean; s2 += x[eb][r] * x[eb][r]; }
        s2 = xsum32(s2); const float rstd = 1.0f / sqrtf(s2 * (1.0f / 64.0f) + LN_EPS);
#pragma unroll
        for (int eb = 0; eb < 2; ++eb)
#pragma unroll
            for (int r = 0; r < 16; ++r) stf[r32 * 66 + 32 * eb + crow(r, hi)] = x[eb][r] * rstd;
#pragma unroll
        for (int i = 0; i < 4; ++i) { const int row = i * 8 + (lane >> 3), ch = lane & 7;
            const f32x4 g0 = *(const GAS f32x4*)(gn_g + h * 64 + ch * 8), g1 = *(const GAS f32x4*)(gn_g + h * 64 + ch * 8 + 4);
            float o[8];
#pragma unroll
            for (int e = 0; e < 8; ++e) { const float gate = bfel(gq[i], e), nv = stf[row * 66 + ch * 8 + e], gg = e < 4 ? g0[e & 3] : g1[e & 3];
                o[e] = gate * __builtin_amdgcn_rcpf(1.0f + ex2(-gate * LOG2E)) * nv * gg; }
            v4u t; t.x = cvtpk(o[0], o[1]); t.y = cvtpk(o[2], o[3]); t.z = cvtpk(o[4], o[5]); t.w = cvtpk(o[6], o[7]);
            *(GAS v4u*)(O + (size_t)(b * SEQ + c * 64 + 32 * ih + row) * DM + 512 + h * 64 + ch * 8) = t; }
    }
}

constexpr int CA_SLOT = 2 * 64 * TP, CA_TB = 5 * CA_SLOT, CA_STG = CA_TB + 2304;
static_assert(CA_STG + 8 * 32 * TP <= LDSCTL_OFF, "chunk attention LDS map");
__device__ __forceinline__ void ca_softmax_pv(const f32x16& a0, const f32x16& a1, int st, const LAS float* tb, const LAS unsigned char* Vs, int iq, int hi, int lane, float& m, float& l, f32x16 (&oacc)[2]) {
    const float C1 = 0.125f * LOG2E;
    f32x16 p0, p1; float mn;
    if (st <= 3) {
        const float bc = tb[575 - 512];
        float t = fmaxf(a0[0], a1[0]);
#pragma unroll
        for (int r = 1; r < 16; ++r) t = fmaxf(fmaxf(t, a0[r]), a1[r]);
        float tm = t * C1 + bc; tm = xmax32(tm); mn = fmaxf(m, tm);
        const float cc = bc - mn; p0 = a0 * C1 + cc; p1 = a1 * C1 + cc;
    } else {
        int lo_ = iq - 4 * hi; asm volatile("" : "+v"(lo_));
        const LAS float* tp = tb + (575 - 256 - 64 * (8 - st)) - lo_;
#pragma unroll
        for (int r = 0; r < 16; ++r) { const int k = (r & 3) + 8 * (r >> 2); p0[r] = a0[r] * C1 + tp[k]; p1[r] = a1[r] * C1 + tp[k + 32]; }
        float t = fmaxf(p0[0], p1[0]);
#pragma unroll
        for (int r = 1; r < 16; ++r) t = fmaxf(fmaxf(t, p0[r]), p1[r]);
        t = xmax32(t); mn = fmaxf(m, t);
        p0 = p0 - mn; p1 = p1 - mn;
    }
    if (__any(mn > m)) { const float al = ex2(m - mn); l *= al; oacc[0] = oacc[0] * al; oacc[1] = oacc[1] * al; }
    m = mn;
#pragma unroll
    for (int r = 0; r < 16; ++r) { p0[r] = ex2(p0[r]); p1[r] = ex2(p1[r]); }
    { const f32x16 sm = p0 + p1; float ps = 0.f;
#pragma unroll
      for (int r = 0; r < 16; r += 4) ps += (sm[r] + sm[r + 1]) + (sm[r + 2] + sm[r + 3]);
      l += ps; }
    float s0[16], s1[16];
#pragma unroll
    for (int r = 0; r < 16; ++r) { s0[r] = p0[r]; s1[r] = p1[r]; }
    const bf16x8 p00 = pack8(s0), p01 = pack8(s0 + 8), p10 = pack8(s1), p11 = pack8(s1 + 8);
#pragma unroll
    for (int db = 0; db < 2; ++db) {
        bf16x8 vf[4];
#pragma unroll
        for (int k = 0; k < 4; ++k) vf[k] = tr_frag(Vs, 16 * k + 4 * hi, 16 * k + 8 + 4 * hi, db, lane);
        __builtin_amdgcn_sched_barrier(0);
        oacc[db] = mfma32(vf[0], p00, oacc[db]); oacc[db] = mfma32(vf[1], p01, oacc[db]);
        oacc[db] = mfma32(vf[2], p10, oacc[db]); oacc[db] = mfma32(vf[3], p11, oacc[db]); }
}
#define CA_BAR() asm volatile("s_waitcnt lgkmcnt(0)\n\ts_barrier" ::: "memory")
__device__ __forceinline__ void chunk_attn_phase(const Ctx& C, const bf16* QKV, const float* rel_bias, bf16* O) {
    const int lane = (ph_tid() & 63), r32 = lane & 31, hi = lane >> 5, w = C.wave, tid = ph_tid();
    LAS unsigned char* lds = C.lds; LAS float* tb = (LAS float*)(lds + CA_TB); LAS unsigned char* stg = lds + CA_STG + w * (32 * TP);
    const int prow = tid >> 3, pch = tid & 7;
    const int NU = BATCH * 16 * 16, per = (NU + C.G - 1) / C.G;
    const bool late = w >= 4;
    int cur_h = -1;
    for (int i = 0; i < per; ++i) {
        const int u = C.vcu * per + i; if (u >= NU) break;
        const int g = u & 15, h = (u >> 4) & 15, b = u >> 8, c0 = 4 * g, qc = c0 + (w >> 1), iq = 32 * (w & 1) + r32;
        CA_BAR();
        if (h != cur_h) { for (int k = tid; k < 576; k += NWAVES * 64) { const int e = 575 - k; tb[k] = rel_bias[h * 513 + (e > 512 ? 512 : e)] * LOG2E; } cur_h = h; }
        const bf16* Qb = QKV + (size_t)b * SEQ * NQKV + h * 64;
        const bf16* Kp = Qb + (size_t)prow * NQKV + 1024 + pch * 8;
        bf16x8 qf[4];
#pragma unroll
        for (int dk = 0; dk < 4; ++dk) qf[dk] = *(const GAS bf16x8*)(Qb + (size_t)(qc * 64 + iq) * NQKV + 16 * dk + 8 * hi);
#pragma unroll
        for (int j = 0; j < 4; ++j) { const int kcj = c0 - 8 + j;
            if (kcj >= 0) { const v4u kr = *(const GAS v4u*)(Kp + (size_t)kcj * 64 * NQKV), vr = *(const GAS v4u*)(Kp + (size_t)kcj * 64 * NQKV + 1024);
                LAS unsigned char* sl = lds + (kcj % 5) * CA_SLOT + prow * TP + pch * 16; *(LAS v4u*)sl = kr; *(LAS v4u*)(sl + 64 * TP) = vr; } }
        asm volatile("" : "+v"(qf[0]), "+v"(qf[1]), "+v"(qf[2]), "+v"(qf[3]));
        v4u kA = {0u, 0u, 0u, 0u}, vA = {0u, 0u, 0u, 0u}, kB = {0u, 0u, 0u, 0u}, vB = {0u, 0u, 0u, 0u};
        { const int nx = c0 - 4 < 0 ? 0 : c0 - 4; kA = *(const GAS v4u*)(Kp + (size_t)nx * 64 * NQKV); vA = *(const GAS v4u*)(Kp + (size_t)nx * 64 * NQKV + 1024); }
        CA_BAR();
        float m = -1.0e30f, l = 0.f; f32x16 oacc[2]; oacc[0] = f32x16{}; oacc[1] = f32x16{};
        f32x16 a0 = f32x16{}, a1 = f32x16{};
#define CA_STEP(ST, KR, VR, KN, VN) do { const int st = (ST); \
            const int pre = c0 - 4 + st; const bool has_pre = (st < 8) && (pre >= 0); \
            { const int nx = pre + 1 < 0 ? 0 : (pre + 1 > 63 ? 63 : pre + 1);     \
              KN = *(const GAS v4u*)(Kp + (size_t)nx * 64 * NQKV); VN = *(const GAS v4u*)(Kp + (size_t)nx * 64 * NQKV + 1024); } \
            const int kc = qc - 8 + st; \
            if (late && st > 0 && kc - 1 >= 0) ca_softmax_pv(a0, a1, st - 1, tb, lds + ((kc - 1) % 5) * CA_SLOT + 64 * TP, iq, hi, lane, m, l, oacc);     \
            if (kc >= 0) { \
                const LAS unsigned char* Ks = lds + (kc % 5) * CA_SLOT; \
                a0 = f32x16{}; a1 = f32x16{}; \
                _Pragma("unroll") for (int dk = 0; dk < 4; ++dk) { a0 = mfma32(row_frag(Ks, r32, hi, dk), qf[dk], a0); a1 = mfma32(row_frag(Ks + 32 * TP, r32, hi, dk), qf[dk], a1); } \
                if (!late) ca_softmax_pv(a0, a1, st, tb, Ks + 64 * TP, iq, hi, lane, m, l, oacc); \
            } \
            if (has_pre) { LAS unsigned char* sl = lds + (pre % 5) * CA_SLOT + prow * TP + pch * 16; *(LAS v4u*)sl = KR; *(LAS v4u*)(sl + 64 * TP) = VR; } \
            CA_BAR(); } while (0)
        for (int s2 = 0; s2 < 8; s2 += 2) { CA_STEP(s2, kA, vA, kB, vB); CA_STEP(s2 + 1, kB, vB, kA, vA); }
        CA_STEP(8, kA, vA, kB, vB);
#undef CA_STEP
        if (late) ca_softmax_pv(a0, a1, 8, tb, lds + (qc % 5) * CA_SLOT + 64 * TP, iq, hi, lane, m, l, oacc);
        l += __shfl_xor(l, 32); const float inv = 1.0f / l;
#pragma unroll
        for (int db = 0; db < 2; ++db)
#pragma unroll
            for (int r = 0; r < 16; ++r) *(LAS unsigned short*)(stg + r32 * TP + (db * 32 + crow(r, hi)) * 2) = (unsigned short)cvtpk(oacc[db][r] * inv, 0.f);
#pragma unroll
        for (int k = 0; k < 4; ++k) { const int row = k * 8 + (lane >> 3), ch = lane & 7; const v4u v = *(const LAS v4u*)(stg + row * TP + ch * 16);
            *(GAS v4u*)(O + (size_t)(b * SEQ + qc * 64 + 32 * (w & 1) + row) * DM + h * 64 + ch * 8) = v; }
    }
}

struct Params { const float* in[23]; float* out; unsigned char* ws; };
__global__ void __launch_bounds__(NWAVES * 64, 2) fwd_kernel(Params p) {
    extern __shared__ __attribute__((aligned(16))) unsigned char lds_raw[];
    Ctx C;
    C.lds = (LAS unsigned char*)lds_raw; C.wave = __builtin_amdgcn_readfirstlane((int)threadIdx.x >> 6);
    C.G = gridDim.x; { const int bx = blockIdx.x; C.vcu = (C.G % 8 == 0) ? (bx % 8) * (C.G / 8) + bx / 8 : bx; }
    C.gw = C.vcu * NWAVES + C.wave; C.NGW = C.G * NWAVES;
    unsigned char* ws = p.ws; gu32* ctl = (gu32*)(ws + WS_CTL);
    volatile LAS unsigned* MISC = (volatile LAS unsigned*)(C.lds + MISC_OFF);
    for (int u = threadIdx.x; u < (LDS_BYTES - LDSCTL_OFF) / 4; u += NWAVES * 64) ((LAS unsigned*)(C.lds + LDSCTL_OFF))[u] = 0u;
    __syncthreads();
    XcdBarrier bar = xcd_barrier_post((unsigned*)(ctl + CW_BAR), MISC + 8);
#define GRID_BAR() xcd_barrier(bar)
    const int bx = (int)blockIdx.x;
    bf16* XB = (bf16*)(ws + WS_XB); bf16* OB = (bf16*)(ws + WS_O); bf16* MIX = (bf16*)(ws + WS_MIX);
    float* KV = p.out;     const float* rope = (const float*)(ws + WS_ROPE);

    p0_prologue(C, p.in, ws, (unsigned char*)p.out);
    GRID_BAR();
    quant_rows_fp8<2>(C, (const bf16*)((unsigned char*)p.out + OUT_WGU1), NEXP * 2 * FF1, ws + WS_WGU1Q, (float*)(ws + WS_SBGU));
    quant_rows_fp8<7>(C, (const bf16*)((unsigned char*)p.out + OUT_WDN1), NEXP * DM, ws + WS_WDN1Q, (float*)(ws + WS_SBDN));
    { pg8::Gemm g{XB, (const bf16*)(ws + WS_WIN), MTOK, D_IN, DM}; pg8::StaticOrder S; S.init(MTOK, D_IN, C.G, bx);
      pg8::EpiPlain E{(bf16*)(ws + WS_H), D_IN, 0, 0};
      pg8::gemm_phase<pg8::EpiPlain, pg8::StaticOrder, true, true>(C.lds, g, S, E, C.wave); }
    GRID_BAR();
    sb_phase(C, (const bf16*)(ws + WS_H), OB);
    ret_kv_phase(C, (const bf16*)(ws + WS_H), rope, KV);
    GRID_BAR();
    ret_scan_phase(C, KV, (bf16*)((unsigned char*)p.out + 128 * MiB));
    GRID_BAR();
    ret_out_phase(C, (const bf16*)(ws + WS_H), rope, (const bf16*)((unsigned char*)p.out + 128 * MiB), p.in[4], OB);
    GRID_BAR();
    { pg8::Gemm g{OB, (const bf16*)(ws + WS_WO0), MTOK, DM, DM}; pg8::StaticOrder S; S.init(MTOK, DM, C.G, bx);
      pg8::EpiPlain E{MIX, DM, 0, 0};
      pg8::gemm_phase<pg8::EpiPlain, pg8::StaticOrder, true, true>(C.lds, g, S, E, C.wave); }
    GRID_BAR();
    ln_phase<0, false>(C, XB, MIX, p.in[1], p.in[2], nullptr, XB, nullptr, nullptr, ws);
    GRID_BAR();
    { pg8::Gemm g{XB, (const bf16*)(ws + WS_WGU0), MTOK, 2 * FF0, DM}; pg8::StaticOrder S; S.init(MTOK, 2 * FF0, C.G, bx);
      pg8::EpiSwiGLU E{(bf16*)(ws + WS_HID0), FF0, 0, 0};
      pg8::gemm_phase<pg8::EpiSwiGLU, pg8::StaticOrder, true, true>(C.lds, g, S, E, C.wave); }
    GRID_BAR();
    { pg8::Gemm g{(const bf16*)(ws + WS_HID0), (const bf16*)(ws + WS_WDN0), MTOK, DM, FF0}; pg8::StaticOrder S; S.init(MTOK, DM, C.G, bx);
      pg8::EpiPlain E{MIX, DM, 0, 0};
      pg8::gemm_phase<pg8::EpiPlain, pg8::StaticOrder, true, true>(C.lds, g, S, E, C.wave); }
    GRID_BAR();
    ln_phase<0, false>(C, XB, MIX, p.in[6], p.in[7], nullptr, XB, nullptr, nullptr, ws);
    GRID_BAR();
    { pg8::Gemm g{XB, (const bf16*)(ws + WS_WQKV), MTOK, NQKV, DM}; pg8::StaticOrder S; S.init(MTOK, NQKV, C.G, bx);
      pg8::EpiPlain E{(bf16*)(ws + WS_QKV), NQKV, 0, 0};
      pg8::gemm_phase<pg8::EpiPlain, pg8::StaticOrder, true, true>(C.lds, g, S, E, C.wave); }
    GRID_BAR();
    chunk_attn_phase(C, (const bf16*)(ws + WS_QKV), p.in[14], OB);
    GRID_BAR();
    { pg8::Gemm g{OB, (const bf16*)(ws + WS_WO1), MTOK, DM, DM}; pg8::StaticOrder S; S.init(MTOK, DM, C.G, bx);
      pg8::EpiPlain E{MIX, DM, 0, 0};
      pg8::gemm_phase<pg8::EpiPlain, pg8::StaticOrder, true, true>(C.lds, g, S, E, C.wave); }
    GRID_BAR();
    ln_phase<1, false>(C, XB, MIX, p.in[11], p.in[12], nullptr, XB, p.in[18], p.in[19], ws);
    GRID_BAR();
    moe_assign(C, ws, ctl);
    GRID_BAR();
    const int ntile = (int)__builtin_amdgcn_readfirstlane(__hip_atomic_load(ctl + CW_NTILES, RLX_AGENT));
    moe_gather(C, ws, ntile);
    GRID_BAR();
    for (int t0 = 0; t0 < ntile; t0 += MOE_SLICE) {
        const int nT = (ntile - t0) < MOE_SLICE ? (ntile - t0) : MOE_SLICE;
        { pg8::Gemm g{(const bf16*)(ws + WS_AMOE), (const bf16*)(ws + WS_WGU1Q), MOE_ROWS, 2 * FF1, DM / 2}; MoeOrder S; S.init(t0, nT, 2 * FF1 / 256, C.G, bx, (const gu32*)(ws + WS_TILE), (LAS unsigned*)(C.lds + MOE_TAB_OFF), ph_tid());
          pg8::EpiSwiGLU8 E{ws + WS_HSL, FF1, 2 * FF1 / 256, t0, (const float*)(ws + WS_SAS), (const float*)(ws + WS_SBGU)};
          pg8::gemm_phase<pg8::EpiSwiGLU8, MoeOrder, true, true, 1>(C.lds, g, S, E, C.wave); }
        GRID_BAR();
        { pg8::Gemm g{(const bf16*)(ws + WS_HSL - (size_t)t0 * 256 * FF1), (const bf16*)(ws + WS_WDN1Q), MOE_ROWS, DM, FF1 / 2}; MoeOrder S; S.init(t0, nT, DM / 256, C.G, bx, (const gu32*)(ws + WS_TILE), (LAS unsigned*)(C.lds + MOE_TAB_OFF), ph_tid());
          pg8::EpiPlain8 E{(bf16*)(ws + WS_Y), DM, DM / 256, (const float*)(ws + WS_SBDN)};
          pg8::gemm_phase<pg8::EpiPlain8, MoeOrder, true, true, 1>(C.lds, g, S, E, C.wave); }
        GRID_BAR();
    }
    ln_phase<2, false>(C, XB, (const bf16*)(ws + WS_Y), p.in[16], p.in[17], p.out, nullptr, nullptr, nullptr, ws);
#undef GRID_BAR
}

extern "C" void kernel_launch(void* const* d_in, const int* in_sizes, int n_in, void* d_out, int out_size, void* d_ws, size_t ws_size, hipStream_t stream) {
    static int grid = 0;
    if (grid == 0) {
        if (n_in != 23 || in_sizes[0] != MTOK * DM || out_size != MTOK * DM || ws_size < WS_END) {
            fprintf(stderr, "kernel_launch: unexpected shapes/workspace (n_in %d, in0 %d, out %d, ws %zu, need %zu); nothing launched\n", n_in, n_in > 0 ? in_sizes[0] : -1, out_size, ws_size, (size_t)WS_END); grid = -1; return; }
        int dev = 0, cus = 0, per_cu = 0;
        if (hipGetDevice(&dev) != hipSuccess || hipDeviceGetAttribute(&cus, hipDeviceAttributeMultiprocessorCount, dev) != hipSuccess) { grid = -1; return; }
        if (hipFuncSetAttribute((const void*)fwd_kernel, hipFuncAttributeMaxDynamicSharedMemorySize, LDS_BYTES) != hipSuccess) { fprintf(stderr, "kernel_launch: hipFuncSetAttribute failed\n"); grid = -1; return; }
        if (hipOccupancyMaxActiveBlocksPerMultiprocessor(&per_cu, (const void*)fwd_kernel, NWAVES * 64, LDS_BYTES) != hipSuccess || per_cu < 1)
            fprintf(stderr, "kernel_launch: note: occupancy query reports %d workgroups per CU\n", per_cu);
        (void)hipGetLastError();
        grid = cus;
    }
    if (grid < 0) return;
    if (hipMemsetAsync((char*)d_ws + WS_CTL, 0, CTL_ZERO_BYTES, stream) != hipSuccess) return;
    Params p{};
    for (int i = 0; i < 23; ++i) p.in[i] = (const float*)d_in[i];
    p.out = (float*)d_out; p.ws = (unsigned char*)d_ws;
    hipLaunchKernelGGL(fwd_kernel, dim3(grid), dim3(NWAVES * 64), LDS_BYTES, stream, p);
}
```
